# Optimizing an MI355X kernel written in HIP

```python
import jax, jax.numpy as jnp
from jax import lax
import numpy as np

D_MODEL = 1024
BATCH = 8
SEQ = 4096
DEPTH = 2

HEAD_DIM = 64
SB_HEADS = 4
DSA_HEADS = 4
NSA_HEADS = 4
BRANCH_WIDTH = 4 * HEAD_DIM
IDX_HEADS = 4
IDX_DIM = 64
DSA_TOPK = 256
CMP_LEN = 32
CMP_STRIDE = 16
CMP_HIDDEN = 128
SEL_LEN = 64
SEL_TOPN = 16
WINDOW = 512
N_MEM = 256
MEM_HEADS = 4
MEM_HEAD_DIM = 64
D_FF = ((8 * D_MODEL + 3 * 256 - 1) // (3 * 256)) * 256
Q_BLOCK = 128
ROPE_THETA = 10000.0
RMS_EPS = 1e-6
FORCED_SCORE = 1e4

IN_SPLITS = (
    ('q_a', SB_HEADS * HEAD_DIM), ('k_a', SB_HEADS * HEAD_DIM), ('v_a', SB_HEADS * HEAD_DIM),
    ('q_b', DSA_HEADS * HEAD_DIM), ('k_b', HEAD_DIM), ('v_b', HEAD_DIM),
    ('q_idx', IDX_HEADS * IDX_DIM), ('k_idx', IDX_DIM), ('w_idx', IDX_HEADS),
    ('q_c', NSA_HEADS * HEAD_DIM), ('k_cmp', HEAD_DIM), ('v_cmp', HEAD_DIM),
    ('k_sel', HEAD_DIM), ('v_sel', HEAD_DIM), ('k_win', HEAD_DIM), ('v_win', HEAD_DIM),
    ('g_c', NSA_HEADS * 3),
    ('g_merge', 3 * D_MODEL),
)
D_IN = sum(w for _, w in IN_SPLITS)

kernel_name = 'hybrid_sb_dsa_nsa_gated_block'


def _rmsnorm(x, g):
    xf = x.astype(jnp.float32)
    y = xf * lax.rsqrt(jnp.mean(xf * xf, axis=-1, keepdims=True) + RMS_EPS)
    return (y * g.astype(jnp.float32)).astype(x.dtype)


def _rope(x):
    S, hd = x.shape[1], x.shape[-1]
    inv = ROPE_THETA ** (-jnp.arange(0, hd, 2, dtype=jnp.float32) / hd)
    ang = jnp.arange(S, dtype=jnp.float32)[:, None] * inv[None, :]
    cos = jnp.cos(ang)[None, :, None, :]
    sin = jnp.sin(ang)[None, :, None, :]
    xf = x.astype(jnp.float32)
    x1, x2 = xf[..., : hd // 2], xf[..., hd // 2:]
    return jnp.concatenate([x1 * cos - x2 * sin, x2 * cos + x1 * sin], axis=-1).astype(x.dtype)


def _masked_softmax(s, mask):
    s = jnp.where(mask, s.astype(jnp.float32), -jnp.inf)
    m = jnp.max(s, axis=-1, keepdims=True)
    m = jnp.where(jnp.isfinite(m), m, 0.0)
    e = jnp.where(mask, jnp.exp(s - m), 0.0)
    den = jnp.sum(e, axis=-1, keepdims=True)
    return e / jnp.maximum(den, 1e-30)


def _sweep(block_fn, S):
    out = lax.map(block_fn, jnp.arange(S // Q_BLOCK))
    out = jnp.moveaxis(out, 0, 1)
    return out.reshape((out.shape[0], S) + out.shape[3:])


def _split_columns(p):
    parts, off = {}, 0
    for name, w in IN_SPLITS:
        parts[name] = p[..., off:off + w]
        off += w
    return parts


def _stick_breaking(q, k, v):
    B, S, H, hd = q.shape
    scale = hd ** -0.5
    kpos = jnp.arange(S)

    def block(i):
        q0 = i * Q_BLOCK
        qpos = q0 + jnp.arange(Q_BLOCK)
        qb = lax.dynamic_slice_in_dim(q, q0, Q_BLOCK, axis=1)
        z = jnp.einsum('bqhd,bkhd->bhqk', qb, k).astype(jnp.float32) * scale
        strict = kpos[None, :] < qpos[:, None]
        log_1m = jnp.where(strict, jax.nn.log_sigmoid(-z), 0.0)
        suffix = lax.cumsum(log_1m, axis=3, reverse=True) - log_1m
        w = jnp.where(strict, jnp.exp(jax.nn.log_sigmoid(z) + suffix), 0.0)
        return jnp.einsum('bhqk,bkhd->bqhd', w.astype(v.dtype), v)

    return _sweep(block, S)


def _dsa_attention(q, k, v, q_idx, k_idx, w_idx):
    B, S, H, hd = q.shape
    topk = min(DSA_TOPK, S // 4)
    kpos = jnp.arange(S)
    bidx = jnp.arange(B)[:, None, None]
    w_scale = (IDX_HEADS * IDX_DIM) ** -0.5
    scale = hd ** -0.5

    def block(i):
        q0 = i * Q_BLOCK
        qpos = q0 + jnp.arange(Q_BLOCK)
        qi = lax.dynamic_slice_in_dim(q_idx, q0, Q_BLOCK, axis=1)
        wi = lax.dynamic_slice_in_dim(w_idx, q0, Q_BLOCK, axis=1).astype(jnp.float32) * w_scale
        rel = jax.nn.relu(jnp.einsum('bqhd,bkd->bqhk', qi, k_idx).astype(jnp.float32))
        score = jnp.einsum('bqh,bqhk->bqk', wi, rel)
        score = jnp.where(kpos[None, None, :] <= qpos[None, :, None], score, -jnp.inf)
        _, sel = lax.top_k(score, topk)
        kg = k[bidx, sel]
        vg = v[bidx, sel]
        qb = lax.dynamic_slice_in_dim(q, q0, Q_BLOCK, axis=1)
        s = jnp.einsum('bqhd,bqkd->bhqk', qb, kg).astype(jnp.float32) * scale
        valid = (sel <= qpos[None, :, None])[:, None]
        p = _masked_softmax(s, valid)
        return jnp.einsum('bhqk,bqkd->bqhd', p.astype(v.dtype), vg)

    return _sweep(block, S)


def _compress(tok, pos_emb, w1, w2):
    B, S, hd = tok.shape
    n_cmp = (S - CMP_LEN) // CMP_STRIDE + 1
    idx = np.arange(n_cmp)[:, None] * CMP_STRIDE + np.arange(CMP_LEN)[None, :]
    blocks = tok[:, idx] + pos_emb
    hid = jax.nn.gelu(blocks.reshape(B, n_cmp, CMP_LEN * hd) @ w1)
    return hid @ w2


def _nsa_attention(q, k_cmp, v_cmp, k_sel, v_sel, k_win, v_win, gates,
                   cmp_pos_k, cmp_w1_k, cmp_w2_k, cmp_pos_v, cmp_w1_v, cmp_w2_v):
    B, S, H, hd = q.shape
    scale = hd ** -0.5
    kc = _compress(k_cmp, cmp_pos_k, cmp_w1_k, cmp_w2_k)
    vc = _compress(v_cmp, cmp_pos_v, cmp_w1_v, cmp_w2_v)
    n_cmp = kc.shape[1]
    cmp_end = jnp.arange(n_cmp) * CMP_STRIDE + CMP_LEN - 1
    n_sel = S // SEL_LEN
    topn = min(SEL_TOPN, n_sel)
    cs = np.arange(n_cmp) * CMP_STRIDE
    ss = np.arange(n_sel) * SEL_LEN
    overlap = jnp.asarray(((cs[:, None] < ss[None, :] + SEL_LEN) &
                           (cs[:, None] + CMP_LEN > ss[None, :])).astype(np.float32))
    k_blocks = k_sel.reshape(B, n_sel, SEL_LEN, hd)
    v_blocks = v_sel.reshape(B, n_sel, SEL_LEN, hd)
    k_pad = jnp.pad(k_win, ((0, 0), (WINDOW, 0), (0, 0)))
    v_pad = jnp.pad(v_win, ((0, 0), (WINDOW, 0), (0, 0)))
    sel_ids = jnp.arange(n_sel)
    offs = jnp.arange(SEL_LEN)
    band_offs = jnp.arange(WINDOW + Q_BLOCK)
    bidx = jnp.arange(B)[:, None, None]

    def block(i):
        q0 = i * Q_BLOCK
        qpos = q0 + jnp.arange(Q_BLOCK)
        qb = lax.dynamic_slice_in_dim(q, q0, Q_BLOCK, axis=1)
        gb = lax.dynamic_slice_in_dim(gates, q0, Q_BLOCK, axis=1)
        s_c = jnp.einsum('bqhd,bnd->bhqn', qb, kc).astype(jnp.float32) * scale
        p_c = _masked_softmax(s_c, (cmp_end[None, :] <= qpos[:, None])[None, None])
        o_cmp = jnp.einsum('bhqn,bnd->bqhd', p_c.astype(vc.dtype), vc)
        imp = jnp.einsum('bhqn,nj->bqj', p_c, overlap)
        cur = qpos // SEL_LEN
        forced = ((sel_ids[None, :] == 0) | (sel_ids[None, :] == cur[:, None]) |
                  (sel_ids[None, :] == cur[:, None] - 1))
        admissible = sel_ids[None, :] * SEL_LEN <= qpos[:, None]
        imp = jnp.where(forced[None], FORCED_SCORE, imp)
        imp = jnp.where(admissible[None], imp, -jnp.inf)
        _, sel = lax.top_k(imp, topn)
        kg = k_blocks[bidx, sel].reshape(B, Q_BLOCK, topn * SEL_LEN, hd)
        vg = v_blocks[bidx, sel].reshape(B, Q_BLOCK, topn * SEL_LEN, hd)
        tok = (sel[..., None] * SEL_LEN + offs).reshape(B, Q_BLOCK, topn * SEL_LEN)
        s_s = jnp.einsum('bqhd,bqkd->bhqk', qb, kg).astype(jnp.float32) * scale
        p_s = _masked_softmax(s_s, (tok <= qpos[None, :, None])[:, None])
        o_sel = jnp.einsum('bhqk,bqkd->bqhd', p_s.astype(vg.dtype), vg)
        kw = lax.dynamic_slice_in_dim(k_pad, q0, WINDOW + Q_BLOCK, axis=1)
        vw = lax.dynamic_slice_in_dim(v_pad, q0, WINDOW + Q_BLOCK, axis=1)
        wpos = q0 - WINDOW + band_offs
        diff = qpos[:, None] - wpos[None, :]
        wmask = (diff >= 0) & (diff < WINDOW) & (wpos[None, :] >= 0)
        s_w = jnp.einsum('bqhd,bkd->bhqk', qb, kw).astype(jnp.float32) * scale
        p_w = _masked_softmax(s_w, wmask[None, None])
        o_win = jnp.einsum('bhqk,bkd->bqhd', p_w.astype(vw.dtype), vw)
        return gb[..., 0:1] * o_cmp + gb[..., 1:2] * o_sel + gb[..., 2:3] * o_win

    return _sweep(block, S)


def _hybrid_mixer(u, w_in, cmp_pos_k, cmp_w1_k, cmp_w2_k, cmp_pos_v, cmp_w1_v, cmp_w2_v, w_up, w_out):
    B, S, _ = u.shape
    p = _split_columns(u @ w_in)

    def heads(t, h, d=HEAD_DIM):
        return t.reshape(B, S, h, d)

    def rope1(t):
        return _rope(t[:, :, None, :])[:, :, 0]

    o_a = _stick_breaking(heads(p['q_a'], SB_HEADS), heads(p['k_a'], SB_HEADS), heads(p['v_a'], SB_HEADS))
    o_b = _dsa_attention(_rope(heads(p['q_b'], DSA_HEADS)), rope1(p['k_b']), p['v_b'],
                         _rope(heads(p['q_idx'], IDX_HEADS, IDX_DIM)), rope1(p['k_idx']), p['w_idx'])
    gates_c = jax.nn.sigmoid(p['g_c'].reshape(B, S, NSA_HEADS, 3))
    o_c = _nsa_attention(_rope(heads(p['q_c'], NSA_HEADS)), rope1(p['k_cmp']), p['v_cmp'],
                         rope1(p['k_sel']), p['v_sel'], rope1(p['k_win']), p['v_win'], gates_c,
                         cmp_pos_k, cmp_w1_k, cmp_w2_k, cmp_pos_v, cmp_w1_v, cmp_w2_v)
    g = jax.nn.sigmoid(p['g_merge'].reshape(B, S, 3, D_MODEL))
    merged = (g[:, :, 0] * (o_a.reshape(B, S, BRANCH_WIDTH) @ w_up[0]) +
              g[:, :, 1] * (o_b.reshape(B, S, BRANCH_WIDTH) @ w_up[1]) +
              g[:, :, 2] * (o_c.reshape(B, S, BRANCH_WIDTH) @ w_up[2]))
    return merged @ w_out


def _memory_attention(h, mem, g_q, g_kv, w_q, w_kv, w_o):
    B, S, _ = h.shape
    M = mem.shape[1]
    q = (_rmsnorm(h, g_q) @ w_q).reshape(B, S, MEM_HEADS, MEM_HEAD_DIM)
    kv = (_rmsnorm(mem, g_kv) @ w_kv).reshape(B, M, 2, MEM_HEADS, MEM_HEAD_DIM)
    s = jnp.einsum('bshd,bmhd->bhsm', q, kv[:, :, 0]).astype(jnp.float32) * MEM_HEAD_DIM ** -0.5
    pr = jax.nn.softmax(s, axis=-1)
    o = jnp.einsum('bhsm,bmhd->bshd', pr.astype(h.dtype), kv[:, :, 1])
    return o.reshape(B, S, MEM_HEADS * MEM_HEAD_DIM) @ w_o


def _swiglu(u, w_in, w_out):
    a = u @ w_in
    return (jax.nn.silu(a[..., :D_FF]) * a[..., D_FF:]) @ w_out


def setup_inputs(seed: int = 0) -> dict:
    key = jax.random.key(seed)
    ks = jax.random.split(key, 21)

    def nrm(k, shape, fan_in):
        return jax.random.normal(k, shape, jnp.float32) * fan_in ** -0.5

    def gain(k, shape):
        return 1.0 + 0.05 * jax.random.normal(k, shape, jnp.float32)

    L = DEPTH
    mem_w = MEM_HEADS * MEM_HEAD_DIM
    return {
        'x': jax.random.normal(ks[0], (BATCH, SEQ, D_MODEL), jnp.float32),
        'mem': jax.random.normal(ks[1], (BATCH, N_MEM, D_MODEL), jnp.float32),
        'norm_mix': gain(ks[2], (L, D_MODEL)),
        'w_in': nrm(ks[3], (L, D_MODEL, D_IN), D_MODEL),
        'cmp_pos_k': 0.1 * jax.random.normal(ks[4], (L, CMP_LEN, HEAD_DIM), jnp.float32),
        'cmp_w1_k': nrm(ks[5], (L, CMP_LEN * HEAD_DIM, CMP_HIDDEN), CMP_LEN * HEAD_DIM),
        'cmp_w2_k': nrm(ks[6], (L, CMP_HIDDEN, HEAD_DIM), CMP_HIDDEN),
        'cmp_pos_v': 0.1 * jax.random.normal(ks[7], (L, CMP_LEN, HEAD_DIM), jnp.float32),
        'cmp_w1_v': nrm(ks[8], (L, CMP_LEN * HEAD_DIM, CMP_HIDDEN), CMP_LEN * HEAD_DIM),
        'cmp_w2_v': nrm(ks[9], (L, CMP_HIDDEN, HEAD_DIM), CMP_HIDDEN),
        'w_up': nrm(ks[10], (L, 3, BRANCH_WIDTH, D_MODEL), BRANCH_WIDTH),
        'w_out': nrm(ks[11], (L, D_MODEL, D_MODEL), D_MODEL),
        'norm_mem_q': gain(ks[12], (L, D_MODEL)),
        'norm_mem_kv': gain(ks[13], (L, D_MODEL)),
        'w_mem_q': nrm(ks[14], (L, D_MODEL, mem_w), D_MODEL),
        'w_mem_kv': nrm(ks[15], (L, D_MODEL, 2 * mem_w), D_MODEL),
        'w_mem_o': nrm(ks[16], (L, mem_w, D_MODEL), mem_w),
        'norm_ffn': gain(ks[17], (L, D_MODEL)),
        'w_ffn_in': nrm(ks[18], (L, D_MODEL, 2 * D_FF), D_MODEL),
        'w_ffn_out': nrm(ks[19], (L, D_FF, D_MODEL), D_FF),
        'norm_final': gain(ks[20], (D_MODEL,)),
    }


def reference(x, mem, norm_mix, w_in, cmp_pos_k, cmp_w1_k, cmp_w2_k, cmp_pos_v, cmp_w1_v, cmp_w2_v,
              w_up, w_out, norm_mem_q, norm_mem_kv, w_mem_q, w_mem_kv, w_mem_o,
              norm_ffn, w_ffn_in, w_ffn_out, norm_final):
    h = x
    for l in range(DEPTH):
        h = h + _hybrid_mixer(_rmsnorm(h, norm_mix[l]), w_in[l],
                              cmp_pos_k[l], cmp_w1_k[l], cmp_w2_k[l],
                              cmp_pos_v[l], cmp_w1_v[l], cmp_w2_v[l], w_up[l], w_out[l])
        h = h + _memory_attention(h, mem, norm_mem_q[l], norm_mem_kv[l], w_mem_q[l], w_mem_kv[l], w_mem_o[l])
        h = h + _swiglu(_rmsnorm(h, norm_ffn[l]), w_ffn_in[l], w_ffn_out[l])
    return _rmsnorm(h, norm_final)
```

```cpp
#include <hip/hip_runtime.h>
#include <cstdio>
#include <cstdint>

#define DI __device__ __forceinline__
#define GAS __attribute__((address_space(1)))
#define LAS __attribute__((address_space(3)))
typedef unsigned short bf16_t;
typedef short bf16x8 __attribute__((ext_vector_type(8)));
typedef short s16x4 __attribute__((ext_vector_type(4)));
typedef float f32x4 __attribute__((ext_vector_type(4)));
typedef float f32x2 __attribute__((ext_vector_type(2)));
typedef float f32x16 __attribute__((ext_vector_type(16)));
typedef unsigned u32x4 __attribute__((ext_vector_type(4)));
typedef unsigned u32x2 __attribute__((ext_vector_type(2)));
typedef GAS unsigned gu32;
typedef __bf16 bf16x2_t __attribute__((ext_vector_type(2)));
#define RLX_AGENT __ATOMIC_RELAXED, __HIP_MEMORY_SCOPE_AGENT

DI unsigned cvtpk(float lo, float hi) { f32x2 v = {lo, hi}; bf16x2_t b = __builtin_convertvector(v, bf16x2_t); return __builtin_bit_cast(unsigned, b); }
DI float bf2f(bf16_t h) { return __builtin_bit_cast(float, (unsigned)h << 16); }
DI float bflo(unsigned w) { return __builtin_bit_cast(float, w << 16); }
DI float bfhi(unsigned w) { return __builtin_bit_cast(float, w & 0xffff0000u); }

namespace pg8 {
constexpr int BM = 256, BK = 64, HALF = 128, HTB = HALF * BK * 2  , STAGE_BYTES = 8 * HTB, NXCD = 8, WGM = 8;

__host__ __device__ __forceinline__ int lds_byte(int r, int c) { const int st = (r >> 4) * 2 + (c >> 5), rr = r & 15, cc = c & 31, ob = rr * 64 + cc * 2; return st * 1024 + (ob ^ (((ob >> 9) & 1) << 5)); }
__host__ __device__ __forceinline__ void stage_rc(int b, int& R, int& C) { const int st = b / 1024, sb = b % 1024, swz = sb ^ (((sb >> 9) & 1) << 5); R = (st >> 1) * 16 + swz / 64; C = (st & 1) * 32 + (swz % 64) / 2; }
__host__ __device__ __forceinline__ int perm32(int rho) { const int n = rho >> 4, i = rho & 15; return 8 * (i >> 2) + 4 * n + (i & 3); }

struct Unit { int pm, pn, br; };
struct Gemm { const bf16_t* A; const bf16_t* Bt; int M, N, K, lda, ldb; size_t brA = 0, brB = 0; };

struct StaticOrder {
    int nM, nN, nwg, G, c;
    __host__ __device__ __forceinline__ void init(int M, int N, int G_, int c_) { nM = M / BM; nN = N / BM; nwg = nM * nN; G = G_; c = c_; }
    __host__ __device__ __forceinline__ bool next(int i, Unit& u) const {
        const long L = (long)i * G + c; if (L >= nwg) return false;
        int wgid = (int)L; { const int q = nwg / NXCD, r = nwg % NXCD, xcd = wgid % NXCD, off = wgid / NXCD; wgid = (xcd < r ? xcd * (q + 1) : r * (q + 1) + (xcd - r) * q) + off; }
        const int nig = WGM * nN, gid = wgid / nig, fm = gid * WGM, gsz = (nM - fm) < WGM ? (nM - fm) : WGM;
        u.pm = fm + ((wgid % nig) % gsz); u.pn = (wgid % nig) / gsz; u.br = 0; return true;
    }
    __device__ __forceinline__ void a_ready(const Unit&) const {}
    __device__ __forceinline__ void done(const Unit&) const {}
};

struct ChainOrder3 : StaticOrder {
    __host__ __device__ __forceinline__ bool next(int i, Unit& u) const { const int t = i / 3; if (!StaticOrder::next(t, u)) return false; u.br = i - 3 * t; return true; }
};

template <class Epi, class Sched, bool ALIGN_EPI = false>
__device__ __forceinline__ void gemm_phase(LAS unsigned char* lds, const Gemm g, const Sched& S, const Epi& E) {
    int tid = threadIdx.x; asm volatile("" : "+v"(tid));
    const int wid = __builtin_amdgcn_readfirstlane(tid >> 6), lane = tid & 63, wr = wid >> 2, wc = wid & 3, fr = lane & 15, fq = lane >> 4;
    const int K = g.K, nt = K / BK;
    unsigned voffA[2], voffB[2];
#pragma unroll
    for (int i = 0; i < 2; ++i) { int R, C; stage_rc(tid * 16 + i * 8192, R, C); const int Rb = Epi::PERM ? ((R & ~31) + perm32(R & 31)) : R;
        voffA[i] = (unsigned)(R * g.lda + C) * 2u; voffB[i] = (unsigned)(Rb * g.ldb + C) * 2u; }
    const size_t kstep = (size_t)(BK * 2);
    const size_t hstepA = (size_t)HALF * g.lda * 2, hstepB = (size_t)HALF * g.ldb * 2;
    const size_t tstepA = 2 * hstepA, tstepB = 2 * hstepB;
    const unsigned ldsw = (unsigned)wid * 1024u;
    const int aoff = lds_byte(wr * 64 + fr, fq * 8), boff = lds_byte(wc * 32 + fr, fq * 8);
#define PG8_SA(b, h) (((b) * 2 + (h)) * HTB)
#define PG8_SB(b, h) ((4 + (b) * 2 + (h)) * HTB)
#define PG8_STAGE(bufoff, gbase, voff) do { _Pragma("unroll") for (int _i = 0; _i < 2; ++_i) \
        __builtin_amdgcn_global_load_lds((const unsigned*)((const char*)(gbase) + (voff)[_i]), (LAS unsigned*)(lds + (bufoff) + ldsw + _i * 8192), 16, 0, 0); } while (0)
#define PG8_LDA(dst, b, h) do { _Pragma("unroll") for (int m = 0; m < 4; ++m) _Pragma("unroll") for (int k = 0; k < 2; ++k) dst[m][k] = *(const LAS bf16x8*)(lds + PG8_SA(b, h) + aoff + m * 2048 + k * 1024); } while (0)
#define PG8_LDB(dst, b, h) do { _Pragma("unroll") for (int n = 0; n < 2; ++n) _Pragma("unroll") for (int k = 0; k < 2; ++k) dst[n][k] = *(const LAS bf16x8*)(lds + PG8_SB(b, h) + boff + n * 2048 + k * 1024); } while (0)
#define PG8_MMA(ai, bj, At, Bt) do { __builtin_amdgcn_s_setprio(1); _Pragma("unroll") for (int m = 0; m < 4; ++m) _Pragma("unroll") for (int n = 0; n < 2; ++n) _Pragma("unroll") for (int k = 0; k < 2; ++k) \
        acc[ai][bj][m][n] = __builtin_amdgcn_mfma_f32_16x16x32_bf16(Bt[n][k], At[m][k], acc[ai][bj][m][n], 0, 0, 0); __builtin_amdgcn_s_setprio(0); } while (0)
#define PG8_WAIT_V(n) asm volatile("s_waitcnt vmcnt(" #n ")" ::: "memory")
#define PG8_WAIT_L(n) asm volatile("s_waitcnt lgkmcnt(" #n ")" ::: "memory")
#define PG8_BAR __builtin_amdgcn_s_barrier()
#define PG8_SCHED __builtin_amdgcn_sched_barrier(0)
    Unit cur, nxt; int ui = 0;
    if (!S.next(0, cur)) return;
    f32x4 acc[2][2][4][2];
#pragma unroll
    for (int a = 0; a < 2; ++a)
#pragma unroll
        for (int b = 0; b < 2; ++b)
#pragma unroll
            for (int m = 0; m < 4; ++m)
#pragma unroll
                for (int n = 0; n < 2; ++n) acc[a][b][m][n] = (f32x4){0.f, 0.f, 0.f, 0.f};
    bf16x8 At[4][2], B0[2][2], B1[2][2];
    const char* cA = (const char*)g.A + (size_t)cur.pm * tstepA + (size_t)cur.br * g.brA; const char* cB = (const char*)g.Bt + (size_t)cur.pn * tstepB + (size_t)cur.br * g.brB;
    S.a_ready(cur);
    PG8_STAGE(PG8_SB(0, 0), cB, voffB); PG8_STAGE(PG8_SB(0, 1), cB + hstepB, voffB); PG8_STAGE(PG8_SA(0, 0), cA, voffA); PG8_STAGE(PG8_SA(0, 1), cA + hstepA, voffA);
    if (wr == 1) PG8_BAR;
    PG8_WAIT_V(2); PG8_BAR;
    PG8_STAGE(PG8_SB(1, 0), cB + kstep, voffB); PG8_STAGE(PG8_SA(1, 0), cA + kstep, voffA); PG8_STAGE(PG8_SB(1, 1), cB + hstepB + kstep, voffB);
    PG8_WAIT_V(6); PG8_BAR;
    for (;;) {
        const bool has_next = S.next(ui + 1, nxt);
        const char* nA = has_next ? (const char*)g.A + (size_t)nxt.pm * tstepA + (size_t)nxt.br * g.brA : cA; const char* nB = has_next ? (const char*)g.Bt + (size_t)nxt.pn * tstepB + (size_t)nxt.br * g.brB : cB;
#pragma clang loop unroll(disable)
        for (int t = 0; t < nt; t += 2) {
            const bool last = (t == nt - 2);
            const char* a1 = cA + (size_t)(t + 1) * kstep;
            const char* a2 = last ? nA : cA + (size_t)(t + 2) * kstep; const char* b2 = last ? nB : cB + (size_t)(t + 2) * kstep;
            const char* a3 = a2 + kstep; const char* b3 = b2 + kstep;
            if (last && has_next) S.a_ready(nxt);
            PG8_LDB(B0, 0, 0); PG8_LDB(B1, 0, 1); PG8_SCHED; PG8_LDA(At, 0, 0); PG8_STAGE(PG8_SA(1, 1), a1 + hstepA, voffA);
            PG8_WAIT_V(8); PG8_WAIT_L(0); PG8_BAR; PG8_MMA(0, 0, At, B0); PG8_MMA(0, 1, At, B1); PG8_BAR; PG8_SCHED;
            PG8_LDA(At, 0, 1); PG8_STAGE(PG8_SB(0, 0), b2, voffB); PG8_STAGE(PG8_SB(0, 1), b2 + hstepB, voffB); PG8_STAGE(PG8_SA(0, 0), a2, voffA);
            PG8_WAIT_V(8); PG8_WAIT_L(0); PG8_BAR; PG8_MMA(1, 0, At, B0); PG8_MMA(1, 1, At, B1); PG8_BAR; PG8_SCHED;
            PG8_LDB(B0, 1, 0); PG8_LDB(B1, 1, 1); PG8_SCHED; PG8_LDA(At, 1, 0); PG8_STAGE(PG8_SA(0, 1), a2 + hstepA, voffA);
            PG8_WAIT_V(8); PG8_WAIT_L(0); PG8_BAR; PG8_MMA(0, 0, At, B0); PG8_MMA(0, 1, At, B1); PG8_BAR; PG8_SCHED;
            PG8_LDA(At, 1, 1); PG8_STAGE(PG8_SB(1, 0), b3, voffB); PG8_STAGE(PG8_SB(1, 1), b3 + hstepB, voffB); PG8_STAGE(PG8_SA(1, 0), a3, voffA);
            PG8_WAIT_V(8); PG8_WAIT_L(0); PG8_BAR; PG8_MMA(1, 0, At, B0); PG8_MMA(1, 1, At, B1); PG8_BAR; PG8_SCHED;
        }
        if constexpr (ALIGN_EPI) { if (wr == 0) PG8_BAR; }
        E(acc, cur, wr, wc, fr, fq); S.done(cur);
        if (!has_next) break;
#pragma unroll
        for (int a = 0; a < 2; ++a)
#pragma unroll
            for (int b = 0; b < 2; ++b)
#pragma unroll
                for (int m = 0; m < 4; ++m)
#pragma unroll
                    for (int n = 0; n < 2; ++n) acc[a][b][m][n] = (f32x4){0.f, 0.f, 0.f, 0.f};
        cur = nxt; cA = nA; cB = nB; ++ui;
        if constexpr (ALIGN_EPI) { if (wr == 1) PG8_BAR; }
    }
    PG8_WAIT_V(0);
    if constexpr (!ALIGN_EPI) { if (wr == 0) PG8_BAR; }
    PG8_BAR;
#undef PG8_SA
#undef PG8_SB
#undef PG8_STAGE
#undef PG8_LDA
#undef PG8_LDB
#undef PG8_MMA
#undef PG8_WAIT_V
#undef PG8_WAIT_L
#undef PG8_BAR
#undef PG8_SCHED
}
}
constexpr int NB = 8, SQ = 4096, DM = 1024, MT = NB * SQ;
constexpr int DIN = 5200, DINP = 5376, DFF = 2816, NMEM = 256;
constexpr int PAP = 1600;
constexpr int C_QA = 0, C_KA = 256, C_QB = 512, C_QI = 768, C_QC = 1024, C_KB = 1280, C_KI = 1344, C_KSEL = 1472, C_KWIN = 1536;
constexpr float LOG2E = 1.4426950408889634f;
constexpr float C2 = 0.125f * LOG2E;
constexpr float RMS_EPS = 1e-6f;

#define MFMA32(a, b, c) __builtin_amdgcn_mfma_f32_32x32x16_bf16((a), (b), (c), 0, 0, 0)
DI int crow(int i, int hh) { return (i & 3) + 8 * (i >> 2) + 4 * hh; }
DI bf16x8 ldg16(const bf16_t* p) { return *(const GAS bf16x8*)p; }
DI bf16x8 ld_vt(const bf16_t* p) { const s16x4 lo = *(const GAS s16x4*)p, hi = *(const GAS s16x4*)(p + 8); return __builtin_shufflevector(lo, hi, 0, 1, 2, 3, 4, 5, 6, 7); }
DI bf16x8 pack8(const f32x16& x, int s) { u32x4 p; p.x = cvtpk(x[8 * s], x[8 * s + 1]); p.y = cvtpk(x[8 * s + 2], x[8 * s + 3]); p.z = cvtpk(x[8 * s + 4], x[8 * s + 5]); p.w = cvtpk(x[8 * s + 6], x[8 * s + 7]); return __builtin_bit_cast(bf16x8, p); }
DI unsigned shx32u(unsigned v) { auto rr = __builtin_amdgcn_permlane32_swap(v, v, false, false); return (threadIdx.x & 32u) ? rr[0] : rr[1]; }
DI float shx32(float v) { return __uint_as_float(shx32u(__float_as_uint(v))); }
DI f32x16 zero16() { f32x16 z; _Pragma("unroll") for (int i = 0; i < 16; ++i) z[i] = 0.f; return z; }
DI unsigned pull(gu32* ctr, int lane) { unsigned v = 0; if (lane == 0) v = __hip_atomic_fetch_add(ctr, 1u, RLX_AGENT); return (unsigned)__builtin_amdgcn_readfirstlane((int)v); }
DI unsigned bitif(bool c, int i) { unsigned b = c ? 1u : 0u; asm("" : "+v"(b)); return b << i; }
DI float fexp2(float x) { return __builtin_amdgcn_exp2f(x); }
DI float flog2(float x) { return __builtin_amdgcn_logf(x); }

DI f32x16 qk_tile(const bf16_t* kp, const bf16x8 (&qf)[4]) {
    bf16x8 kf[4];
#pragma unroll
    for (int s = 0; s < 4; ++s) kf[s] = ldg16(kp + 16 * s);
    f32x16 z = zero16();
#pragma unroll
    for (int s = 0; s < 4; ++s) z = MFMA32(kf[s], qf[s], z);
    return z;
}
DI void pv_tile(f32x16& o0, f32x16& o1, const bf16_t* vp, size_t vts, const f32x16& p) {
#pragma unroll
    for (int s = 0; s < 2; ++s) {
        const bf16x8 pf = pack8(p, s);
        const bf16x8 v0 = ld_vt(vp + 16 * s), v1 = ld_vt(vp + 32 * vts + 16 * s);
        o0 = MFMA32(v0, pf, o0); o1 = MFMA32(v1, pf, o1);
    }
}
DI void store_ot(bf16_t* orow, const f32x16& o0, const f32x16& o1, float sc, int hh) {
#pragma unroll
    for (int g = 0; g < 4; ++g) {
        u32x2 w0, w1;
        w0.x = cvtpk(o0[4 * g] * sc, o0[4 * g + 1] * sc); w0.y = cvtpk(o0[4 * g + 2] * sc, o0[4 * g + 3] * sc);
        w1.x = cvtpk(o1[4 * g] * sc, o1[4 * g + 1] * sc); w1.y = cvtpk(o1[4 * g + 2] * sc, o1[4 * g + 3] * sc);
        *(GAS u32x2*)(orow + 8 * g + 4 * hh) = w0; *(GAS u32x2*)(orow + 32 + 8 * g + 4 * hh) = w1;
    }
}

struct KV { bf16x8 k[4]; bf16x8 v[4]; };
DI void load_k4(bf16x8 (&k)[4], const bf16_t* kp) {
#pragma unroll
    for (int s = 0; s < 4; ++s) k[s] = ldg16(kp + 16 * s);
}
DI void load_kv(KV& t, const bf16_t* kp, const bf16_t* vp, size_t vts) {
    load_k4(t.k, kp);
#pragma unroll
    for (int s = 0; s < 2; ++s) { t.v[2 * s] = ld_vt(vp + 16 * s); t.v[2 * s + 1] = ld_vt(vp + 32 * vts + 16 * s); }
}
DI f32x16 qk_frag(const bf16x8 (&kf)[4], const bf16x8 (&qf)[4]) {
    f32x16 z = zero16();
#pragma unroll
    for (int s = 0; s < 4; ++s) z = MFMA32(kf[s], qf[s], z);
    return z;
}
DI void pv_frag(f32x16& o0, f32x16& o1, const bf16x8 (&v)[4], const f32x16& p) {
#pragma unroll
    for (int s = 0; s < 2; ++s) { const bf16x8 pf = pack8(p, s); o0 = MFMA32(v[2 * s], pf, o0); o1 = MFMA32(v[2 * s + 1], pf, o1); }
}
constexpr float SM_THR = 10.f;
template <bool MASKED = true> DI void softmax_step(f32x16& z, unsigned vm, float& m, float& l, f32x16& o0, f32x16& o1) {
    const float ninf = -__builtin_inff();
    if (MASKED) {
#pragma unroll
    for (int i = 0; i < 16; ++i) z[i] = ((vm >> i) & 1u) ? z[i] : ninf; }
    float t0 = __builtin_fmaxf(__builtin_fmaxf(z[0], z[1]), z[2]), t1 = __builtin_fmaxf(__builtin_fmaxf(z[3], z[4]), z[5]), t2 = __builtin_fmaxf(__builtin_fmaxf(z[6], z[7]), z[8]),
          t3 = __builtin_fmaxf(__builtin_fmaxf(z[9], z[10]), z[11]), t4 = __builtin_fmaxf(__builtin_fmaxf(z[12], z[13]), z[14]);
    float tm = __builtin_fmaxf(__builtin_fmaxf(__builtin_fmaxf(t0, t1), __builtin_fmaxf(t2, t3)), __builtin_fmaxf(t4, z[15]));
    tm = __builtin_fmaxf(tm, shx32(tm));
    const float mc = __builtin_fmaxf(m, tm);
    if (__any(mc > m + SM_THR)) {
        const float alpha = fexp2(m - mc);
        l *= alpha;
#pragma unroll
        for (int i = 0; i < 16; ++i) { o0[i] *= alpha; o1[i] *= alpha; }
        m = mc;
    }
    float ls = 0.f;
#pragma unroll
    for (int i = 0; i < 16; ++i) { z[i] = fexp2(z[i] - m); ls += z[i]; }
    l += ls;
}
DI float sm_meff(float m) { return m > -1e29f ? m : 0.f; }
DI f32x16 qk_frag_init(const bf16x8 (&kf)[4], const bf16x8 (&qf)[4], const f32x16& init) {
    f32x16 z = init;
#pragma unroll
    for (int s = 0; s < 4; ++s) z = MFMA32(kf[s], qf[s], z);
    return z;
}
DI float max_x32(float v) { auto rr = __builtin_amdgcn_permlane32_swap(__float_as_uint(v), __float_as_uint(v), false, false); return fmaxf(__uint_as_float(rr[0]), __uint_as_float(rr[1])); }
DI float add_x32(float v) { auto rr = __builtin_amdgcn_permlane32_swap(__float_as_uint(v), __float_as_uint(v), false, false); return __uint_as_float(rr[0]) + __uint_as_float(rr[1]); }
DI void softmax_core(f32x16& z, float& m, float& l, f32x16& o0, f32x16& o1) {
    float t0 = __builtin_fmaxf(__builtin_fmaxf(z[0], z[1]), z[2]), t1 = __builtin_fmaxf(__builtin_fmaxf(z[3], z[4]), z[5]), t2 = __builtin_fmaxf(__builtin_fmaxf(z[6], z[7]), z[8]),
          t3 = __builtin_fmaxf(__builtin_fmaxf(z[9], z[10]), z[11]), t4 = __builtin_fmaxf(__builtin_fmaxf(z[12], z[13]), z[14]);
    float tm = __builtin_fmaxf(__builtin_fmaxf(__builtin_fmaxf(t0, t1), __builtin_fmaxf(t2, t3)), __builtin_fmaxf(t4, z[15]));
    tm = max_x32(tm);
    const bool started = m > -1e29f, haskey = tm > -3e38f;
    if (__any(started ? (tm > SM_THR) : haskey)) {
        const float delta = started ? __builtin_fmaxf(tm, 0.f) : (haskey ? tm : 0.f);
        const float alpha = started ? fexp2(-delta) : 1.f;
        l *= alpha;
#pragma unroll
        for (int i = 0; i < 16; ++i) { o0[i] *= alpha; o1[i] *= alpha; z[i] -= delta; }
        m = started ? m + delta : (haskey ? tm : m);
    }
    float ls = 0.f;
#pragma unroll
    for (int i = 0; i < 16; ++i) { z[i] = fexp2(z[i]); ls += z[i]; }
    l += ls;
}
template <bool SKIP, class MaskFn>
DI void attn_tiles(f32x16& o0, f32x16& o1, float& m, float& l, const bf16x8 (&qf)[4], const bf16_t* kbase, size_t kpitch, const bf16_t* vtbase, size_t vts,
                   int kt_lo, int kt_hi, const MaskFn& mask, int r, int hh) {
    const bf16_t* kl = kbase + (size_t)r * kpitch + 8 * hh; const bf16_t* vl = vtbase + (size_t)r * vts + 4 * hh;
    int kt = kt_lo; unsigned vm = 0u;
    if (SKIP) { for (; kt <= kt_hi; ++kt) { vm = mask(kt); if (__any(vm != 0u)) break; } } else { if (kt <= kt_hi) vm = mask(kt); }
    if (kt > kt_hi) return;
    KV cur; load_kv(cur, kl + (size_t)(kt * 32) * kpitch, vl + kt * 32, vts);
    for (;;) {
        int kn = kt + 1; unsigned vmn = 0u;
        if (SKIP) { for (; kn <= kt_hi; ++kn) { vmn = mask(kn); if (__any(vmn != 0u)) break; } } else { if (kn <= kt_hi) vmn = mask(kn); }
        const bool more = kn <= kt_hi;
        KV nxt = cur; if (more) load_kv(nxt, kl + (size_t)(kn * 32) * kpitch, vl + kn * 32, vts);
        f32x16 z = qk_frag(cur.k, qf);
        softmax_step(z, vm, m, l, o0, o1);
        pv_frag(o0, o1, cur.v, z);
        if (!more) break;
        cur = nxt; vm = vmn; kt = kn;
    }
}
DI void load_q(bf16x8 (&qf)[4], const bf16_t* qp) {
#pragma unroll
    for (int s = 0; s < 4; ++s) qf[s] = ldg16(qp + 16 * s);
}

constexpr size_t MiB = 1u << 20;
constexpr size_t WS_CTL = 0, CTL_ZERO_BYTES = 2 * MiB;
constexpr size_t WS_ROPE = 2 * MiB, WS_WG = 3 * MiB, WS_TAU = 5 * MiB, WS_RR = WS_TAU + 128 * 1024, WS_BM = WS_TAU + 256 * 1024, WS_BIAS1 = WS_TAU + 512 * 1024;
constexpr size_t WS_KC = 6 * MiB, WS_VCT = WS_KC + 256 * 1024, WS_HID = WS_KC + 512 * 1024;
constexpr size_t WS_MEMB = 9 * MiB, WS_KMEM = 13 * MiB, WS_VMEMT = 15 * MiB;
constexpr size_t WS_KCMP = 17 * MiB, WS_VCMP = 21 * MiB;
constexpr size_t WS_VAT = 26 * MiB, WS_VBT = 42 * MiB, WS_VST = 46 * MiB, WS_VWT = 50 * MiB;
constexpr size_t WS_WIN = 54 * MiB, WS_WFI = 75 * MiB, WS_WFO = 97 * MiB, WS_WOUT = 108 * MiB, WS_WUP = 112 * MiB, WS_WMQ = 115 * MiB, WS_WMKV = 116 * MiB, WS_WMO = 118 * MiB,
                 WS_WC1 = 119 * MiB, WS_WC2 = 121 * MiB;
constexpr size_t WS_HB = 122 * MiB;
constexpr size_t WS_PA = 186 * MiB;
constexpr size_t WS_PG = 286 * MiB;
constexpr size_t WS_END = 478 * MiB;
static_assert(WS_VCMP == WS_KCMP + (size_t)MT * 64 * 2, "compact cmp buffers must be adjacent");
static_assert(WS_PA + (size_t)MT * PAP * 2 <= WS_PG && WS_PG + (size_t)MT * 3072 * 2 <= WS_END && WS_HB + 64 * MiB <= WS_PA, "ws map");
static_assert(WS_WIN + (size_t)2 * DINP * 1024 * 2 <= WS_WFI && WS_WFI + (size_t)2 * 5632 * 1024 * 2 <= WS_WFO && WS_WFO + (size_t)2 * 1024 * DFF * 2 <= WS_WOUT, "weights map");
constexpr int CW_TMO = 0, CW_BAR = 4096, CW_Q = 8192, CW_SS = 32768, CW_SSM = CW_SS + 7 * MT, CW_Q2 = CW_SSM + 2048;
static_assert((size_t)(CW_Q2 + 32 * 4 * 8 * 64) * 4 <= CTL_ZERO_BYTES, "ctl region");
struct Bufs {
    const float* in[21]; float* o_; unsigned char* ws;
#define BIN(name, idx) DI const float* name() const { return in[idx]; }
    BIN(x, 0) BIN(mem, 1) BIN(norm_mix, 2) BIN(w_in, 3) BIN(cmp_pos_k, 4) BIN(cmp_w1_k, 5) BIN(cmp_w2_k, 6) BIN(cmp_pos_v, 7) BIN(cmp_w1_v, 8) BIN(cmp_w2_v, 9) BIN(w_up, 10) BIN(w_out, 11)
    BIN(norm_mem_q, 12) BIN(norm_mem_kv, 13) BIN(w_mem_q, 14) BIN(w_mem_kv, 15) BIN(w_mem_o, 16) BIN(norm_ffn, 17) BIN(w_ffn_in, 18) BIN(w_ffn_out, 19) BIN(norm_final, 20)
#undef BIN
#define BWS(type, name, off) DI type* name() const { return (type*)(ws + (off)); }
    DI float* out() const { return o_; }
    DI gu32* ctl() const { return (gu32*)(ws + WS_CTL); }
    BWS(float, ss, WS_CTL + (size_t)CW_SS * 4) BWS(float, ssm, WS_CTL + (size_t)CW_SSM * 4)
    BWS(f32x2, rope, WS_ROPE) BWS(float, WG, WS_WG) BWS(unsigned, TAU, WS_TAU) BWS(unsigned, RR, WS_RR) BWS(unsigned long long, BM, WS_BM) BWS(float, BIAS1, WS_BIAS1)
    BWS(bf16_t, KC, WS_KC) BWS(bf16_t, VCT, WS_VCT) BWS(bf16_t, HID, WS_HID) BWS(bf16_t, MEMB, WS_MEMB) BWS(bf16_t, KMEM, WS_KMEM) BWS(bf16_t, VMEMT, WS_VMEMT)
    BWS(bf16_t, KCMP, WS_KCMP) BWS(bf16_t, VCMP, WS_VCMP) BWS(bf16_t, VAT, WS_VAT) BWS(bf16_t, VBT, WS_VBT) BWS(bf16_t, VST, WS_VST) BWS(bf16_t, VWT, WS_VWT)
    BWS(bf16_t, WIN, WS_WIN) BWS(bf16_t, WFI, WS_WFI) BWS(bf16_t, WFO, WS_WFO) BWS(bf16_t, WOUT, WS_WOUT) BWS(bf16_t, WUP, WS_WUP) BWS(bf16_t, WMQ, WS_WMQ)
    BWS(bf16_t, WMKV, WS_WMKV) BWS(bf16_t, WMO, WS_WMO) BWS(bf16_t, WC1, WS_WC1) BWS(bf16_t, WC2, WS_WC2)
    BWS(bf16_t, HB, WS_HB) BWS(bf16_t, O3, WS_HB) BWS(unsigned short, MB, WS_HB + 48 * MiB)
    BWS(bf16_t, PA, WS_PA) BWS(bf16_t, MG, WS_PA) BWS(bf16_t, QM, WS_PA + 64 * MiB) BWS(bf16_t, OM, WS_PA + 80 * MiB)
    BWS(bf16_t, PG, WS_PG) BWS(bf16_t, ACT, WS_PG)
#undef BWS
};

DI void sb_unit(const Bufs& P, int b, int h, int qb, int lane) {
    const int r = lane & 31, hh = lane >> 5, q0 = qb * 32, tq = q0 + r;
    const size_t row = (size_t)b * SQ + tq;
    bf16x8 qf[4]; load_q(qf, P.PA() + row * PAP + C_QA + h * 64 + 8 * hh);
    f32x16 o0 = zero16(), o1 = zero16();
    float R = 0.f;
    const bf16_t* kb = P.PA() + ((size_t)b * SQ + r) * PAP + C_KA + h * 64 + 8 * hh;
    const bf16_t* vb = P.VAT() + ((size_t)(b * 4 + h) * 64 + r) * SQ + 4 * hh;
    KV cur; load_kv(cur, kb + (size_t)(qb * 32) * PAP, vb + qb * 32, SQ);
    for (int kt = qb; kt >= 0; --kt) {
        const int k0 = kt * 32;
        KV nxt = cur; if (kt > 0) load_kv(nxt, kb + (size_t)(k0 - 32) * PAP, vb + k0 - 32, SQ);
        f32x16 z = qk_frag(cur.k, qf);
        float Lg[16];
#pragma unroll
        for (int i = 0; i < 16; ++i) {
            const bool valid = (k0 + crow(i, hh)) < tq;
            const float zz = z[i], sp = fmaxf(zz, 0.f) + 0.6931471805599453f * flog2(1.f + fexp2(-fabsf(zz) * LOG2E));
            Lg[i] = valid ? -sp : 0.f;
        }
        float T[4];
#pragma unroll
        for (int g = 0; g < 4; ++g) { Lg[4 * g + 2] += Lg[4 * g + 3]; Lg[4 * g + 1] += Lg[4 * g + 2]; Lg[4 * g] += Lg[4 * g + 1]; T[g] = Lg[4 * g]; }
        float PT[4];
#pragma unroll
        for (int g = 0; g < 4; ++g) PT[g] = shx32(T[g]);
        float above = R;
#pragma unroll
        for (int g = 3; g >= 0; --g) {
            const float ab = above + (hh == 0 ? PT[g] : 0.f);
#pragma unroll
            for (int e = 0; e < 4; ++e) {
                const int i = 4 * g + e; const bool valid = (k0 + crow(i, hh)) < tq;
                z[i] = valid ? fexp2((z[i] + Lg[i] + ab) * LOG2E) : 0.f;
            }
            above += T[g] + PT[g];
        }
        R = above;
        pv_frag(o0, o1, cur.v, z);
        if (__all(R < -60.f)) break;
        cur = nxt;
    }
    store_ot(P.O3() + row * 768 + h * 64, o0, o1, 1.f, hh);
}

DI unsigned mono_key(float s) { const unsigned u = __builtin_bit_cast(unsigned, s + 0.0f); return u ^ ((unsigned)((int)u >> 31) | 0x80000000u); }
DI float mono_inv(unsigned k) { const unsigned u = (k & 0x80000000u) ? (k ^ 0x80000000u) : ~k; return __builtin_bit_cast(float, u); }
DI float mono_inv_hi(unsigned k) { if (k == 0x7fffffffu) return __builtin_bit_cast(float, 0x80000001u); const float f = mono_inv(k); return (f != f) ? ((k & 0x80000000u) ? __builtin_inff() : -__builtin_inff()) : f; }
DI float relu_f(float x) { return __builtin_amdgcn_fmed3f(x, 0.f, __builtin_inff()); }
DI void idx_tile(float (&sc)[16], const bf16x8 (&kf)[4], const bf16x8 (&qi)[4][4], const float (&w)[4]) {
#pragma unroll
    for (int hd = 0; hd < 4; ++hd) {
        f32x16 z = zero16();
#pragma unroll
        for (int s = 0; s < 4; ++s) z = MFMA32(kf[s], qi[hd][s], z);
#pragma unroll
        for (int i = 0; i < 16; ++i) { const float rl = relu_f(z[i]); sc[i] = (hd == 0) ? w[0] * rl : __builtin_fmaf(w[hd], rl, sc[i]); }
    }
}

constexpr int KT_SLICE = 32 * 144;
DI void ktile_issue(u32x4 (&rg)[4], const bf16_t* kcol  , int k0, int lane) {
    const bf16_t* p = kcol + (size_t)(k0 + (lane >> 3)) * PAP + (lane & 7) * 8;
#pragma unroll
    for (int i = 0; i < 4; ++i) rg[i] = *(const GAS u32x4*)(p + (size_t)(8 * i) * PAP);
}
DI void ktile_commit(LAS unsigned char* slice, const u32x4 (&rg)[4], int lane) {
    LAS unsigned char* p = slice + (lane >> 3) * 144 + (lane & 7) * 16;
#pragma unroll
    for (int i = 0; i < 4; ++i) *(LAS u32x4*)(p + i * 8 * 144) = rg[i];
}
DI void ktile_frags(bf16x8 (&kf)[4], const LAS unsigned char* slice, int lane) {
    const LAS unsigned char* p = slice + (lane & 31) * 144 + (lane >> 5) * 16;
#pragma unroll
    for (int s2 = 0; s2 < 4; ++s2) kf[s2] = *(const LAS bf16x8*)(p + s2 * 32);
}
constexpr int HROW = 132;
constexpr int HWAVE = 32 * HROW * 4;
constexpr int DS_CAP = 64;
constexpr int DS_OFF_KSL = 4 * HWAVE, DS_OFF_FLAG = DS_OFF_KSL + 8 * KT_SLICE, DS_OFF_CNT = DS_OFF_FLAG + 512, DS_OFF_CAND = DS_OFF_CNT + 128, DS_LDS_END = DS_OFF_CAND + 32 * DS_CAP * 8;
template <int EXPT = 0, class F> DI void ds_tile_pass(const bf16_t* kcol, LAS unsigned char* kslice, int qb, int wave, int lane, const bf16x8 (&qi)[4][4], const float (&w)[4], const F& f) {
    if (wave > qb) return;
    u32x4 rg[4]; ktile_issue(rg, kcol, wave * 32, lane); ktile_commit(kslice, rg, lane);
    for (int kt = wave; kt <= qb; kt += 8) {
        const int k0 = kt * 32;
        bf16x8 kf[4]; ktile_frags(kf, kslice, lane);
        if (EXPT != 13 && kt + 8 <= qb) ktile_issue(rg, kcol, k0 + 256, lane);
        float sc[16]; if (EXPT == 12) { _Pragma("unroll") for (int i = 0; i < 16; ++i) sc[i] = __builtin_bit_cast(float, (int)kf[i & 3][i >> 2] << 16); } else idx_tile(sc, kf, qi, w);
        f(kt, k0, sc);
        if (EXPT != 13 && kt + 8 <= qb) ktile_commit(kslice, rg, lane);
    }
}
template <int EXP = 0, int CHK = 0> DI void dsa_select_wg(const Bufs& P, int b, int qb, int lane, int wave, LAS unsigned* hist4) {
    const int r = lane & 31, hh = lane >> 5, q0 = qb * 32, tq = q0 + r;
    const size_t row = (size_t)b * SQ + tq;
    const bool takeall = (tq + 1) <= 256;
    bf16x8 qi[4][4];
#pragma unroll
    for (int hd = 0; hd < 4; ++hd) load_q(qi[hd], P.PA() + row * PAP + C_QI + hd * 64 + 8 * hh);
    float w[4]; { const f32x4 wv = *(const GAS f32x4*)(P.WG() + row * 16); w[0] = wv.x; w[1] = wv.y; w[2] = wv.z; w[3] = wv.w; }
    LAS unsigned char* const base = (LAS unsigned char*)hist4;
    { LAS unsigned* z = hist4 + wave * 2112 + lane;
#pragma unroll
      for (int j = 0; j < 33; ++j) z[64 * j] = 0u; }
    LAS unsigned* const tieflag = (LAS unsigned*)(base + DS_OFF_FLAG);
    LAS unsigned* const chk = tieflag + 4;
    LAS unsigned* const ccnt_l = (LAS unsigned*)(base + DS_OFF_CNT);
    LAS unsigned* const cand = (LAS unsigned*)(base + DS_OFF_CAND);
    if (wave == 0) { if (lane == 0) *tieflag = 0u; if (lane < 32) { ccnt_l[lane] = 0u; if (CHK) { chk[3 * lane] = 0xffffffffu; chk[3 * lane + 1] = 0u; chk[3 * lane + 2] = 0u; } } }
    __syncthreads();
    unsigned prefix = 0u, krem = (CHK == 2) ? 255u : 256u, bc = 0u; int npass = 0; bool early = false;
    const bf16_t* kcol = P.PA() + (size_t)b * SQ * PAP + C_KI;
    LAS unsigned char* kslice = base + DS_OFF_KSL + wave * KT_SLICE;
    LAS unsigned* const mk = hist4;
    unsigned short* const mbp = (EXP >= 10 ? (unsigned short*)P.out() : P.MB()) + ((size_t)(b * 128 + qb) * 128) * 64 + lane;
    const unsigned sq = (unsigned)r >> 3;
    auto hist_pass = [&](int pass) -> bool {
        const int sh_d = 24 - 8 * pass, sh_p = (32 - 8 * pass) & 31;
        const unsigned klo = pass == 0 ? 0u : (prefix << sh_p), khi = pass == 0 ? 0xffffffffu : (klo | ((1u << sh_p) - 1u));
        float flo = mono_inv(klo); const float fhi = mono_inv_hi(khi);
        if (flo != flo) flo = -__builtin_inff();
        LAS unsigned* hrow = hist4 + pass * (32 * HROW) + r * HROW;
        ds_tile_pass<EXP>(kcol, kslice, qb, wave, lane, qi, w, [&](int kt, int k0, const float (&sc)[16]) {
            (void)kt;
            if (pass == 0) {
#pragma unroll
                for (int i = 0; i < 16; ++i) {
                    const unsigned d = mono_key(sc[i]) >> 24;
                    const unsigned val = ((k0 + crow(i, hh)) <= tq) ? (1u << (16 * (d & 1u))) : 0u;
                    if (EXP == 14) { if (lane & 1) __hip_atomic_fetch_add(hrow + ((d >> 1) ^ sq), val, __ATOMIC_RELAXED, __HIP_MEMORY_SCOPE_WORKGROUP); }
                    else if (EXP == 15) { if (i & 1) __hip_atomic_fetch_add(hrow + ((d >> 1) ^ sq), val, __ATOMIC_RELAXED, __HIP_MEMORY_SCOPE_WORKGROUP); else asm volatile("" :: "v"(val), "v"(d)); }
                    else if (EXP != 1 && EXP != 11) __hip_atomic_fetch_add(hrow + ((d >> 1) ^ sq), val, __ATOMIC_RELAXED, __HIP_MEMORY_SCOPE_WORKGROUP); else asm volatile("" :: "v"(val), "v"(d));
                }
            } else {
#pragma unroll
                for (int i = 0; i < 16; ++i) {
                    const bool ok = ((k0 + crow(i, hh)) <= tq) && sc[i] >= flo && sc[i] <= fhi;
                    if (ok) { const unsigned d = (mono_key(sc[i]) >> sh_d) & 255u;
                        __hip_atomic_fetch_add(hrow + ((d >> 1) ^ sq), 1u << (16 * (d & 1u)), __ATOMIC_RELAXED, __HIP_MEMORY_SCOPE_WORKGROUP); }
                }
            }
        });
        __syncthreads();
        LAS unsigned* hhalf = hrow + 64 * hh;
        unsigned gs[16], tot = 0u;
#pragma unroll
        for (int j = 0; j < 16; ++j) { const u32x4 x = *(LAS u32x4*)(hhalf + 4 * j);
            gs[j] = ((x.x & 0xffffu) + (x.x >> 16)) + ((x.y & 0xffffu) + (x.y >> 16)) + ((x.z & 0xffffu) + (x.z >> 16)) + ((x.w & 0xffffu) + (x.w >> 16)); tot += gs[j]; }
        const unsigned oth = shx32u(tot), U = hh ? tot : oth;
        const bool mine = hh ? (krem <= U) : (krem > U);
        const unsigned target = hh ? krem : krem - U;
        unsigned cum = 0u; int fj = -1;
#pragma unroll
        for (int j = 15; j >= 0; --j) { const bool hit = (fj < 0) && (cum + gs[j] >= target); fj = hit ? j : fj; cum += (fj < 0) ? gs[j] : 0u; }
        u32x4 xg = *(LAS u32x4*)(hhalf + 4 * (fj < 0 ? 0 : fj));
        if (sq & 1u) xg = (u32x4){xg.y, xg.x, xg.w, xg.z};
        if (sq & 2u) xg = (u32x4){xg.z, xg.w, xg.x, xg.y};
        unsigned above = 0u, binc = 0u; int found = -1;
#pragma unroll
        for (int wi = 3; wi >= 0; --wi) { const unsigned x = xg[wi], hi = x >> 16, lo = x & 0xffffu;
            { const bool hit = (found < 0) && (cum + hi >= target); if (hit) { found = 2 * wi + 1; above = cum; binc = hi; } cum += (found < 0) ? hi : 0u; }
            { const bool hit = (found < 0) && (cum + lo >= target); if (hit) { found = 2 * wi; above = cum; binc = lo; } cum += (found < 0) ? lo : 0u; } }
        const bool okf = (fj >= 0) && (found >= 0);
        unsigned dm = (okf ? (unsigned)(8 * fj + found) : 0u) + 128u * hh, am = (okf ? above : 0u) + (hh ? 0u : U);
        const unsigned d_o = shx32u(dm), a_o = shx32u(am), b_o = shx32u(binc);
        const unsigned dig = mine ? dm : d_o, abv = mine ? am : a_o;
        bc = mine ? binc : b_o;
        krem -= abv; prefix = (prefix << 8) | dig; npass = pass + 1;
        return pass < 3 && __all(bc == krem || takeall);
    };
    early = hist_pass(0);
    if (!early && EXP != 3) early = hist_pass(1);
    const bool collect = !early && (EXP == 0 || EXP >= 10) && __all(bc <= (unsigned)DS_CAP || takeall);
    unsigned tau = 0u, rr = 0u;
    if (collect) {
        const unsigned klo = prefix << 16, khi = klo | 0xffffu;
        float flo = mono_inv(klo); const float fhi = mono_inv_hi(khi);
        if (flo != flo) flo = -__builtin_inff();
        __syncthreads();
        ds_tile_pass<EXP>(kcol, kslice, qb, wave, lane, qi, w, [&](int kt, int k0, const float (&sc)[16]) {
            unsigned gt = 0u;
#pragma unroll
            for (int i = 0; i < 16; ++i) {
                const bool valid = (k0 + crow(i, hh)) <= tq;
                gt |= bitif(valid && (takeall || sc[i] > fhi), i);
                if (valid && !takeall && sc[i] >= flo && sc[i] <= fhi) {
                    const unsigned slot = __hip_atomic_fetch_add(ccnt_l + r, 1u, __ATOMIC_RELAXED, __HIP_MEMORY_SCOPE_WORKGROUP);
                    if (slot < (unsigned)DS_CAP) { cand[(r * DS_CAP + slot) * 2] = mono_key(sc[i]); cand[(r * DS_CAP + slot) * 2 + 1] = (unsigned)(kt * 1024 + lane * 16 + i); }
                }
            }
            mk[kt * 64 + lane] = gt;
        });
        __syncthreads();
        {
            const int qq = wave * 4 + (lane >> 4), j16 = lane & 15;
            const unsigned need = (unsigned)__shfl((int)krem, qq & 31), tk = (unsigned)__shfl((int)(takeall ? 1u : 0u), qq & 31);
            const unsigned cnt = tk ? 0u : (ccnt_l[qq] < (unsigned)DS_CAP ? ccnt_l[qq] : (unsigned)DS_CAP);
            const LAS unsigned* cl = cand + qq * DS_CAP * 2;
            unsigned cmaxn = cnt;
#pragma unroll
            for (int o = 16; o < 64; o <<= 1) { const unsigned t2 = (unsigned)__shfl_xor((int)cmaxn, o); cmaxn = t2 > cmaxn ? t2 : cmaxn; }
            unsigned mykey[4], mypos[4], rank[4];
#pragma unroll
            for (int c = 0; c < 4; ++c) { const unsigned sidx = j16 + 16 * c; const bool have = sidx < cnt; mykey[c] = have ? cl[2 * sidx] : 0u; mypos[c] = have ? cl[2 * sidx + 1] : 0u; rank[c] = 0u; }
            for (unsigned j2 = 0; j2 < cmaxn; ++j2) {
                const bool in = j2 < cnt;
                const unsigned k2 = in ? cl[2 * j2] : 0u, p2 = in ? cl[2 * j2 + 1] : 0u;
                const unsigned i2 = (p2 >> 10) * 32u + (unsigned)crow((int)(p2 & 15u), (int)((p2 >> 9) & 1u));
#pragma unroll
                for (int c = 0; c < 4; ++c) { const unsigned ic = (mypos[c] >> 10) * 32u + (unsigned)crow((int)(mypos[c] & 15u), (int)((mypos[c] >> 9) & 1u));
                    rank[c] += (in && (k2 > mykey[c] || (k2 == mykey[c] && i2 < ic))) ? 1u : 0u; }
            }
#pragma unroll
            for (int c = 0; c < 4; ++c) { const unsigned sidx = j16 + 16 * c;
                if (sidx < cnt && rank[c] < need) __hip_atomic_fetch_or(mk + (mypos[c] >> 4), 1u << (mypos[c] & 15u), __ATOMIC_RELAXED, __HIP_MEMORY_SCOPE_WORKGROUP); }
        }
        __syncthreads();
        if (wave <= qb) for (int kt = wave; kt <= qb; kt += 8) mbp[(size_t)kt * 64] = (unsigned short)mk[kt * 64 + lane];
    } else {
        if (!early && EXP != 3) { early = hist_pass(2); if (!early) (void)hist_pass(3); }
        if (takeall) { tau = 0u; rr = 0xffffffffu; }
        else if (early) { tau = (prefix << (32 - 8 * npass)) - 1u; rr = 0u; }
        else { tau = prefix; rr = krem; }
        if (EXP != 0) { asm volatile("" :: "v"(tau), "v"(rr)); __syncthreads(); return; }
        const float tauf = mono_inv_hi(tau);
        __syncthreads();
        unsigned anyeq = 0u;
        ds_tile_pass<EXP>(kcol, kslice, qb, wave, lane, qi, w, [&](int kt, int k0, const float (&sc)[16]) {
            unsigned gt = 0u, eq = 0u;
#pragma unroll
            for (int i = 0; i < 16; ++i) { const bool valid = (k0 + crow(i, hh)) <= tq; gt |= bitif(valid && sc[i] > tauf, i); eq |= bitif(valid && sc[i] == tauf, i); }
            mbp[(size_t)kt * 64] = (unsigned short)gt;
            mk[kt * 64 + lane] = gt | (eq << 16);
            anyeq |= eq;
        });
        if (__any(anyeq != 0u && rr != 0u)) { if (lane == 0) __hip_atomic_fetch_or(tieflag, 1u, __ATOMIC_RELAXED, __HIP_MEMORY_SCOPE_WORKGROUP); }
        __syncthreads();
        if (*tieflag != 0u && wave == 0) {
            unsigned run = 0u;
            for (int kt = 0; kt <= qb; ++kt) {
                const unsigned wd = mk[kt * 64 + lane], gt = wd & 0xffffu, eq = wd >> 16;
                if (__any(eq != 0u)) {
                    unsigned cg[4], pk = 0u;
#pragma unroll
                    for (int g = 0; g < 4; ++g) { cg[g] = __builtin_popcount((eq >> (4 * g)) & 15u); pk |= cg[g] << (8 * g); }
                    const unsigned opk = shx32u(pk);
                    unsigned bs = run, bits = gt;
#pragma unroll
                    for (int g = 0; g < 4; ++g) {
                        const unsigned og = (opk >> (8 * g)) & 255u;
                        unsigned ord = bs + (hh ? og : 0u);
#pragma unroll
                        for (int e = 0; e < 4; ++e) { const int i = 4 * g + e; const unsigned ei = (eq >> i) & 1u; bits |= bitif(ei && ord < rr, i); ord += ei; }
                        bs += cg[g] + og;
                    }
                    run = bs;
                    mbp[(size_t)kt * 64] = (unsigned short)bits;
                    mk[kt * 64 + lane] = bits;
                } else mk[kt * 64 + lane] = gt;
            }
        }
    }
    __syncthreads();
    if (CHK) {
        unsigned cmin = 0xffffffffu, cmax = 0u, ccnt = 0u;
        asm volatile("s_waitcnt vmcnt(0)" ::: "memory");
        ds_tile_pass<EXP>(kcol, kslice, qb, wave, lane, qi, w, [&](int kt, int k0, const float (&sc)[16]) {
            const unsigned bits = (unsigned)__builtin_nontemporal_load(mbp + (size_t)kt * 64);
#pragma unroll
            for (int i = 0; i < 16; ++i) { const bool valid = (k0 + crow(i, hh)) <= tq; const unsigned uk = mono_key(sc[i]);
                if ((bits >> i) & 1u) cmin = uk < cmin ? uk : cmin; else if (valid) cmax = uk > cmax ? uk : cmax; }
            ccnt += __builtin_popcount(bits);
        });
        __hip_atomic_fetch_min(chk + 3 * r, cmin, __ATOMIC_RELAXED, __HIP_MEMORY_SCOPE_WORKGROUP); __hip_atomic_fetch_max(chk + 3 * r + 1, cmax, __ATOMIC_RELAXED, __HIP_MEMORY_SCOPE_WORKGROUP);
        __hip_atomic_fetch_add(chk + 3 * r + 2, ccnt, __ATOMIC_RELAXED, __HIP_MEMORY_SCOPE_WORKGROUP);
        __syncthreads();
        if (wave == 1 && hh == 0) { const unsigned want = (unsigned)((tq + 1) < 256 ? (tq + 1) : 256);
            const bool bad = (chk[3 * r + 2] != want) || (chk[3 * r] < chk[3 * r + 1]);
            if (bad) __hip_atomic_fetch_or((gu32*)P.ctl() + 2, 1u, RLX_AGENT); }
        __syncthreads();
    }
}
DI void dsa_mask_unit(const Bufs& P, int b, int qb, int lane, LAS unsigned char* kslice) {
    const int r = lane & 31, hh = lane >> 5, q0 = qb * 32, tq = q0 + r;
    const size_t row = (size_t)b * SQ + tq;
    bf16x8 qi[4][4];
#pragma unroll
    for (int hd = 0; hd < 4; ++hd) load_q(qi[hd], P.PA() + row * PAP + C_QI + hd * 64 + 8 * hh);
    float w[4]; { const f32x4 wv = *(const GAS f32x4*)(P.WG() + row * 16); w[0] = wv.x; w[1] = wv.y; w[2] = wv.z; w[3] = wv.w; }
    const unsigned tau = P.TAU()[row], rr = P.RR()[row];
    float tauf = mono_inv(tau); if (tauf != tauf) tauf = -__builtin_inff();
    unsigned run = 0u;
    const bf16_t* kcol = P.PA() + (size_t)b * SQ * PAP + C_KI;
    unsigned short* mb = P.MB() + ((size_t)(b * 128 + qb) * 128) * 64 + lane;
    u32x4 rg[4]; ktile_issue(rg, kcol, 0, lane); ktile_commit(kslice, rg, lane);
    for (int kt = 0; kt <= qb; ++kt) {
        const int k0 = kt * 32;
        bf16x8 kf[4]; ktile_frags(kf, kslice, lane);
        if (kt < qb) ktile_issue(rg, kcol, k0 + 32, lane);
        float sc[16]; idx_tile(sc, kf, qi, w);
        if (kt < qb) ktile_commit(kslice, rg, lane);
        unsigned gt = 0u, eq = 0u;
#pragma unroll
        for (int i = 0; i < 16; ++i) {
            const bool valid = (k0 + crow(i, hh)) <= tq;
            gt |= bitif(valid && sc[i] > tauf, i); eq |= bitif(valid && sc[i] == tauf, i);
        }
        unsigned bits = gt;
        if (__any(eq != 0u)) {
        unsigned cg[4], pk = 0u;
#pragma unroll
        for (int g = 0; g < 4; ++g) { cg[g] = __builtin_popcount((eq >> (4 * g)) & 15u); pk |= cg[g] << (8 * g); }
        const unsigned opk = shx32u(pk);
        unsigned base = run;
#pragma unroll
        for (int g = 0; g < 4; ++g) {
            const unsigned og = (opk >> (8 * g)) & 255u;
            unsigned ord = base + (hh ? og : 0u);
#pragma unroll
            for (int e = 0; e < 4; ++e) { const int i = 4 * g + e; const unsigned ei = (eq >> i) & 1u; bits |= bitif(ei && ord < rr, i); ord += ei; }
            base += cg[g] + og;
        }
        run = base;
        }
        mb[(size_t)kt * 64] = (unsigned short)bits;
    }
}
DI void dsa_attn_unit(const Bufs& P, int b, int h, int qb, int lane) {
    const int r = lane & 31, hh = lane >> 5, q0 = qb * 32;
    const size_t row = (size_t)b * SQ + q0 + r;
    bf16x8 qf[4]; load_q(qf, P.PA() + row * PAP + C_QB + h * 64 + 8 * hh);
    f32x16 o0 = zero16(), o1 = zero16(); float m = -1e30f, l = 0.f;
    const unsigned short* mb = P.MB() + ((size_t)(b * 128 + qb) * 128) * 64 + lane;
    auto mask = [&](int kt) -> unsigned { return (unsigned)mb[(size_t)kt * 64]; };
    attn_tiles<false>(o0, o1, m, l, qf, P.PA() + (size_t)b * SQ * PAP + C_KB, PAP, P.VBT() + (size_t)b * 64 * SQ, SQ, 0, qb, mask, r, hh);
    const float lt = l + shx32(l), inv = lt > 0.f ? 1.f / lt : 0.f;
    store_ot(P.O3() + row * 768 + 256 + h * 64, o0, o1, inv, hh);
}


template <int MODE>
DI void dsa_attn_probe(const Bufs& P, int b, int h, int qb, int lane) {
    const int r = lane & 31, hh = lane >> 5, q0 = qb * 32;
    const size_t row = (size_t)b * SQ + q0 + r;
    bf16x8 qf[4]; load_q(qf, P.PA() + row * PAP + C_QB + h * 64 + 8 * hh);
    f32x16 o0 = zero16(), o1 = zero16(); float m = -1e30f, l = 0.f;
    const unsigned short* mb = P.MB() + ((size_t)(b * 128 + qb) * 128) * 64 + lane;
    const bf16_t* kl = P.PA() + (size_t)b * SQ * PAP + C_KB + (size_t)r * PAP + 8 * hh; const bf16_t* vl = P.VBT() + (size_t)b * 64 * SQ + (size_t)r * SQ + 4 * hh;
    if (MODE == 1) {
        bf16x8 acc = qf[0];
        for (int kt = 0; kt <= qb; ++kt) { KV t; load_kv(t, kl + (size_t)(kt * 32) * PAP, vl + kt * 32, SQ); const unsigned vm = mb[(size_t)kt * 64];
#pragma unroll
            for (int j = 0; j < 4; ++j) acc = acc ^ t.k[j] ^ t.v[j]; acc[0] ^= (short)vm; }
        o0[0] = (float)acc[0] + (float)acc[1] + (float)acc[2] + (float)acc[3] + (float)acc[4] + (float)acc[5] + (float)acc[6] + (float)acc[7];
    } else {
        auto mask = [&](int kt) -> unsigned { return (unsigned)mb[0]; };
        attn_tiles<false>(o0, o1, m, l, qf, P.PA() + (size_t)b * SQ * PAP + C_KB, 0, P.VBT() + (size_t)b * 64 * SQ, SQ, 0, qb, mask, r, hh);
    }
    const float lt = l + shx32(l), inv = lt > 0.f ? 1.f / lt : 0.f;
    store_ot((bf16_t*)P.out() + row * 768 + 256 + h * 64, o0, o1, inv, hh);
}
template <int CHK = 0> DI void nsa_cmp_unit(const Bufs& P, int b, int qb, int lane, LAS float* impl) {
    const int r = lane & 31, hh = lane >> 5, q0 = qb * 32, tq = q0 + r;
    const size_t row = (size_t)b * SQ + tq;
    const bf16_t* kcb = P.KC() + (size_t)b * 256 * 64 + 8 * hh;
    const bf16_t* vcb = P.VCT() + ((size_t)b * 64 + r) * 256 + 4 * hh;
    const int cmax = (tq >= 31) ? ((tq - 31) >> 4) : -1;
    const int ctile_hi = qb >> 4;
    LAS float* imp = impl + lane;
#pragma unroll
    for (int a = 0; a < 32; ++a) imp[64 * a] = 0.f;
    for (int h = 0; h < 4; ++h) {
        bf16x8 qf[4]; load_q(qf, P.PA() + row * PAP + C_QC + h * 64 + 8 * hh);
        float m = -1e30f, l = 0.f;
        for (int kt = 0; kt <= ctile_hi; ++kt) {
            const int k0 = kt * 32;
            const f32x16 z = qk_tile(kcb + (size_t)(k0 + r) * 64, qf);
            float tm = -1e30f;
#pragma unroll
            for (int i = 0; i < 16; ++i) tm = ((k0 + crow(i, hh)) <= cmax) ? fmaxf(tm, z[i]) : tm;
            tm = fmaxf(tm, shx32(tm));
            const float mn = fmaxf(m, tm); float ls = 0.f;
#pragma unroll
            for (int i = 0; i < 16; ++i) ls += ((k0 + crow(i, hh)) <= cmax) ? fexp2(z[i] - mn) : 0.f;
            l = l * fexp2(m - mn) + ls; m = mn;
        }
        const float lt = l + shx32(l), inv = lt > 0.f ? 1.f / lt : 0.f;
        f32x16 o0 = zero16(), o1 = zero16();
        float carry = 0.f;
        for (int kt = 0; kt <= ctile_hi; ++kt) {
            const int k0 = kt * 32;
            f32x16 z = qk_tile(kcb + (size_t)(k0 + r) * 64, qf);
#pragma unroll
            for (int i = 0; i < 16; ++i) z[i] = ((k0 + crow(i, hh)) <= cmax) ? fexp2(z[i] - m) * inv : 0.f;
            float px[4];
#pragma unroll
            for (int g = 0; g < 4; ++g) px[g] = shx32(z[4 * g + 3]);
#pragma unroll
            for (int g = 0; g < 4; ++g) {
                const float G = (z[4 * g] + z[4 * g + 1]) + (z[4 * g + 2] + z[4 * g + 3]);
                const float prev = hh ? px[g] : (g == 0 ? carry : px[g - 1]);
                imp[64 * (4 * kt + g)] += G + prev;
            }
            carry = px[3];
            pv_tile(o0, o1, vcb + k0, 256, z);
        }
        const float gate = P.WG()[row * 16 + 4 + h * 3 + 0];
        store_ot(P.O3() + row * 768 + 512 + h * 64, o0, o1, gate, hh);
    }
    const int cur = tq >> 6;
    unsigned own = 0u;
    unsigned cand = 0u;
#pragma unroll
    for (int a = 0; a < 32; ++a) { const int j = 2 * a + hh; const bool adm = j <= cur, forced = (j == 0) || (j == cur) || (j == cur - 1);
        own |= bitif(adm && (forced || cur < 16), a); cand |= bitif(adm && !forced, a); }
    if (__any(cur >= 16)) {
        float iv[32];
#pragma unroll
        for (int a = 0; a < 32; ++a) iv[a] = imp[64 * a];
        for (int it = 0; it < 13; ++it) {
            float bv = -1e30f; int ba = 64;
#pragma unroll
            for (int a = 0; a < 32; ++a) { const bool c = (cand >> a) & 1u; if (c && iv[a] > bv) { bv = iv[a]; ba = a; } }
            const float pv_ = shx32(bv); const int pa = __shfl_xor(ba, 32);
            const int jo = 2 * ba + hh, jp = 2 * pa + (1 - hh);
            const bool win = (ba < 64) && ((pa >= 64) || (bv > pv_) || (bv == pv_ && jo < jp));
            const unsigned wb = (win ? 1u : 0u) << (ba & 31);
            if (cur >= 16) own |= wb;
            cand &= ~wb;
        }
    }
    if (CHK) {
        float smin = 1e30f, umax = -1e30f; int sj = -1, uj = 999;
#pragma unroll
        for (int a = 0; a < 32; ++a) { const int j = 2 * a + hh; const bool adm = j <= cur, forced = (j == 0) || (j == cur) || (j == cur - 1); const float v = imp[64 * a];
            if (adm && !forced) { if ((own >> a) & 1u) { if (v < smin || (v == smin && j > sj)) { smin = v; sj = j; } } else { if (v > umax || (v == umax && j < uj)) { umax = v; uj = j; } } } }
        const float psmin = shx32(smin), pumax = shx32(umax); const int psj = __shfl_xor(sj, 32), puj = __shfl_xor(uj, 32);
        if (psmin < smin || (psmin == smin && psj > sj)) { smin = psmin; sj = psj; }
        if (pumax > umax || (pumax == umax && puj < uj)) { umax = pumax; uj = puj; }
        const unsigned both = __builtin_popcount(own) + __builtin_popcount(shx32u(own));
        const unsigned want = (unsigned)(cur + 1 < 16 ? cur + 1 : 16);
        bool bad = both != want;
        if (sj >= 0 && uj < 999 && (umax > smin || (umax == smin && uj < sj))) bad = true;
        { const int j0 = 0, j1 = cur, j2 = cur - 1; const unsigned oo = shx32u(own);
          auto has = [&](int j) -> bool { if (j < 0) return true; const unsigned msk = ((j & 1) == hh) ? own : oo; return (msk >> (j >> 1)) & 1u; };
          if (!has(j0) || !has(j1) || !has(j2)) bad = true; }
        if (bad) __hip_atomic_fetch_or((gu32*)P.ctl() + 2, 2u, RLX_AGENT);
    }
    const unsigned oth = shx32u(own);
    if (hh == 0) {
        unsigned long long bm = 0ull;
#pragma unroll
        for (int a = 0; a < 32; ++a) { bm |= (unsigned long long)((own >> a) & 1u) << (2 * a); bm |= (unsigned long long)((oth >> a) & 1u) << (2 * a + 1); }
        P.BM()[row] = bm;
    }
}
DI void nsa_selwin_unit(const Bufs& P, int b, int h, int qb, int lane, bf16_t* obase) {
    const int r = lane & 31, hh = lane >> 5, q0 = qb * 32, tq = q0 + r;
    const size_t row = (size_t)b * SQ + tq;
    bf16x8 qf[4]; load_q(qf, P.PA() + row * PAP + C_QC + h * 64 + 8 * hh);
    const unsigned long long bm = P.BM()[row];
    f32x16 a0 = zero16(), a1 = zero16();
    {
        f32x16 o0 = zero16(), o1 = zero16(); float m = -1e30f, l = 0.f;
        auto mask = [&](int kt) -> unsigned {
            if (!((bm >> (kt >> 1)) & 1ull)) return 0u;
            unsigned v = 0u;
#pragma unroll
            for (int i = 0; i < 16; ++i) v |= bitif((kt * 32 + crow(i, hh)) <= tq, i);
            return v; };
        attn_tiles<true>(o0, o1, m, l, qf, P.PA() + (size_t)b * SQ * PAP + C_KSEL, PAP, P.VST() + (size_t)b * 64 * SQ, SQ, 0, qb, mask, r, hh);
        const float lt = l + shx32(l), g = (lt > 0.f ? 1.f / lt : 0.f) * P.WG()[row * 16 + 4 + h * 3 + 1];
#pragma unroll
        for (int i = 0; i < 16; ++i) { a0[i] = o0[i] * g; a1[i] = o1[i] * g; }
    }
    {
        f32x16 o0 = zero16(), o1 = zero16(); float m = -1e30f, l = 0.f;
        auto mask = [&](int kt) -> unsigned {
            unsigned v = 0u;
#pragma unroll
            for (int i = 0; i < 16; ++i) { const int key = kt * 32 + crow(i, hh); v |= bitif(key <= tq && key > tq - 512, i); }
            return v; };
        const int lo = (q0 - 511) > 0 ? ((q0 - 511) >> 5) : 0;
        attn_tiles<false>(o0, o1, m, l, qf, P.PA() + (size_t)b * SQ * PAP + C_KWIN, PAP, P.VWT() + (size_t)b * 64 * SQ, SQ, lo, qb, mask, r, hh);
        const float lt = l + shx32(l), g = (lt > 0.f ? 1.f / lt : 0.f) * P.WG()[row * 16 + 4 + h * 3 + 2];
#pragma unroll
        for (int i = 0; i < 16; ++i) { a0[i] += o0[i] * g; a1[i] += o1[i] * g; }
    }
    bf16_t* orow = obase + row * 768 + 512 + h * 64;
#pragma unroll
    for (int g = 0; g < 4; ++g) {
        const u32x2 c0 = *(const GAS u32x2*)(orow + 8 * g + 4 * hh), c1 = *(const GAS u32x2*)(orow + 32 + 8 * g + 4 * hh);
        a0[4 * g] += bflo(c0.x); a0[4 * g + 1] += bfhi(c0.x); a0[4 * g + 2] += bflo(c0.y); a0[4 * g + 3] += bfhi(c0.y);
        a1[4 * g] += bflo(c1.x); a1[4 * g + 1] += bfhi(c1.x); a1[4 * g + 2] += bflo(c1.y); a1[4 * g + 3] += bfhi(c1.y);
    }
    store_ot(orow, a0, a1, 1.f, hh);
}

constexpr int AW_KP = 144, AW_VP = 136, AW_KB = 64 * AW_KP, AW_BUF = AW_KB + 64 * AW_VP;
template <int KIND  , int EXP = 0>
DI void attn_wg(f32x16& o0, f32x16& o1, float& m, float& l, const bf16x8 (&qf)[4], const bf16_t* kglob  , const bf16_t* vtglob  ,
                int st_lo, int st_hi, int tq, int kt32_base_unused, const unsigned short* mb  , unsigned long long bm, int lane, int tid, LAS unsigned char* lds) {
    (void)kt32_base_unused;
    const int r = lane & 31, hh = lane >> 5;
    const int srow = tid >> 3, sch = tid & 7;
    const bf16_t* kg = kglob + (size_t)srow * PAP + sch * 8; const bf16_t* vg = vtglob + (size_t)srow * SQ + sch * 8;
    LAS unsigned char* const kw = lds + srow * AW_KP + sch * 16; LAS unsigned char* const vw = lds + AW_KB + srow * AW_VP + sch * 16;
    const int kro = r * AW_KP + hh * 16, vro = AW_KB + r * AW_VP + hh * 8;
    if (st_lo > st_hi) return;
    u32x4 kr = *(const GAS u32x4*)(kg + (size_t)(st_lo * 64) * PAP), vr = *(const GAS u32x4*)(vg + st_lo * 64);
    unsigned mw0 = 0u, mw1 = 0u;
    if (KIND == 0) { mw0 = mb[(size_t)(2 * st_lo) * 64]; mw1 = mb[(size_t)(2 * st_lo + 1) * 64]; }
    *(LAS u32x4*)kw = kr; *(LAS u32x2*)vw = (u32x2){vr.x, vr.y}; *(LAS u32x2*)(vw + 8) = (u32x2){vr.z, vr.w};
    __syncthreads();
    for (int st = st_lo; st <= st_hi; ++st) {
        LAS unsigned char* const buf = lds + ((st - st_lo) & 1) * AW_BUF;
        const bool more = st < st_hi;
        unsigned nw0 = 0u, nw1 = 0u;
        if (more) { if (EXP != 3) { kr = *(const GAS u32x4*)(kg + (size_t)((st + 1) * 64) * PAP); vr = *(const GAS u32x4*)(vg + (st + 1) * 64); }
            if (KIND == 0) { nw0 = mb[(size_t)(2 * st + 2) * 64]; nw1 = mb[(size_t)(2 * st + 3) * 64]; } }
#pragma unroll
        for (int j = 0; j < 2; ++j) {
            const int k0 = st * 64 + j * 32, q0w = tq - r;
            unsigned vm = 0xffffu; int mode;
            bool lanesel = true;
            if (KIND == 0) { vm = (2 * st + j <= (tq >> 5)) ? (j ? mw1 : mw0) : 0u; mode = 0; }
            else if (KIND == 1) {
                lanesel = ((bm >> st) & 1ull) != 0ull;
                if (k0 + 31 <= q0w) { mode = 2; vm = lanesel ? 0xffffu : 0u; }
                else { mode = 0; vm = 0u; if (lanesel) {
#pragma unroll
                    for (int i = 0; i < 16; ++i) vm |= bitif((k0 + crow(i, hh)) <= tq, i); } }
            } else {
                if (k0 + 31 <= q0w && k0 > q0w + 31 - 512) mode = 1;
                else { mode = 0; vm = 0u;
#pragma unroll
                    for (int i = 0; i < 16; ++i) { const int key = k0 + crow(i, hh); vm |= bitif(key <= tq && key > tq - 512, i); } }
            }
            if (!__any(vm != 0u)) continue;
            bf16x8 kf[4];
#pragma unroll
            for (int s2 = 0; s2 < 4; ++s2) kf[s2] = *(const LAS bf16x8*)(buf + kro + j * 32 * AW_KP + s2 * 32);
            const float nme = -sm_meff(m), ninf = -__builtin_inff();
            f32x16 init;
            if (mode == 1) {
#pragma unroll
                for (int i = 0; i < 16; ++i) init[i] = nme;
            } else if (mode == 2) {
                const float v = lanesel ? nme : ninf;
#pragma unroll
                for (int i = 0; i < 16; ++i) init[i] = v;
            } else {
                const unsigned nb = __builtin_bit_cast(unsigned, nme), ib = __builtin_bit_cast(unsigned, ninf); unsigned xb = nb ^ ib; asm volatile("" : "+v"(xb));
#pragma unroll
                for (int i = 0; i < 16; ++i) { const unsigned t = (unsigned)__builtin_amdgcn_sbfe((int)vm, i, 1); init[i] = __builtin_bit_cast(float, (t & xb) ^ ib); }
            }
            f32x16 z; if (EXP == 2) { _Pragma("unroll") for (int i = 0; i < 16; ++i) z[i] = __builtin_bit_cast(float, (int)kf[i & 3][i >> 2] << 16) + init[i]; } else z = qk_frag_init(kf, qf, init);
            if (EXP == 1) { asm volatile("" :: "v"(vm)); } else softmax_core(z, m, l, o0, o1);
            bf16x8 vf[4];
#pragma unroll
            for (int s2 = 0; s2 < 2; ++s2) {
#pragma unroll
                for (int db = 0; db < 2; ++db) {
                    const LAS unsigned char* vp = buf + vro + db * 32 * AW_VP + (j * 32 + 16 * s2) * 2;
                    const s16x4 lo = *(const LAS s16x4*)vp, hi = *(const LAS s16x4*)(vp + 16);
                    vf[2 * s2 + db] = __builtin_shufflevector(lo, hi, 0, 1, 2, 3, 4, 5, 6, 7);
                }
            }
            if (EXP == 2) { _Pragma("unroll") for (int i = 0; i < 16; ++i) { o0[i] += z[i] + __builtin_bit_cast(float, (int)vf[i & 3][i >> 2] << 16); } } else pv_frag(o0, o1, vf, z);
        }
        if (more) {
            const int off = ((st - st_lo + 1) & 1) * AW_BUF;
            *(LAS u32x4*)(kw + off) = kr; *(LAS u32x2*)(vw + off) = (u32x2){vr.x, vr.y}; *(LAS u32x2*)(vw + off + 8) = (u32x2){vr.z, vr.w};
            mw0 = nw0; mw1 = nw1;
        }
        __syncthreads();
    }
}
template <int EXP = 0> DI void dsa_attn_wg(const Bufs& P, int b, int qb64, int lane, int wave, int tid, LAS unsigned char* lds) {
    const int r = lane & 31, hh = lane >> 5, sub = wave >> 2, h = wave & 3, qb = 2 * qb64 + sub, tq = qb * 32 + r;
    const size_t row = (size_t)b * SQ + tq;
    bf16x8 qf[4]; load_q(qf, P.PA() + row * PAP + C_QB + h * 64 + 8 * hh);
    f32x16 o0 = zero16(), o1 = zero16(); float m = -1e30f, l = 0.f;
    const unsigned short* mb = P.MB() + ((size_t)(b * 128 + qb) * 128) * 64 + lane;
    attn_wg<0, EXP>(o0, o1, m, l, qf, P.PA() + (size_t)b * SQ * PAP + C_KB, P.VBT() + (size_t)b * 64 * SQ, 0, qb64, tq, 0, mb, 0ull, lane, tid, lds);
    const float lt = l + shx32(l), inv = lt > 0.f ? 1.f / lt : 0.f;
    store_ot((EXP ? (bf16_t*)P.out() : P.O3()) + row * 768 + 256 + h * 64, o0, o1, inv, hh);
}
DI void nsa_selwin_wg(const Bufs& P, int b, int qb64, int lane, int wave, int tid, LAS unsigned char* lds, bf16_t* obase) {
    const int r = lane & 31, hh = lane >> 5, sub = wave >> 2, h = wave & 3, qb = 2 * qb64 + sub, tq = qb * 32 + r;
    const size_t row = (size_t)b * SQ + tq;
    bf16x8 qf[4]; load_q(qf, P.PA() + row * PAP + C_QC + h * 64 + 8 * hh);
    const unsigned long long bm = P.BM()[row];
    f32x16 a0 = zero16(), a1 = zero16();
    {
        f32x16 o0 = zero16(), o1 = zero16(); float m = -1e30f, l = 0.f;
        attn_wg<1>(o0, o1, m, l, qf, P.PA() + (size_t)b * SQ * PAP + C_KSEL, P.VST() + (size_t)b * 64 * SQ, 0, qb64, tq, 0, nullptr, bm, lane, tid, lds);
        const float lt = l + shx32(l), g = (lt > 0.f ? 1.f / lt : 0.f) * P.WG()[row * 16 + 4 + h * 3 + 1];
#pragma unroll
        for (int i = 0; i < 16; ++i) { a0[i] = o0[i] * g; a1[i] = o1[i] * g; }
    }
    {
        f32x16 o0 = zero16(), o1 = zero16(); float m = -1e30f, l = 0.f;
        const int lo = (qb64 * 64 - 511) > 0 ? ((qb64 * 64 - 511) >> 6) : 0;
        attn_wg<2>(o0, o1, m, l, qf, P.PA() + (size_t)b * SQ * PAP + C_KWIN, P.VWT() + (size_t)b * 64 * SQ, lo, qb64, tq, 0, nullptr, 0ull, lane, tid, lds);
        const float lt = l + shx32(l), g = (lt > 0.f ? 1.f / lt : 0.f) * P.WG()[row * 16 + 4 + h * 3 + 2];
#pragma unroll
        for (int i = 0; i < 16; ++i) { a0[i] += o0[i] * g; a1[i] += o1[i] * g; }
    }
    bf16_t* orow = obase + row * 768 + 512 + h * 64;
#pragma unroll
    for (int g = 0; g < 4; ++g) {
        const u32x2 c0 = *(const GAS u32x2*)(orow + 8 * g + 4 * hh), c1 = *(const GAS u32x2*)(orow + 32 + 8 * g + 4 * hh);
        a0[4 * g] += bflo(c0.x); a0[4 * g + 1] += bfhi(c0.x); a0[4 * g + 2] += bflo(c0.y); a0[4 * g + 3] += bfhi(c0.y);
        a1[4 * g] += bflo(c1.x); a1[4 * g + 1] += bfhi(c1.x); a1[4 * g + 2] += bflo(c1.y); a1[4 * g + 3] += bfhi(c1.y);
    }
    store_ot(orow, a0, a1, 1.f, hh);
}
constexpr int MW_KP = 144, MW_VP = 520, MW_VOFF = 256 * MW_KP;
DI void mem_attn_wg(const Bufs& P, int l_, int b, int h, int qc, int lane, int wave, int tid, LAS unsigned char* lds) {
    const int r = lane & 31, hh = lane >> 5;
    const size_t row = (size_t)b * SQ + qc * 256 + wave * 32 + r;
    bf16x8 qf[4]; load_q(qf, P.QM() + row * 256 + h * 64 + 8 * hh);
    const bf16_t* kg = P.KMEM() + ((size_t)l_ * 2048 + (size_t)b * 256) * 256 + h * 64;
    const bf16_t* vg = P.VMEMT() + ((size_t)l_ * 32 + b * 4 + h) * 64 * 256;
#pragma unroll
    for (int i = 0; i < 4; ++i) { const int c = tid + 512 * i;
        { const int kr = c >> 3, ch = c & 7; *(LAS u32x4*)(lds + kr * MW_KP + ch * 16) = *(const GAS u32x4*)(kg + (size_t)kr * 256 + ch * 8); }
        { const int d = c >> 5, ch = c & 31; const u32x4 v = *(const GAS u32x4*)(vg + (size_t)d * 256 + ch * 8); LAS unsigned char* p = lds + MW_VOFF + d * MW_VP + ch * 16;
          *(LAS u32x2*)p = (u32x2){v.x, v.y}; *(LAS u32x2*)(p + 8) = (u32x2){v.z, v.w}; } }
    __syncthreads();
    f32x16 o0 = zero16(), o1 = zero16(); float m = -1e30f, l = 0.f;
    const LAS unsigned char* kl = lds + r * MW_KP + hh * 16; const LAS unsigned char* vl = lds + MW_VOFF + r * MW_VP + hh * 8;
    for (int kt = 0; kt < 8; ++kt) {
        bf16x8 kf[4];
#pragma unroll
        for (int s2 = 0; s2 < 4; ++s2) kf[s2] = *(const LAS bf16x8*)(kl + kt * 32 * MW_KP + s2 * 32);
        f32x16 z = qk_frag(kf, qf);
        softmax_step<false>(z, 0xffffu, m, l, o0, o1);
        bf16x8 vf[4];
#pragma unroll
        for (int s2 = 0; s2 < 2; ++s2) {
#pragma unroll
            for (int db = 0; db < 2; ++db) { const LAS unsigned char* vp = vl + db * 32 * MW_VP + (kt * 32 + 16 * s2) * 2;
                const s16x4 lo = *(const LAS s16x4*)vp, hi = *(const LAS s16x4*)(vp + 16); vf[2 * s2 + db] = __builtin_shufflevector(lo, hi, 0, 1, 2, 3, 4, 5, 6, 7); } }
        pv_frag(o0, o1, vf, z);
    }
    const float lt = l + shx32(l), inv = lt > 0.f ? 1.f / lt : 0.f;
    store_ot(P.OM() + row * 256 + h * 64, o0, o1, inv, hh);
    __syncthreads();
}
DI void mem_attn_unit(const Bufs& P, int l_, int b, int h, int qb, int lane) {
    const int r = lane & 31, hh = lane >> 5;
    const size_t row = (size_t)b * SQ + qb * 32 + r;
    bf16x8 qf[4]; load_q(qf, P.QM() + row * 256 + h * 64 + 8 * hh);
    f32x16 o0 = zero16(), o1 = zero16(); float m = -1e30f, l = 0.f;
    auto mask = [&](int) -> unsigned { return 0xffffu; };
    attn_tiles<false>(o0, o1, m, l, qf, P.KMEM() + ((size_t)l_ * 2048 + (size_t)b * 256) * 256 + h * 64, 256, P.VMEMT() + ((size_t)l_ * 32 + b * 4 + h) * 64 * 256, 256, 0, 7, mask, r, hh);
    const float lt = l + shx32(l), inv = lt > 0.f ? 1.f / lt : 0.f;
    store_ot(P.OM() + row * 256 + h * 64, o0, o1, inv, hh);
}
DI void st8(bf16_t* p, const f32x4& a, const f32x4& b) { u32x4 w; w.x = cvtpk(a[0], a[1]); w.y = cvtpk(a[2], a[3]); w.z = cvtpk(b[0], b[1]); w.w = cvtpk(b[2], b[3]); *(GAS u32x4*)p = w; }
DI void st8nt(bf16_t* p, const f32x4& a, const f32x4& b) { u32x4 w; w.x = cvtpk(a[0], a[1]); w.y = cvtpk(a[2], a[3]); w.z = cvtpk(b[0], b[1]); w.w = cvtpk(b[2], b[3]); __builtin_nontemporal_store(w, (GAS u32x4*)p); }
DI float sigm(float x) { return __builtin_amdgcn_rcpf(1.f + fexp2(-x * LOG2E)); }
DI float rs_of(float ssq) { return __builtin_amdgcn_rsqf(ssq * (1.f / 1024.f) + RMS_EPS); }

struct EpiIn {
    static constexpr bool PERM = true;
    const float* ss; Bufs P; LAS unsigned char* scr;
    DI void operator()(const f32x4 (&acc)[2][2][4][2], const pg8::Unit& u, int wr, int wc, int fr0, int fq0) const {
        int fr = fr0, fq = fq0; asm volatile("" : "+v"(fr), "+v"(fq));
        const int pn = u.pn, b = u.pm >> 4;
        float rsv[8];
#pragma unroll
        for (int i = 0; i < 8; ++i) rsv[i] = rs_of(ss[u.pm * 256 + (i >> 2) * 128 + wr * 64 + (i & 3) * 16 + fr]);
#pragma unroll
        for (int bj = 0; bj < 2; ++bj) {
            const int cl = bj * 128 + wc * 32 + fq * 8, g = cl >> 6, e = cl & 63;
            int mode = 5; float scale = 1.f; bf16_t* dst = nullptr; size_t pitch = 0;
            if (pn == 0) { mode = 0; scale = 0.125f; dst = P.PA() + C_QA + cl; pitch = PAP; }
            else if (pn == 1) { mode = 0; dst = P.PA() + C_KA + cl; pitch = PAP; }
            else if (pn == 2) { mode = 2; dst = P.VAT() + ((size_t)(b * 4 + g) * 64 + e) * SQ; }
            else if (pn == 3) { mode = 1; scale = C2; dst = P.PA() + C_QB + cl; pitch = PAP; }
            else if (pn == 4) { mode = 1; dst = P.PA() + C_QI + cl; pitch = PAP; }
            else if (pn == 5) { mode = 1; scale = C2; dst = P.PA() + C_QC + cl; pitch = PAP; }
            else if (pn == 6) { mode = 1;
                if (g == 0) { dst = P.PA() + C_KB + e; pitch = PAP; } else if (g == 1) { dst = P.PA() + C_KI + e; pitch = PAP; }
                else if (g == 2) { dst = P.KCMP() + e; pitch = 64; } else { dst = P.PA() + C_KSEL + e; pitch = PAP; } }
            else if (pn == 7) {
                if (g == 0) { mode = 1; dst = P.PA() + C_KWIN + e; pitch = PAP; } else if (g == 1) { mode = 0; dst = P.VCMP() + e; pitch = 64; }
                else if (g == 2) { mode = (e < 16) ? 4 : 5; } else mode = 5; }
            else if (pn == 8) { mode = 2; if (g == 0) dst = P.VBT() + ((size_t)b * 64 + e) * SQ; else if (g == 1) dst = P.VST() + ((size_t)b * 64 + e) * SQ; else if (g == 2) dst = P.VWT() + ((size_t)b * 64 + e) * SQ; else mode = 5; }
            else { mode = 3; dst = P.PG() + (size_t)(pn - 9) * 256 + cl; pitch = 3072; }
#pragma unroll
            for (int ai = 0; ai < 2; ++ai) {
                f32x4 c01s[4], c23s[4];
                if (mode == 1) {
#pragma unroll
                    for (int m = 0; m < 4; ++m) { const int t = (u.pm * 256 + ai * 128 + wr * 64 + m * 16 + fr) & (SQ - 1);
                        const f32x4* cs = (const f32x4*)(P.rope() + (size_t)t * 32 + (e >> 1)); c01s[m] = *(const GAS f32x4*)cs; c23s[m] = *(const GAS f32x4*)(cs + 1); }
                }
#pragma unroll
                for (int m = 0; m < 4; ++m) {
                    const int row = u.pm * 256 + ai * 128 + wr * 64 + m * 16 + fr;
                    const float rs = rsv[ai * 4 + m];
                    const int t = row & (SQ - 1);
                    const f32x4 v0 = acc[ai][bj][m][0] * rs, v1 = acc[ai][bj][m][1] * rs;
                    if (mode == 0) { st8(dst + (size_t)row * pitch, v0 * scale, v1 * scale); }
                    else if (mode == 1) {
                        const f32x4 c01 = c01s[m], c23 = c23s[m];
                        f32x4 r0, r1;
                        r0[0] = v0[0] * c01[0] - v0[1] * c01[1]; r0[1] = v0[1] * c01[0] + v0[0] * c01[1];
                        r0[2] = v0[2] * c01[2] - v0[3] * c01[3]; r0[3] = v0[3] * c01[2] + v0[2] * c01[3];
                        r1[0] = v1[0] * c23[0] - v1[1] * c23[1]; r1[1] = v1[1] * c23[0] + v1[0] * c23[1];
                        r1[2] = v1[2] * c23[2] - v1[3] * c23[3]; r1[3] = v1[3] * c23[2] + v1[2] * c23[3];
                        st8(dst + (size_t)row * pitch, r0 * scale, r1 * scale);
                    } else if (mode == 2) {
                        const unsigned w0 = cvtpk(v0[0], v0[1]), w1 = cvtpk(v0[2], v0[3]), w2 = cvtpk(v1[0], v1[1]), w3 = cvtpk(v1[2], v1[3]);
                        LAS unsigned short* sw = (LAS unsigned short*)(scr + (wr * 4 + wc) * 1024) + (fq * 8) * 16 + fr;
                        sw[0] = (unsigned short)w0; sw[16] = (unsigned short)(w0 >> 16); sw[32] = (unsigned short)w1; sw[48] = (unsigned short)(w1 >> 16);
                        sw[64] = (unsigned short)w2; sw[80] = (unsigned short)(w2 >> 16); sw[96] = (unsigned short)w3; sw[112] = (unsigned short)(w3 >> 16);
                        const int ln = fq * 16 + fr, dd = ln >> 1, hf = ln & 1;
                        const u32x4 tv = *(LAS u32x4*)(scr + (wr * 4 + wc) * 1024 + dd * 32 + hf * 16);
                        const int trow0 = (row - fr) & (SQ - 1);
                        *(GAS u32x4*)(dst + (ptrdiff_t)(dd - fq * 8) * SQ + trow0 + hf * 8) = tv;
                    } else if (mode == 3) {
                        f32x4 s0, s1;
#pragma unroll
                        for (int j = 0; j < 4; ++j) { s0[j] = sigm(v0[j]); s1[j] = sigm(v1[j]); }
                        st8nt(dst + (size_t)row * pitch, s0, s1);
                    } else if (mode == 4) {
                        f32x4 s0, s1;
                        if (e == 0) { s0 = v0 * 0.0625f; } else {
#pragma unroll
                            for (int j = 0; j < 4; ++j) s0[j] = sigm(v0[j]); }
#pragma unroll
                        for (int j = 0; j < 4; ++j) s1[j] = sigm(v1[j]);
                        GAS f32x4* wg = (GAS f32x4*)(P.WG() + (size_t)row * 16 + e);
                        wg[0] = s0; wg[1] = s1;
                    }
                }
                asm volatile("" ::: "memory");
            }
        }
    }
};
struct EpiMemKV {
    static constexpr bool PERM = true;
    Bufs P;
    DI void operator()(const f32x4 (&acc)[2][2][4][2], const pg8::Unit& u, int wr, int wc, int fr0, int fq0) const {
        int fr = fr0, fq = fq0; asm volatile("" : "+v"(fr), "+v"(fq));
        const int layer = u.pn >> 1, isv = u.pn & 1;
#pragma unroll
        for (int ai = 0; ai < 2; ++ai)
#pragma unroll
            for (int m = 0; m < 4; ++m) {
                const int row = u.pm * 256 + ai * 128 + wr * 64 + m * 16 + fr;
                const float rs = rs_of(P.ssm()[row]); const int b = row >> 8, mt = row & 255;
#pragma unroll
                for (int bj = 0; bj < 2; ++bj) {
                    const int cl = bj * 128 + wc * 32 + fq * 8, g = cl >> 6, e = cl & 63;
                    const f32x4 v0 = acc[ai][bj][m][0] * rs, v1 = acc[ai][bj][m][1] * rs;
                    if (!isv) st8(P.KMEM() + ((size_t)layer * 2048 + row) * 256 + cl, v0, v1);
                    else {
                        const unsigned w0 = cvtpk(v0[0], v0[1]), w1 = cvtpk(v0[2], v0[3]), w2 = cvtpk(v1[0], v1[1]), w3 = cvtpk(v1[2], v1[3]);
                        GAS bf16_t* d = (GAS bf16_t*)P.VMEMT() + (((size_t)layer * 32 + b * 4 + g) * 64 + e) * 256 + mt;
                        d[0] = (bf16_t)w0; d[256] = (bf16_t)(w0 >> 16); d[512] = (bf16_t)w1; d[768] = (bf16_t)(w1 >> 16);
                        d[1024] = (bf16_t)w2; d[1280] = (bf16_t)(w2 >> 16); d[1536] = (bf16_t)w3; d[1792] = (bf16_t)(w3 >> 16);
                    }
                    asm volatile("" ::: "memory");
                }
            }
    }
};
DI float gelu_tanh(float x) { const float u = 0.7978845608028654f * (x + 0.044715f * x * x * x); const float e = fexp2(-2.f * LOG2E * fabsf(u)); const float th = (1.f - e) * __builtin_amdgcn_rcpf(1.f + e);
    return 0.5f * x * (1.f + (u < 0.f ? -th : th)); }
struct EpiCmp1 {
    static constexpr bool PERM = true;
    bf16_t* HID; const float* bias;
    DI void operator()(const f32x4 (&acc)[2][2][4][2], const pg8::Unit& u, int wr, int wc, int fr0, int fq0) const {
        int fr = fr0, fq = fq0; asm volatile("" : "+v"(fr), "+v"(fq));
        const bool isv = u.pm >= 8;
#pragma unroll
        for (int bj = 0; bj < 2; ++bj) {
            const int cl = bj * 128 + wc * 32 + fq * 8;
            const bool keep = (bj == 1) == isv;
            const f32x4 b0 = *(const GAS f32x4*)(bias + cl), b1 = *(const GAS f32x4*)(bias + cl + 4);
#pragma unroll
            for (int ai = 0; ai < 2; ++ai)
#pragma unroll
                for (int m = 0; m < 4; ++m) {
                    const int row = u.pm * 256 + ai * 128 + wr * 64 + m * 16 + fr;
                    f32x4 h0, h1;
#pragma unroll
                    for (int j = 0; j < 4; ++j) { h0[j] = keep ? gelu_tanh(acc[ai][bj][m][0][j] + b0[j]) : 0.f; h1[j] = keep ? gelu_tanh(acc[ai][bj][m][1][j] + b1[j]) : 0.f; }
                    st8(HID + (size_t)row * 256 + (cl & 127) + (keep ? 0 : 128), h0, h1);
                }
        }
    }
};
struct EpiCmp2 {
    static constexpr bool PERM = true;
    bf16_t *KC, *VCT;
    DI void operator()(const f32x4 (&acc)[2][2][4][2], const pg8::Unit& u, int wr, int wc, int fr0, int fq0) const {
        int fr = fr0, fq = fq0; asm volatile("" : "+v"(fr), "+v"(fq));
        const bool isv = u.pm >= 8;
        if (wc >= 2) return;
#pragma unroll
        for (int ai = 0; ai < 2; ++ai)
#pragma unroll
            for (int m = 0; m < 4; ++m) {
                const int row = u.pm * 256 + ai * 128 + wr * 64 + m * 16 + fr, rl = row & 2047, b = rl >> 8, ci = rl & 255;
                const bool live = ci != 255;
                const f32x4 zf = {0.f, 0.f, 0.f, 0.f};
                (void)b;
                {
                    const int cl = wc * 32 + fq * 8;
                    const f32x4 v0 = live ? acc[ai][0][m][0] : zf, v1 = live ? acc[ai][0][m][1] : zf;
                    if (!isv) st8(KC + (size_t)rl * 64 + cl, v0, v1);
                }
            }
    }
    DI void vpart(const f32x4 (&acc)[2][2][4][2], const pg8::Unit& u, int wr, int wc, int fr0, int fq0) const {
        int fr = fr0, fq = fq0; asm volatile("" : "+v"(fr), "+v"(fq));
        if (u.pm < 8 || wc < 2) return;
#pragma unroll
        for (int ai = 0; ai < 2; ++ai)
#pragma unroll
            for (int m = 0; m < 4; ++m) {
                const int row = u.pm * 256 + ai * 128 + wr * 64 + m * 16 + fr, rl = row & 2047, b = rl >> 8, ci = rl & 255;
                const bool live = ci != 255;
                const f32x4 zf = {0.f, 0.f, 0.f, 0.f};
                const int d0 = (wc - 2) * 32 + fq * 8;
                const f32x4 v0 = live ? acc[ai][0][m][0] : zf, v1 = live ? acc[ai][0][m][1] : zf;
                const unsigned w0 = cvtpk(v0[0], v0[1]), w1 = cvtpk(v0[2], v0[3]), w2 = cvtpk(v1[0], v1[1]), w3 = cvtpk(v1[2], v1[3]);
                GAS bf16_t* d = (GAS bf16_t*)VCT + ((size_t)b * 64 + d0) * 256 + ci;
                d[0] = (bf16_t)w0; d[256] = (bf16_t)(w0 >> 16); d[512] = (bf16_t)w1; d[768] = (bf16_t)(w1 >> 16);
                d[1024] = (bf16_t)w2; d[1280] = (bf16_t)(w2 >> 16); d[1536] = (bf16_t)w3; d[1792] = (bf16_t)(w3 >> 16);
            }
    }
};
struct EpiCmp2All {
    static constexpr bool PERM = true;
    EpiCmp2 e;
    DI void operator()(const f32x4 (&acc)[2][2][4][2], const pg8::Unit& u, int wr, int wc, int fr0, int fq0) const {
        int fr = fr0, fq = fq0; asm volatile("" : "+v"(fr), "+v"(fq));
        if (u.pm < 8) e(acc, u, wr, wc, fr, fq); else e.vpart(acc, u, wr, wc, fr, fq);
    }
};
struct EpiMerge {
    static constexpr bool PERM = true;
    const bf16_t* PG; bf16_t* MG;
    DI void operator()(const f32x4 (&acc)[2][2][4][2], const pg8::Unit& u, int wr, int wc, int fr0, int fq0) const {
        int fr = fr0, fq = fq0; asm volatile("" : "+v"(fr), "+v"(fq));
        const int br = u.br;
#pragma unroll
        for (int ai = 0; ai < 2; ++ai)
#pragma unroll
            for (int bj = 0; bj < 2; ++bj) {
                const int rowb = u.pm * 256 + ai * 128 + wr * 64 + fr, col = u.pn * 256 + bj * 128 + wc * 32 + fq * 8;
                u32x4 gw[4], pw[4];
#pragma unroll
                for (int m = 0; m < 4; ++m) { gw[m] = *(const GAS u32x4*)(PG + (size_t)(rowb + m * 16) * 3072 + br * 1024 + col); pw[m] = (u32x4){0u, 0u, 0u, 0u}; }
                if (br > 0) {
#pragma unroll
                    for (int m = 0; m < 4; ++m) pw[m] = *(const GAS u32x4*)(MG + (size_t)(rowb + m * 16) * 1024 + col); }
#pragma unroll
                for (int m = 0; m < 4; ++m) {
                    f32x4 v0 = acc[ai][bj][m][0], v1 = acc[ai][bj][m][1];
                    v0[0] = v0[0] * bflo(gw[m].x) + bflo(pw[m].x); v0[1] = v0[1] * bfhi(gw[m].x) + bfhi(pw[m].x); v0[2] = v0[2] * bflo(gw[m].y) + bflo(pw[m].y); v0[3] = v0[3] * bfhi(gw[m].y) + bfhi(pw[m].y);
                    v1[0] = v1[0] * bflo(gw[m].z) + bflo(pw[m].z); v1[1] = v1[1] * bfhi(gw[m].z) + bfhi(pw[m].z); v1[2] = v1[2] * bflo(gw[m].w) + bflo(pw[m].w); v1[3] = v1[3] * bfhi(gw[m].w) + bfhi(pw[m].w);
                    st8(MG + (size_t)(rowb + m * 16) * 1024 + col, v0, v1);
                }
                asm volatile("" ::: "memory");
            }
    }
};
template <bool DRY = false> struct EpiResidT {
    static constexpr bool PERM = true;
    const float* hin; float* hout; bf16_t* HB; float* ssout;
    DI void operator()(const f32x4 (&acc)[2][2][4][2], const pg8::Unit& u, int wr, int wc, int fr0, int fq0) const {
        int fr = fr0, fq = fq0; asm volatile("" : "+v"(fr), "+v"(fq));
#pragma unroll
        for (int ai = 0; ai < 2; ++ai) {
            float sq[4] = {0.f, 0.f, 0.f, 0.f};
            const int rowb = u.pm * 256 + ai * 128 + wr * 64 + fr;
#pragma unroll
            for (int bj = 0; bj < 2; ++bj) {
                const size_t offb = (size_t)rowb * 1024 + u.pn * 256 + bj * 128 + wc * 32 + fq * 8;
                f32x4 ha[4], hb4[4];
#pragma unroll
                for (int m = 0; m < 4; ++m) { ha[m] = *(const GAS f32x4*)(hin + offb + (size_t)m * 16 * 1024); hb4[m] = *(const GAS f32x4*)(hin + offb + (size_t)m * 16 * 1024 + 4); }
#pragma unroll
                for (int m = 0; m < 4; ++m) {
                    const size_t off = offb + (size_t)m * 16 * 1024;
                    const f32x4 v0 = acc[ai][bj][m][0] + ha[m], v1 = acc[ai][bj][m][1] + hb4[m];
                    if (!DRY) { *(GAS f32x4*)(hout + off) = v0; *(GAS f32x4*)(hout + off + 4) = v1; }
                    st8(HB + off, v0, v1);
                    sq[m] += (v0[0] * v0[0] + v0[1] * v0[1]) + (v0[2] * v0[2] + v0[3] * v0[3]) + (v1[0] * v1[0] + v1[1] * v1[1]) + (v1[2] * v1[2] + v1[3] * v1[3]);
                }
                asm volatile("" ::: "memory");
            }
#pragma unroll
            for (int m = 0; m < 4; ++m) { float q = sq[m]; q += __shfl_xor(q, 16); q += __shfl_xor(q, 32); if (fq == 0) atomicAdd(ssout + rowb + m * 16, q); }
        }
    }
};
typedef EpiResidT<false> EpiResid;
struct EpiMemQ {
    static constexpr bool PERM = true;
    const float* ss; bf16_t* QM;
    DI void operator()(const f32x4 (&acc)[2][2][4][2], const pg8::Unit& u, int wr, int wc, int fr0, int fq0) const {
        int fr = fr0, fq = fq0; asm volatile("" : "+v"(fr), "+v"(fq));
#pragma unroll
        for (int ai = 0; ai < 2; ++ai)
#pragma unroll
            for (int m = 0; m < 4; ++m) {
                const int row = u.pm * 256 + ai * 128 + wr * 64 + m * 16 + fr;
                const float rs = rs_of(ss[row]) * C2;
#pragma unroll
                for (int bj = 0; bj < 2; ++bj) st8(QM + (size_t)row * 256 + bj * 128 + wc * 32 + fq * 8, acc[ai][bj][m][0] * rs, acc[ai][bj][m][1] * rs);
            }
    }
};
struct EpiFfnIn {
    static constexpr bool PERM = true;
    const float* ss; bf16_t* ACT;
    DI void operator()(const f32x4 (&acc)[2][2][4][2], const pg8::Unit& u, int wr, int wc, int fr0, int fq0) const {
        int fr = fr0, fq = fq0; asm volatile("" : "+v"(fr), "+v"(fq));
#pragma unroll
        for (int ai = 0; ai < 2; ++ai)
#pragma unroll
            for (int m = 0; m < 4; ++m) {
                const int row = u.pm * 256 + ai * 128 + wr * 64 + m * 16 + fr;
                const float rs = rs_of(ss[row]);
                f32x4 o0, o1;
#pragma unroll
                for (int j = 0; j < 4; ++j) { const float g0 = acc[ai][0][m][0][j] * rs, g1 = acc[ai][0][m][1][j] * rs;
                    o0[j] = g0 * sigm(g0) * (acc[ai][1][m][0][j] * rs); o1[j] = g1 * sigm(g1) * (acc[ai][1][m][1][j] * rs); }
                st8nt(ACT + (size_t)row * DFF + u.pn * 128 + wc * 32 + fq * 8, o0, o1);
            }
    }
};
constexpr int LDS_SCRATCH = 139264, MISC_OFF = LDS_SCRATCH, LDS_BYTES = 147456;
static_assert(8 * HWAVE <= LDS_SCRATCH && DS_LDS_END <= LDS_SCRATCH && 128 * 64 * 4 <= 4 * HWAVE && pg8::STAGE_BYTES <= LDS_SCRATCH, "LDS map");

#define XB_TMO      128
#define XB_XCNT(j)  (256  + 64 * (j))
#define XB_XSUB(j)  (1280 + 64 * (j))
#define XB_XGEN(j)  (2304 + 64 * (j))
#define XB_TOP      3328
#define XB_TOPGEN   3392
#define XCD_BAR_WORDS 3456
#define XB_SPIN_CAP (1u << 18)

__device__ __forceinline__ unsigned xb_ld(unsigned* p)              { return __hip_atomic_load(p, __ATOMIC_RELAXED, __HIP_MEMORY_SCOPE_AGENT); }
__device__ __forceinline__ unsigned xb_add(unsigned* p, unsigned v) { return __hip_atomic_fetch_add(p, v, __ATOMIC_RELAXED, __HIP_MEMORY_SCOPE_AGENT); }
__device__ __forceinline__ unsigned xb_xcc_id() { return (unsigned)__builtin_amdgcn_s_getreg((3 << 11) | 20) & 0xFu; }
#define XB_SPIN(cond, bar) do { unsigned _sp = 0; while (cond) { __builtin_amdgcn_s_sleep(1); \
    if ((++_sp & 255u) == 0u) { if (xb_ld(&(bar)[XB_TMO])) break; if (_sp > XB_SPIN_CAP) { atomicAdd(&(bar)[XB_TMO], 1u); break; } } } } while (0)

struct XcdBarrier {
    unsigned* bar; unsigned x;
    volatile LAS unsigned* st;
};

__device__ __forceinline__ XcdBarrier xcd_barrier_post(unsigned* bar, volatile LAS unsigned* st) {
    XcdBarrier b; b.bar = bar; b.x = xb_xcc_id(); b.st = st;
    if (threadIdx.x == 0) (void)xb_add(&bar[XB_XCNT(b.x)], 1u);
    return b;
}
__device__ __forceinline__ void xcd_barrier_complete(unsigned* bar, unsigned x, unsigned& nloc, unsigned& nx) {
    const unsigned G = gridDim.x * gridDim.y * gridDim.z;
    unsigned sum, cnt, mine, sp = 0u;
    for (;;) {
        sum = 0u; cnt = 0u; mine = 0u;
#pragma unroll
        for (unsigned j = 0; j < 16; ++j) { const unsigned c = xb_ld(&bar[XB_XCNT(j)]); sum += c; cnt += (c > 0u) ? 1u : 0u; mine = (j == x) ? c : mine; }
        if (sum == G) break;
        __builtin_amdgcn_s_sleep(1);
        if ((++sp & 255u) == 0u) { if (xb_ld(&bar[XB_TMO])) break; if (sp > XB_SPIN_CAP) { atomicAdd(&bar[XB_TMO], 1u); break; } }
    }
    nloc = mine > 0u ? mine : 1u; nx = cnt > 0u ? cnt : 1u;
}

__device__ __forceinline__ void xcd_barrier(const XcdBarrier& b) {
    asm volatile("s_waitcnt vmcnt(0)" ::: "memory");
    __syncthreads();
    if (threadIdx.x == 0) {
        unsigned* bar = b.bar;
        __builtin_amdgcn_s_waitcnt(0);
        unsigned nloc = b.st[0], nx = b.st[1];
        if (nloc == 0u) { xcd_barrier_complete(bar, b.x, nloc, nx); b.st[0] = nloc; b.st[1] = nx; }
        const unsigned old = xb_add(&bar[XB_XSUB(b.x)], 1u);
        const unsigned gen = old / nloc;
        if (old + 1u == (gen + 1u) * nloc) {
            __builtin_amdgcn_fence(__ATOMIC_RELEASE, "agent");
            asm volatile("s_waitcnt vmcnt(0)" ::: "memory");
            const unsigned og = xb_add(&bar[XB_TOP], 1u);
            const unsigned tg = og / nx;
            if (og + 1u == (tg + 1u) * nx) xb_add(&bar[XB_TOPGEN], 1u);
            else XB_SPIN(xb_ld(&bar[XB_TOPGEN]) == tg, bar);
            __builtin_amdgcn_fence(__ATOMIC_ACQUIRE, "agent");
            xb_add(&bar[XB_XGEN(b.x)], 1u);
            asm volatile("s_waitcnt vmcnt(0)" ::: "memory");
        } else {
            XB_SPIN(xb_ld(&bar[XB_XGEN(b.x)]) == gen, bar);
            __builtin_amdgcn_fence(__ATOMIC_ACQUIRE, "agent");
            asm volatile("s_waitcnt vmcnt(0)" ::: "memory");
        }
    }
    __syncthreads();
}
DI float wave_sum(float v) {
#pragma unroll
    for (int o = 1; o < 64; o <<= 1) v += __shfl_xor(v, o);
    return v;
}
DI int ropeperm(int e) { return (e & 1) ? (e >> 1) + 32 : (e >> 1); }
DI int win_srccol(int n) {
    const int pn = n >> 8, c = n & 255, g = c >> 6, e = c & 63, rp = ropeperm(e);
    switch (pn) {
        case 0: return c; case 1: return 256 + c; case 2: return 512 + c;
        case 3: return 768 + g * 64 + rp; case 4: return 1152 + g * 64 + rp; case 5: return 1476 + g * 64 + rp;
        case 6: return g == 0 ? 1024 + rp : g == 1 ? 1408 + rp : g == 2 ? 1732 + rp : 1860 + rp;
        case 7: return g == 0 ? 1988 + rp : g == 1 ? 1796 + e : g == 2 ? (e < 4 ? 1472 + e : e < 16 ? 2116 + (e - 4) : -1) : -1;
        case 8: return g == 0 ? 1088 + e : g == 1 ? 1924 + e : g == 2 ? 2052 + e : -1;
        default: return 2128 + (n - 2304);
    }
}
constexpr int CV_P = 136;
template <class ColFn> DI void conv_weight(bf16_t* dst, int N, int K, int ld, const float* gain, bool kperm, int kmax, const ColFn& colp, int gwave, int gwaves, int lane, LAS unsigned char* scr) {
    const int nkt = K >> 6, total = (N >> 6) * nkt;
    for (int t = gwave; t < total; t += gwaves) {
        const int n0 = (t / nkt) << 6, k0 = (t % nkt) << 6;
        const float* cp = colp(n0 + lane);
        const bool live = (cp != nullptr) && (k0 < kmax);
        const float* cq = live ? cp + (size_t)k0 * ld : nullptr;
#pragma unroll
        for (int c = 0; c < 2; ++c) {
            float x[32];
#pragma unroll
            for (int j = 0; j < 32; ++j) { const int kk = 32 * c + j, rr = kperm ? ropeperm(kk) : kk; x[j] = live ? cq[(size_t)rr * ld] : 0.f; }
            if (gain) {
#pragma unroll
                for (int j = 0; j < 32; ++j) x[j] *= gain[k0 + 32 * c + j];
            }
#pragma unroll
            for (int j = 0; j < 32; j += 2) *(LAS unsigned*)(scr + lane * CV_P + (32 * c + j) * 2) = cvtpk(x[j], x[j + 1]);
        }
        asm volatile("s_waitcnt lgkmcnt(0)" ::: "memory");
#pragma unroll
        for (int i = 0; i < 8; ++i) {
            const int n = 8 * i + (lane >> 3), ch = lane & 7;
            const u32x2 lo = *(LAS u32x2*)(scr + n * CV_P + ch * 16), hi = *(LAS u32x2*)(scr + n * CV_P + ch * 16 + 8);
            *(GAS u32x4*)(dst + (size_t)(n0 + n) * K + k0 + ch * 8) = (u32x4){lo.x, lo.y, hi.x, hi.y};
        }
        asm volatile("s_waitcnt lgkmcnt(0)" ::: "memory");
    }
}
DI void prologue(const Bufs& P, int gtid, int gthreads, int gwave, int gwaves, int lane, LAS unsigned char* scr) {
    for (int l = 0; l < 2; ++l) {
        { const float* W = P.w_in() + (size_t)l * 1024 * DIN;
          conv_weight(P.WIN() + (size_t)l * DINP * 1024, DINP, 1024, DIN, P.norm_mix() + l * 1024, false, 1024, [&](int n) -> const float* { const int sc = win_srccol(n); return sc < 0 ? nullptr : W + sc; }, gwave, gwaves, lane, scr); }
        { const float* W = P.w_ffn_in() + (size_t)l * 1024 * 5632;
          conv_weight(P.WFI() + (size_t)l * 5632 * 1024, 5632, 1024, 5632, P.norm_ffn() + l * 1024, false, 1024, [&](int n) -> const float* { const int c = n & 255, idx = (n >> 8) * 128 + (c & 127); return W + ((c & 128) ? DFF + idx : idx); }, gwave, gwaves, lane, scr); }
        { const float* W = P.w_ffn_out() + (size_t)l * DFF * 1024;
          conv_weight(P.WFO() + (size_t)l * 1024 * DFF, 1024, DFF, 1024, nullptr, false, DFF, [&](int n) -> const float* { return W + n; }, gwave, gwaves, lane, scr); }
        { const float* W = P.w_out() + (size_t)l * 1024 * 1024;
          conv_weight(P.WOUT() + (size_t)l * 1024 * 1024, 1024, 1024, 1024, nullptr, false, 1024, [&](int n) -> const float* { return W + n; }, gwave, gwaves, lane, scr); }
        for (int br = 0; br < 3; ++br) { const float* W = P.w_up() + ((size_t)l * 3 + br) * 256 * 1024;
          conv_weight(P.WUP() + ((size_t)l * 3 + br) * 1024 * 256, 1024, 256, 1024, nullptr, false, 256, [&](int n) -> const float* { return W + n; }, gwave, gwaves, lane, scr); }
        { const float* W = P.w_mem_q() + (size_t)l * 1024 * 256;
          conv_weight(P.WMQ() + (size_t)l * 256 * 1024, 256, 1024, 256, P.norm_mem_q() + l * 1024, false, 1024, [&](int n) -> const float* { return W + n; }, gwave, gwaves, lane, scr); }
        { const float* W = P.w_mem_kv() + (size_t)l * 1024 * 512;
          conv_weight(P.WMKV() + (size_t)l * 512 * 1024, 512, 1024, 512, P.norm_mem_kv() + l * 1024, false, 1024, [&](int n) -> const float* { return W + n; }, gwave, gwaves, lane, scr); }
        { const float* W = P.w_mem_o() + (size_t)l * 256 * 1024;
          conv_weight(P.WMO() + (size_t)l * 1024 * 256, 1024, 256, 1024, nullptr, false, 256, [&](int n) -> const float* { return W + n; }, gwave, gwaves, lane, scr); }
        { const float* Wk = P.cmp_w1_k() + (size_t)l * 2048 * 128; const float* Wv = P.cmp_w1_v() + (size_t)l * 2048 * 128;
          conv_weight(P.WC1() + (size_t)l * 256 * 2048, 128, 2048, 128, nullptr, true, 2048, [&](int n) -> const float* { return Wk + n; }, gwave, gwaves, lane, scr);
          conv_weight(P.WC1() + (size_t)l * 256 * 2048 + (size_t)128 * 2048, 128, 2048, 128, nullptr, false, 2048, [&](int n) -> const float* { return Wv + n; }, gwave, gwaves, lane, scr); }
        { const float* Wk = P.cmp_w2_k() + (size_t)l * 128 * 64; const float* Wv = P.cmp_w2_v() + (size_t)l * 128 * 64;
          conv_weight(P.WC2() + (size_t)l * 256 * 256, 256, 256, 64, nullptr, false, 128, [&](int n) -> const float* { return n < 64 ? Wk + ropeperm(n) : n < 128 ? Wv + (n - 64) : nullptr; }, gwave, gwaves, lane, scr); }
        for (int o = gwave; o < 256; o += gwaves) {
            const float* W = (o < 128 ? P.cmp_w1_k() : P.cmp_w1_v()) + (size_t)l * 2048 * 128; const float* pos = (o < 128 ? P.cmp_pos_k() : P.cmp_pos_v()) + (size_t)l * 2048; const int n = o & 127;
            float s = 0.f;
#pragma unroll 16
            for (int k = lane; k < 2048; k += 64) s += pos[k] * W[(size_t)k * 128 + n];
            s = wave_sum(s); if (lane == 0) P.BIAS1()[l * 256 + o] = s;
        }
    }
    for (int i = gtid; i < SQ * 32; i += gthreads) {
        const int pos = i >> 5, f = i & 31;
        const float inv = exp2f(-(float)f * (13.287712379549449f / 32.f));
        const float ang = (float)pos * inv;
        const double rev = (double)ang * 0.15915494309189535; const double fr = rev - __builtin_rint(rev);
        const float frf = (float)fr;
        P.rope()[i] = (f32x2){__builtin_amdgcn_cosf(frf), __builtin_amdgcn_sinf(frf)};
    }
    for (int row = 2 * gwave; row < MT + 2048; row += 2 * gwaves) {
        f32x4 v[2][4];
#pragma unroll
        for (int q = 0; q < 2; ++q) { const int rw = row + q; const bool ism = rw >= MT; const int rr = ism ? rw - MT : rw;
            const float* src = (ism ? P.mem() : P.x()) + (size_t)rr * 1024;
#pragma unroll
            for (int j = 0; j < 4; ++j) v[q][j] = *(const GAS f32x4*)(src + 256 * j + 4 * lane); }
#pragma unroll
        for (int q = 0; q < 2; ++q) { const int rw = row + q; const bool ism = rw >= MT; const int rr = ism ? rw - MT : rw;
            bf16_t* dst = (ism ? P.MEMB() : P.HB()) + (size_t)rr * 1024;
            float s = 0.f;
#pragma unroll
            for (int j = 0; j < 4; ++j) { const f32x4 t = v[q][j]; s += (t.x * t.x + t.y * t.y) + (t.z * t.z + t.w * t.w);
                u32x2 w; w.x = cvtpk(t.x, t.y); w.y = cvtpk(t.z, t.w); *(GAS u32x2*)(dst + 256 * j + 4 * lane) = w; }
            s = wave_sum(s); if (lane == 0) { if (ism) P.ssm()[rr] = s; else P.ss()[rr] = s; } }
    }
}

#ifndef PROBE_DUP
#define PROBE_DUP 0
#endif
#ifndef MK_ONE_LAUNCH
#define MK_ONE_LAUNCH 1
#endif
constexpr int NPH_LAYER = 11, PH_FINAL = 2 + 2 * NPH_LAYER, NPHASES = PH_FINAL + 1;
struct Args { Bufs P; int ph_lo, ph_hi; };

__global__ void __launch_bounds__(512, 2) mk_fwd(Args args) {
    extern __shared__ __attribute__((aligned(16))) unsigned char lds_raw[];
    LAS unsigned char* lds = (LAS unsigned char*)lds_raw;
    volatile LAS unsigned* MISC = (volatile LAS unsigned*)(lds + MISC_OFF);
    const Bufs& P = args.P;
    const int G = gridDim.x;
#define TID ((int)threadIdx.x)
#define LANE (TID & 63)
#define WAVE (__builtin_amdgcn_readfirstlane(TID >> 6))
    if (TID < 32) MISC[TID] = 0u;
    __syncthreads();
    XcdBarrier bar; bar.bar = (unsigned*)(P.ctl() + CW_BAR); bar.x = 0; bar.st = nullptr;
    if (MK_ONE_LAUNCH) bar = xcd_barrier_post((unsigned*)(P.ctl() + CW_BAR), MISC + 8);
    const int lo = args.ph_lo, hi = args.ph_hi;
#ifndef PHMASK
#define PHMASK 0xFFFFFFFFu
#endif
#define EN(i) (((PHMASK) >> (i)) & 1u)
#define IN(k) (lo <= (k) && (k) < hi)
#define SEAM(k) do { if (IN(k) && IN((k) + 1)) xcd_barrier(bar); } while (0)
#define QCTR(ph, slot) (Q.ctl() + CW_Q + ((ph) * 4 + (slot)) * 64)
#define QCTRB(ph, slot, b) (Q.ctl() + CW_Q2 + ((((ph) * 4 + (slot)) * 8 + (int)(b)) * 64))
#define FOR_WG_UNITS(ph, slot, nper, BODY) do { const unsigned myx_ = xb_xcc_id() & 7u; \
        for (unsigned qi_ = 0; qi_ < 8u; ++qi_) { const int bq = (int)((myx_ + qi_) & 7u); \
            for (;;) { if (TID == 0) MISC[16] = __hip_atomic_fetch_add(QCTRB(ph, slot, bq), 1u, RLX_AGENT); __syncthreads(); const unsigned u = MISC[16]; __syncthreads(); \
                if (u >= (unsigned)(nper)) break; BODY; } } } while (0)
#define FOR_UNITS(ph, slot, nper, BODY) do { const unsigned myx_ = xb_xcc_id() & 7u; \
        for (unsigned qi_ = 0; qi_ < 8u; ++qi_) { const int bq = (int)((myx_ + qi_) & 7u); gu32* ctr_ = QCTRB(ph, slot, bq); \
            for (;;) { const unsigned u = pull(ctr_, ln); if (u >= (unsigned)(nper)) break; BODY; } } } while (0)

    if (EN(0) && IN(0)) { prologue(P, (int)blockIdx.x * 512 + TID, G * 512, (int)blockIdx.x * 8 + WAVE, G * 8, LANE, lds + WAVE * 16384); if (PROBE_DUP == 8) prologue(P, (int)blockIdx.x * 512 + TID, G * 512, (int)blockIdx.x * 8 + WAVE, G * 8, LANE, lds + WAVE * 16384); }
    SEAM(0);
    if (EN(1) && IN(1)) {
        { pg8::Gemm g{P.HB(), P.WIN(), MT, DINP, 1024, 1024, 1024}; pg8::StaticOrder S; S.init(MT, DINP, G, (int)blockIdx.x); EpiIn E{P.ss(), P, lds + pg8::STAGE_BYTES};
          pg8::gemm_phase<EpiIn, pg8::StaticOrder, true>(lds, g, S, E);
          if (PROBE_DUP == 21) pg8::gemm_phase<EpiIn, pg8::StaticOrder, true>(lds, g, S, E);
          if (PROBE_DUP == 25) { EpiMemQ E2{P.ss(), (bf16_t*)P.out()}; pg8::gemm_phase<EpiMemQ, pg8::StaticOrder, true>(lds, g, S, E2); } }
        { pg8::Gemm g{P.MEMB(), P.WMKV(), 2048, 1024, 1024, 1024, 1024}; pg8::StaticOrder S; S.init(2048, 1024, G, (int)((blockIdx.x + G / 2) % G));   EpiMemKV E{P};
          pg8::gemm_phase<EpiMemKV, pg8::StaticOrder, false>(lds, g, S, E); }
    }
    SEAM(1);
#pragma unroll
    for (int l = 0; l < 2; ++l) {
        const int pb = 2 + l * NPH_LAYER;
        float* ss_mix = P.ss() + (size_t)(3 * l) * MT; float* ss_a = P.ss() + (size_t)(3 * l + 1) * MT; float* ss_b = P.ss() + (size_t)(3 * l + 2) * MT; float* ss_c = P.ss() + (size_t)(3 * l + 3) * MT;
        (void)ss_mix;
        if (EN(2) && IN(pb + 0)) {
            Bufs Q = P; asm volatile("" : "+s"(Q.ws), "+s"(Q.o_));
            { pg8::Gemm g{Q.KCMP(), Q.WC1() + (size_t)l * 256 * 2048, 4096, 256, 2048, 1024, 2048}; pg8::StaticOrder S; S.init(4096, 256, G, (int)blockIdx.x); EpiCmp1 E{Q.HID(), Q.BIAS1() + l * 256};
              pg8::gemm_phase<EpiCmp1, pg8::StaticOrder, false>(lds, g, S, E); }
            __syncthreads(); __builtin_amdgcn_fence(__ATOMIC_ACQUIRE, "agent"); asm volatile("s_waitcnt vmcnt(0)" ::: "memory"); __syncthreads();
            { pg8::Gemm g{Q.HID(), Q.WC2() + (size_t)l * 256 * 256, 4096, 256, 256, 256, 256}; pg8::StaticOrder S; S.init(4096, 256, G, (int)blockIdx.x); EpiCmp2All E{{Q.KC(), Q.VCT()}};
              pg8::gemm_phase<EpiCmp2All, pg8::StaticOrder, false>(lds, g, S, E); }
            int td = TID; asm volatile("" : "+v"(td)); const int ln = td & 63;
            if (PROBE_DUP == 40 || PROBE_DUP == 42) FOR_WG_UNITS(pb + 0, 2, 128, (dsa_select_wg<0, 1>(Q, bq, 127 - (int)u, ln, WAVE, (LAS unsigned*)lds)));
            else if (PROBE_DUP == 41) FOR_WG_UNITS(pb + 0, 2, 128, (dsa_select_wg<0, 2>(Q, bq, 127 - (int)u, ln, WAVE, (LAS unsigned*)lds)));
            else FOR_WG_UNITS(pb + 0, 2, 128, dsa_select_wg<0>(Q, bq, 127 - (int)u, ln, WAVE, (LAS unsigned*)lds));
            if (PROBE_DUP == 3 && l == 0) FOR_WG_UNITS(pb + 0, 3, 128, dsa_select_wg<0>(Q, bq, 127 - (int)u, ln, WAVE, (LAS unsigned*)lds));
            if (PROBE_DUP == 31 && l == 0) FOR_WG_UNITS(pb + 0, 3, 128, dsa_select_wg<11>(Q, bq, 127 - (int)u, ln, WAVE, (LAS unsigned*)lds));
            if (PROBE_DUP == 32 && l == 0) FOR_WG_UNITS(pb + 0, 3, 128, dsa_select_wg<12>(Q, bq, 127 - (int)u, ln, WAVE, (LAS unsigned*)lds));
            if (PROBE_DUP == 33 && l == 0) FOR_WG_UNITS(pb + 0, 3, 128, dsa_select_wg<13>(Q, bq, 127 - (int)u, ln, WAVE, (LAS unsigned*)lds));
            if (PROBE_DUP == 35 && l == 0) FOR_WG_UNITS(pb + 0, 3, 128, dsa_select_wg<14>(Q, bq, 127 - (int)u, ln, WAVE, (LAS unsigned*)lds));
            if (PROBE_DUP == 36 && l == 0) FOR_WG_UNITS(pb + 0, 3, 128, dsa_select_wg<15>(Q, bq, 127 - (int)u, ln, WAVE, (LAS unsigned*)lds));
            if (PROBE_DUP == 34 && l == 0) FOR_WG_UNITS(pb + 0, 3, 128, dsa_select_wg<10>(Q, bq, 127 - (int)u, ln, WAVE, (LAS unsigned*)lds));
            FOR_UNITS(pb + 0, 1, 512, sb_unit(Q, bq, (int)(u >> 7), (int)(u & 127u), ln));
            if (PROBE_DUP == 2 && l == 0) FOR_UNITS(pb + 0, 0, 512, sb_unit(Q, bq, (int)(u >> 7), (int)(u & 127u), ln));
        }
        SEAM(pb + 0);
        if (EN(3) && IN(pb + 1)) {
            Bufs Q = P; asm volatile("" : "+s"(Q.ws), "+s"(Q.o_));
            int td = TID; asm volatile("" : "+v"(td)); const int ln = td & 63;
            if (PROBE_DUP == 40 || PROBE_DUP == 41 || PROBE_DUP == 43) FOR_UNITS(pb + 1, 1, 128, nsa_cmp_unit<1>(Q, bq, 127 - (int)u, ln, (LAS float*)(lds + WAVE * HWAVE)));
            else FOR_UNITS(pb + 1, 1, 128, nsa_cmp_unit<0>(Q, bq, 127 - (int)u, ln, (LAS float*)(lds + WAVE * HWAVE)));
            FOR_WG_UNITS(pb + 1, 0, 64, dsa_attn_wg(Q, bq, 63 - (int)u, ln, WAVE, td, lds));
            if (PROBE_DUP == 6 && l == 0) FOR_WG_UNITS(pb + 1, 3, 64, dsa_attn_wg(Q, bq, 63 - (int)u, ln, WAVE, td, lds));
            if (PROBE_DUP == 61 && l == 0) FOR_WG_UNITS(pb + 1, 3, 64, dsa_attn_wg<1>(Q, bq, 63 - (int)u, ln, WAVE, td, lds));
            if (PROBE_DUP == 62 && l == 0) FOR_WG_UNITS(pb + 1, 3, 64, dsa_attn_wg<2>(Q, bq, 63 - (int)u, ln, WAVE, td, lds));
            if (PROBE_DUP == 63 && l == 0) FOR_WG_UNITS(pb + 1, 3, 64, dsa_attn_wg<3>(Q, bq, 63 - (int)u, ln, WAVE, td, lds));
        }
        SEAM(pb + 1);
        if (EN(5) && IN(pb + 2)) {
            Bufs Q = P; asm volatile("" : "+s"(Q.ws), "+s"(Q.o_));
            int td = TID; asm volatile("" : "+v"(td)); const int ln = td & 63;
            FOR_WG_UNITS(pb + 2, 1, 64, nsa_selwin_wg(Q, bq, 63 - (int)u, ln, WAVE, td, lds, Q.O3()));
            if (PROBE_DUP == 5 && l == 0) FOR_WG_UNITS(pb + 2, 3, 64, nsa_selwin_wg(Q, bq, 63 - (int)u, ln, WAVE, td, lds, (bf16_t*)Q.out()));
        }
        SEAM(pb + 2);
        if (EN(6) && IN(pb + 3)) {
            Bufs Q = P; asm volatile("" : "+s"(Q.ws), "+s"(Q.o_));
            pg8::ChainOrder3 S; S.init(MT, 1024, G, (int)blockIdx.x);
            pg8::Gemm g{Q.O3(), Q.WUP() + (size_t)l * 3 * 1024 * 256, MT, 1024, 256, 768, 256, (size_t)256 * 2, (size_t)1024 * 256 * 2};
            EpiMerge E{Q.PG(), Q.MG()};
            pg8::gemm_phase<EpiMerge, pg8::ChainOrder3, true>(lds, g, S, E);
        }
        SEAM(pb + 3);
        if (EN(7) && IN(pb + 4)) {
            Bufs Q = P; asm volatile("" : "+s"(Q.ws), "+s"(Q.o_));
            pg8::Gemm g{Q.MG(), Q.WOUT() + (size_t)l * 1024 * 1024, MT, 1024, 1024, 1024, 1024}; pg8::StaticOrder S; S.init(MT, 1024, G, (int)blockIdx.x);
            EpiResid E{l == 0 ? Q.x() : (const float*)Q.out(), Q.out(), Q.HB(), ss_a};
            pg8::gemm_phase<EpiResid, pg8::StaticOrder, true>(lds, g, S, E);
            if (PROBE_DUP == 24 && l == 0) { EpiResid E2{Q.x(), Q.out(), Q.HB(), (float*)Q.TAU()}; pg8::gemm_phase<EpiResid, pg8::StaticOrder, true>(lds, g, S, E2); }
        }
        SEAM(pb + 4);
        if (EN(8) && IN(pb + 5)) {
            Bufs Q = P; asm volatile("" : "+s"(Q.ws), "+s"(Q.o_));
            pg8::Gemm g{Q.HB(), Q.WMQ() + (size_t)l * 256 * 1024, MT, 256, 1024, 1024, 1024}; pg8::StaticOrder S; S.init(MT, 256, G, (int)blockIdx.x); EpiMemQ E{ss_a, Q.QM()};
            pg8::gemm_phase<EpiMemQ, pg8::StaticOrder, false>(lds, g, S, E);
            if (PROBE_DUP == 28 && l == 0) pg8::gemm_phase<EpiMemQ, pg8::StaticOrder, false>(lds, g, S, E);
        }
        SEAM(pb + 5);
        if (EN(9) && IN(pb + 6)) {
            Bufs Q = P; asm volatile("" : "+s"(Q.ws), "+s"(Q.o_));
            int td = TID; asm volatile("" : "+v"(td)); const int ln = td & 63;
            FOR_WG_UNITS(pb + 6, 0, 64, mem_attn_wg(Q, l, bq, (int)(u & 3u), (int)(u >> 2), ln, WAVE, td, lds));
            if (PROBE_DUP == 7 && l == 0) FOR_WG_UNITS(pb + 6, 3, 64, mem_attn_wg(Q, l, bq, (int)(u & 3u), (int)(u >> 2), ln, WAVE, td, lds));
        }
        SEAM(pb + 6);
        if (EN(10) && IN(pb + 7)) {
            Bufs Q = P; asm volatile("" : "+s"(Q.ws), "+s"(Q.o_));
            pg8::Gemm g{Q.OM(), Q.WMO() + (size_t)l * 1024 * 256, MT, 1024, 256, 256, 256}; pg8::StaticOrder S; S.init(MT, 1024, G, (int)blockIdx.x);
            EpiResid E{Q.out(), Q.out(), Q.HB(), ss_b};
            pg8::gemm_phase<EpiResid, pg8::StaticOrder, true>(lds, g, S, E);
            if (PROBE_DUP == 27 && l == 0) { EpiResidT<true> E2{Q.out(), Q.out(), Q.PA(), (float*)Q.TAU()}; pg8::gemm_phase<EpiResidT<true>, pg8::StaticOrder, true>(lds, g, S, E2); }
        }
        SEAM(pb + 7);
        if (EN(11) && IN(pb + 8)) {
            Bufs Q = P; asm volatile("" : "+s"(Q.ws), "+s"(Q.o_));
            pg8::Gemm g{Q.HB(), Q.WFI() + (size_t)l * 5632 * 1024, MT, 5632, 1024, 1024, 1024}; pg8::StaticOrder S; S.init(MT, 5632, G, (int)blockIdx.x); EpiFfnIn E{ss_b, Q.ACT()};
            pg8::gemm_phase<EpiFfnIn, pg8::StaticOrder, true>(lds, g, S, E);
            if (PROBE_DUP == 22 && l == 0) pg8::gemm_phase<EpiFfnIn, pg8::StaticOrder, true>(lds, g, S, E);
        }
        SEAM(pb + 8);
        if (EN(12) && IN(pb + 9)) {
            Bufs Q = P; asm volatile("" : "+s"(Q.ws), "+s"(Q.o_));
            pg8::Gemm g{Q.ACT(), Q.WFO() + (size_t)l * 1024 * DFF, MT, 1024, DFF, DFF, DFF}; pg8::StaticOrder S; S.init(MT, 1024, G, (int)blockIdx.x);
            EpiResid E{Q.out(), Q.out(), Q.HB(), ss_c};
            pg8::gemm_phase<EpiResid, pg8::StaticOrder, true>(lds, g, S, E);
            if (PROBE_DUP == 26 && l == 0) { EpiResidT<true> E2{Q.out(), Q.out(), Q.PA(), (float*)Q.TAU()}; pg8::gemm_phase<EpiResidT<true>, pg8::StaticOrder, true>(lds, g, S, E2); }
        }
        SEAM(pb + 9);
        if (EN(13) && IN(pb + 10) && l == 0) {
            Bufs Q = P; asm volatile("" : "+s"(Q.ws), "+s"(Q.o_));
            pg8::Gemm g{Q.HB(), Q.WIN() + (size_t)DINP * 1024, MT, DINP, 1024, 1024, 1024}; pg8::StaticOrder S; S.init(MT, DINP, G, (int)blockIdx.x); EpiIn E{ss_c, Q, lds + pg8::STAGE_BYTES};
            pg8::gemm_phase<EpiIn, pg8::StaticOrder, true>(lds, g, S, E);
        }
        if (l == 0) SEAM(pb + 10);
    }
    if (PROBE_DUP == 30) { for (int i = 0; i < 20; ++i) xcd_barrier(bar); }
    if (EN(15) && IN(PH_FINAL)) {
        const float* ssf = P.ss() + (size_t)6 * MT;
        const int lane = LANE, gwave = (int)blockIdx.x * 8 + WAVE, gwaves = G * 8;
        const unsigned chkflag = (PROBE_DUP >= 40 && PROBE_DUP <= 43) ? __hip_atomic_load(P.ctl() + 2, RLX_AGENT) : 0u;
        for (int row = gwave; row < MT; row += gwaves) {
            const float rs = rs_of(ssf[row]); float* o = P.out() + (size_t)row * 1024;
#pragma unroll
            for (int j = 0; j < 4; ++j) { const f32x4 v = *(const GAS f32x4*)(o + 256 * j + 4 * lane), g = *(const GAS f32x4*)(P.norm_final() + 256 * j + 4 * lane); *(GAS f32x4*)(o + 256 * j + 4 * lane) = v * rs * g; }
            if (chkflag && row == 0 && lane < 2) o[lane] = (chkflag & (1u << lane)) ? __builtin_nanf("") : o[lane];
        }
    }
#undef IN
#undef SEAM
#undef QCTR
}

extern "C" void kernel_launch(void* const* d_in, const int* in_sizes, int n_in, void* d_out, int out_size, void* d_ws, size_t ws_size, hipStream_t stream) {
    static int grid = 0;
    if (grid == 0) {
        if (n_in != 21 || in_sizes[0] != MT * DM || out_size != MT * DM || ws_size < WS_END) {
            fprintf(stderr, "kernel_launch: unexpected problem: n_in %d in0 %d out %d ws %zu (need %zu); nothing launched\n", n_in, n_in > 0 ? in_sizes[0] : -1, out_size, ws_size, (size_t)WS_END); grid = -1; return; }
        int dev = 0, cus = 0, per_cu = 0;
        if (hipGetDevice(&dev) != hipSuccess || hipDeviceGetAttribute(&cus, hipDeviceAttributeMultiprocessorCount, dev) != hipSuccess) { grid = -1; return; }
        if (hipFuncSetAttribute((const void*)mk_fwd, hipFuncAttributeMaxDynamicSharedMemorySize, LDS_BYTES) != hipSuccess) { fprintf(stderr, "kernel_launch: hipFuncSetAttribute failed\n"); grid = -1; return; }
        if (hipOccupancyMaxActiveBlocksPerMultiprocessor(&per_cu, (const void*)mk_fwd, 512, LDS_BYTES) != hipSuccess || per_cu < 1)
            fprintf(stderr, "kernel_launch: note: occupancy query reports %d workgroups per CU\n", per_cu);
        (void)hipGetLastError();
        grid = cus;
    }
    if (grid < 0) return;
    if (hipMemsetAsync((char*)d_ws + WS_CTL, 0, CTL_ZERO_BYTES, stream) != hipSuccess) { fprintf(stderr, "kernel_launch: memset failed\n"); return; }
    Args a{};
    for (int i = 0; i < 21; ++i) a.P.in[i] = (const float*)d_in[i];
    a.P.o_ = (float*)d_out; a.P.ws = (unsigned char*)d_ws;
#if MK_ONE_LAUNCH
    a.ph_lo = 0; a.ph_hi = NPHASES;
    hipLaunchKernelGGL(mk_fwd, dim3(grid), dim3(512), LDS_BYTES, stream, a);
#else
    for (int ph = 0; ph < NPHASES; ++ph) { a.ph_lo = ph; a.ph_hi = ph + 1; hipLaunchKernelGGL(mk_fwd, dim3(grid), dim3(512), LDS_BYTES, stream, a); }
#endif
    const hipError_t le = hipPeekAtLastError();
    if (le != hipSuccess) fprintf(stderr, "kernel_launch: launch failed: %s\n", hipGetErrorName(le));
}
```

```cpp
#include <hip/hip_runtime.h>
#include <cstdio>
#include <cstdint>
#include <type_traits>

#define DI __device__ __forceinline__
#define GAS __attribute__((address_space(1)))
#define LAS __attribute__((address_space(3)))
typedef unsigned short bf16_t;
typedef short bf16x8 __attribute__((ext_vector_type(8)));
typedef short s16x4 __attribute__((ext_vector_type(4)));
typedef float f32x4 __attribute__((ext_vector_type(4)));
typedef float f32x2 __attribute__((ext_vector_type(2)));
typedef float f32x16 __attribute__((ext_vector_type(16)));
typedef unsigned u32x4 __attribute__((ext_vector_type(4)));
typedef unsigned u32x2 __attribute__((ext_vector_type(2)));
typedef GAS unsigned gu32;
typedef __bf16 bf16x2_t __attribute__((ext_vector_type(2)));
#define RLX_AGENT __ATOMIC_RELAXED, __HIP_MEMORY_SCOPE_AGENT

DI unsigned cvtpk(float lo, float hi) { f32x2 v = {lo, hi}; bf16x2_t b = __builtin_convertvector(v, bf16x2_t); return __builtin_bit_cast(unsigned, b); }
DI float bf2f(bf16_t h) { return __builtin_bit_cast(float, (unsigned)h << 16); }
DI float bflo(unsigned w) { return __builtin_bit_cast(float, w << 16); }
DI float bfhi(unsigned w) { return __builtin_bit_cast(float, w & 0xffff0000u); }

namespace pg8 {
constexpr int BM = 256, BK = 64, HALF = 128, HTB = HALF * BK * 2  , STAGE_BYTES = 8 * HTB, NXCD = 8, WGM = 8;

__host__ __device__ __forceinline__ int lds_byte(int r, int c) { const int st = (r >> 4) * 2 + (c >> 5), rr = r & 15, cc = c & 31, ob = rr * 64 + cc * 2; return st * 1024 + (ob ^ (((ob >> 9) & 1) << 5)); }
__host__ __device__ __forceinline__ void stage_rc(int b, int& R, int& C) { const int st = b / 1024, sb = b % 1024, swz = sb ^ (((sb >> 9) & 1) << 5); R = (st >> 1) * 16 + swz / 64; C = (st & 1) * 32 + (swz % 64) / 2; }
__host__ __device__ __forceinline__ int perm32(int rho) { const int n = rho >> 4, i = rho & 15; return 8 * (i >> 2) + 4 * n + (i & 3); }

struct Unit { int pm, pn, br; };
struct Gemm { const bf16_t* A; const bf16_t* Bt; int M, N, K, lda, ldb; size_t brA = 0, brB = 0; };

struct StaticOrder {
    int nM, nN, nwg, G, c;
    __host__ __device__ __forceinline__ void init(int M, int N, int G_, int c_) { nM = M / BM; nN = N / BM; nwg = nM * nN; G = G_; c = c_; }
    __host__ __device__ __forceinline__ bool next(int i, Unit& u) const {
        const long L = (long)i * G + c; if (L >= nwg) return false;
        int wgid = (int)L; { const int q = nwg / NXCD, r = nwg % NXCD, xcd = wgid % NXCD, off = wgid / NXCD; wgid = (xcd < r ? xcd * (q + 1) : r * (q + 1) + (xcd - r) * q) + off; }
        const int nig = WGM * nN, gid = wgid / nig, fm = gid * WGM, gsz = (nM - fm) < WGM ? (nM - fm) : WGM;
        u.pm = fm + ((wgid % nig) % gsz); u.pn = (wgid % nig) / gsz; u.br = 0; return true;
    }
    __device__ __forceinline__ void a_ready(const Unit&) const {}
    __device__ __forceinline__ void done(const Unit&) const {}
};

struct ChainOrder3 : StaticOrder {
    __host__ __device__ __forceinline__ bool next(int i, Unit& u) const { const int t = i / 3; if (!StaticOrder::next(t, u)) return false; u.br = i - 3 * t; return true; }
};

template <class Epi, class Sched, bool ALIGN_EPI = false>
__device__ __forceinline__ void gemm_phase(LAS unsigned char* lds, const Gemm g, const Sched& S, const Epi& E) {
    int tid = threadIdx.x; asm volatile("" : "+v"(tid));
    const int wid = __builtin_amdgcn_readfirstlane(tid >> 6), lane = tid & 63, wr = wid >> 2, wc = wid & 3, fr = lane & 15, fq = lane >> 4;
    const int K = g.K, nt = K / BK;
    unsigned voffA[2], voffB[2];
#pragma unroll
    for (int i = 0; i < 2; ++i) { int R, C; stage_rc(tid * 16 + i * 8192, R, C); const int Rb = Epi::PERM ? ((R & ~31) + perm32(R & 31)) : R;
        voffA[i] = (unsigned)(R * g.lda + C) * 2u; voffB[i] = (unsigned)(Rb * g.ldb + C) * 2u; }
    const size_t kstep = (size_t)(BK * 2);
    const size_t hstepA = (size_t)HALF * g.lda * 2, hstepB = (size_t)HALF * g.ldb * 2;
    const size_t tstepA = 2 * hstepA, tstepB = 2 * hstepB;
    const unsigned ldsw = (unsigned)wid * 1024u;
    const int aoff = lds_byte(wr * 64 + fr, fq * 8), boff = lds_byte(wc * 32 + fr, fq * 8);
#define PG8_SA(b, h) (((b) * 2 + (h)) * HTB)
#define PG8_SB(b, h) ((4 + (b) * 2 + (h)) * HTB)
#define PG8_STAGE(bufoff, gbase, voff) do { _Pragma("unroll") for (int _i = 0; _i < 2; ++_i) \
        __builtin_amdgcn_global_load_lds((const unsigned*)((const char*)(gbase) + (voff)[_i]), (LAS unsigned*)(lds + (bufoff) + ldsw + _i * 8192), 16, 0, 0); } while (0)
#define PG8_LDA(dst, b, h) do { _Pragma("unroll") for (int m = 0; m < 4; ++m) _Pragma("unroll") for (int k = 0; k < 2; ++k) dst[m][k] = *(const LAS bf16x8*)(lds + PG8_SA(b, h) + aoff + m * 2048 + k * 1024); } while (0)
#define PG8_LDB(dst, b, h) do { _Pragma("unroll") for (int n = 0; n < 2; ++n) _Pragma("unroll") for (int k = 0; k < 2; ++k) dst[n][k] = *(const LAS bf16x8*)(lds + PG8_SB(b, h) + boff + n * 2048 + k * 1024); } while (0)
#define PG8_MMA(ai, bj, At, Bt) do { __builtin_amdgcn_s_setprio(1); _Pragma("unroll") for (int m = 0; m < 4; ++m) _Pragma("unroll") for (int n = 0; n < 2; ++n) _Pragma("unroll") for (int k = 0; k < 2; ++k) \
        acc[ai][bj][m][n] = __builtin_amdgcn_mfma_f32_16x16x32_bf16(Bt[n][k], At[m][k], acc[ai][bj][m][n], 0, 0, 0); __builtin_amdgcn_s_setprio(0); } while (0)
#define PG8_WAIT_V(n) asm volatile("s_waitcnt vmcnt(" #n ")" ::: "memory")
#define PG8_WAIT_L(n) asm volatile("s_waitcnt lgkmcnt(" #n ")" ::: "memory")
#define PG8_BAR __builtin_amdgcn_s_barrier()
#define PG8_SCHED __builtin_amdgcn_sched_barrier(0)
    Unit cur, nxt; int ui = 0;
    if (!S.next(0, cur)) return;
    f32x4 acc[2][2][4][2];
#pragma unroll
    for (int a = 0; a < 2; ++a)
#pragma unroll
        for (int b = 0; b < 2; ++b)
#pragma unroll
            for (int m = 0; m < 4; ++m)
#pragma unroll
                for (int n = 0; n < 2; ++n) acc[a][b][m][n] = (f32x4){0.f, 0.f, 0.f, 0.f};
    bf16x8 At[4][2], B0[2][2], B1[2][2];
    const char* cA = (const char*)g.A + (size_t)cur.pm * tstepA + (size_t)cur.br * g.brA; const char* cB = (const char*)g.Bt + (size_t)cur.pn * tstepB + (size_t)cur.br * g.brB;
    S.a_ready(cur);
    PG8_STAGE(PG8_SB(0, 0), cB, voffB); PG8_STAGE(PG8_SB(0, 1), cB + hstepB, voffB); PG8_STAGE(PG8_SA(0, 0), cA, voffA); PG8_STAGE(PG8_SA(0, 1), cA + hstepA, voffA);
    if (wr == 1) PG8_BAR;
    PG8_WAIT_V(2); PG8_BAR;
    PG8_STAGE(PG8_SB(1, 0), cB + kstep, voffB); PG8_STAGE(PG8_SA(1, 0), cA + kstep, voffA); PG8_STAGE(PG8_SB(1, 1), cB + hstepB + kstep, voffB);
    PG8_WAIT_V(6); PG8_BAR;
    for (;;) {
        const bool has_next = S.next(ui + 1, nxt);
        const char* nA = has_next ? (const char*)g.A + (size_t)nxt.pm * tstepA + (size_t)nxt.br * g.brA : cA; const char* nB = has_next ? (const char*)g.Bt + (size_t)nxt.pn * tstepB + (size_t)nxt.br * g.brB : cB;
#pragma clang loop unroll(disable)
        for (int t = 0; t < nt; t += 2) {
            const bool last = (t == nt - 2);
            const char* a1 = cA + (size_t)(t + 1) * kstep;
            const char* a2 = last ? nA : cA + (size_t)(t + 2) * kstep; const char* b2 = last ? nB : cB + (size_t)(t + 2) * kstep;
            const char* a3 = a2 + kstep; const char* b3 = b2 + kstep;
            if (last && has_next) S.a_ready(nxt);
            PG8_LDB(B0, 0, 0); PG8_LDB(B1, 0, 1); PG8_SCHED; PG8_LDA(At, 0, 0); PG8_STAGE(PG8_SA(1, 1), a1 + hstepA, voffA);
            PG8_WAIT_V(8); PG8_WAIT_L(0); PG8_BAR; PG8_MMA(0, 0, At, B0); PG8_MMA(0, 1, At, B1); PG8_BAR; PG8_SCHED;
            PG8_LDA(At, 0, 1); PG8_STAGE(PG8_SB(0, 0), b2, voffB); PG8_STAGE(PG8_SB(0, 1), b2 + hstepB, voffB); PG8_STAGE(PG8_SA(0, 0), a2, voffA);
            PG8_WAIT_V(8); PG8_WAIT_L(0); PG8_BAR; PG8_MMA(1, 0, At, B0); PG8_MMA(1, 1, At, B1); PG8_BAR; PG8_SCHED;
            PG8_LDB(B0, 1, 0); PG8_LDB(B1, 1, 1); PG8_SCHED; PG8_LDA(At, 1, 0); PG8_STAGE(PG8_SA(0, 1), a2 + hstepA, voffA);
            PG8_WAIT_V(8); PG8_WAIT_L(0); PG8_BAR; PG8_MMA(0, 0, At, B0); PG8_MMA(0, 1, At, B1); PG8_BAR; PG8_SCHED;
            PG8_LDA(At, 1, 1); PG8_STAGE(PG8_SB(1, 0), b3, voffB); PG8_STAGE(PG8_SB(1, 1), b3 + hstepB, voffB); PG8_STAGE(PG8_SA(1, 0), a3, voffA);
            PG8_WAIT_V(8); PG8_WAIT_L(0); PG8_BAR; PG8_MMA(1, 0, At, B0); PG8_MMA(1, 1, At, B1); PG8_BAR; PG8_SCHED;
        }
        if constexpr (ALIGN_EPI) { if (wr == 0) PG8_BAR; }
        E(acc, cur, wr, wc, fr, fq); S.done(cur);
        if (!has_next) break;
#pragma unroll
        for (int a = 0; a < 2; ++a)
#pragma unroll
            for (int b = 0; b < 2; ++b)
#pragma unroll
                for (int m = 0; m < 4; ++m)
#pragma unroll
                    for (int n = 0; n < 2; ++n) acc[a][b][m][n] = (f32x4){0.f, 0.f, 0.f, 0.f};
        cur = nxt; cA = nA; cB = nB; ++ui;
        if constexpr (ALIGN_EPI) { if (wr == 1) PG8_BAR; }
    }
    PG8_WAIT_V(0);
    if constexpr (!ALIGN_EPI) { if (wr == 0) PG8_BAR; }
    PG8_BAR;
#undef PG8_SA
#undef PG8_SB
#undef PG8_STAGE
#undef PG8_LDA
#undef PG8_LDB
#undef PG8_MMA
#undef PG8_WAIT_V
#undef PG8_WAIT_L
#undef PG8_BAR
#undef PG8_SCHED
}
}
constexpr int NB = 8, SQ = 4096, DM = 1024, MT = NB * SQ;
constexpr int DIN = 5200, DINP = 5376, DFF = 2816, NMEM = 256;
constexpr int PAP = 1600;
constexpr int C_QA = 0, C_KA = 256, C_QB = 512, C_QI = 768, C_QC = 1024, C_KB = 1280, C_KI = 1344, C_KSEL = 1472, C_KWIN = 1536;
constexpr float LOG2E = 1.4426950408889634f;
constexpr float C2 = 0.125f * LOG2E;
constexpr float RMS_EPS = 1e-6f;

#define MFMA32(a, b, c) __builtin_amdgcn_mfma_f32_32x32x16_bf16((a), (b), (c), 0, 0, 0)
DI int crow(int i, int hh) { return (i & 3) + 8 * (i >> 2) + 4 * hh; }
DI bf16x8 ldg16(const bf16_t* p) { return *(const GAS bf16x8*)p; }
DI bf16x8 ld_vt(const bf16_t* p) { const s16x4 lo = *(const GAS s16x4*)p, hi = *(const GAS s16x4*)(p + 8); return __builtin_shufflevector(lo, hi, 0, 1, 2, 3, 4, 5, 6, 7); }
DI bf16x8 pack8(const f32x16& x, int s) { u32x4 p; p.x = cvtpk(x[8 * s], x[8 * s + 1]); p.y = cvtpk(x[8 * s + 2], x[8 * s + 3]); p.z = cvtpk(x[8 * s + 4], x[8 * s + 5]); p.w = cvtpk(x[8 * s + 6], x[8 * s + 7]); return __builtin_bit_cast(bf16x8, p); }
DI unsigned shx32u(unsigned v) { auto rr = __builtin_amdgcn_permlane32_swap(v, v, false, false); return (threadIdx.x & 32u) ? rr[0] : rr[1]; }
DI float shx32(float v) { return __uint_as_float(shx32u(__float_as_uint(v))); }
DI f32x16 zero16() { f32x16 z; _Pragma("unroll") for (int i = 0; i < 16; ++i) z[i] = 0.f; return z; }
DI unsigned pull(gu32* ctr, int lane) { unsigned v = 0; if (lane == 0) v = __hip_atomic_fetch_add(ctr, 1u, RLX_AGENT); return (unsigned)__builtin_amdgcn_readfirstlane((int)v); }
DI unsigned bitif(bool c, int i) { unsigned b = c ? 1u : 0u; asm("" : "+v"(b)); return b << i; }
DI float fexp2(float x) { return __builtin_amdgcn_exp2f(x); }
DI float flog2(float x) { return __builtin_amdgcn_logf(x); }

DI f32x16 qk_tile(const bf16_t* kp, const bf16x8 (&qf)[4]) {
    bf16x8 kf[4];
#pragma unroll
    for (int s = 0; s < 4; ++s) kf[s] = ldg16(kp + 16 * s);
    f32x16 z = zero16();
#pragma unroll
    for (int s = 0; s < 4; ++s) z = MFMA32(kf[s], qf[s], z);
    return z;
}
DI void pv_tile(f32x16& o0, f32x16& o1, const bf16_t* vp, size_t vts, const f32x16& p) {
#pragma unroll
    for (int s = 0; s < 2; ++s) {
        const bf16x8 pf = pack8(p, s);
        const bf16x8 v0 = ld_vt(vp + 16 * s), v1 = ld_vt(vp + 32 * vts + 16 * s);
        o0 = MFMA32(v0, pf, o0); o1 = MFMA32(v1, pf, o1);
    }
}
DI void store_ot(bf16_t* orow, const f32x16& o0, const f32x16& o1, float sc, int hh) {
#pragma unroll
    for (int g = 0; g < 4; ++g) {
        u32x2 w0, w1;
        w0.x = cvtpk(o0[4 * g] * sc, o0[4 * g + 1] * sc); w0.y = cvtpk(o0[4 * g + 2] * sc, o0[4 * g + 3] * sc);
        w1.x = cvtpk(o1[4 * g] * sc, o1[4 * g + 1] * sc); w1.y = cvtpk(o1[4 * g + 2] * sc, o1[4 * g + 3] * sc);
        *(GAS u32x2*)(orow + 8 * g + 4 * hh) = w0; *(GAS u32x2*)(orow + 32 + 8 * g + 4 * hh) = w1;
    }
}

struct KV { bf16x8 k[4]; bf16x8 v[4]; };
DI void load_k4(bf16x8 (&k)[4], const bf16_t* kp) {
#pragma unroll
    for (int s = 0; s < 4; ++s) k[s] = ldg16(kp + 16 * s);
}
DI void load_kv(KV& t, const bf16_t* kp, const bf16_t* vp, size_t vts) {
    load_k4(t.k, kp);
#pragma unroll
    for (int s = 0; s < 2; ++s) { t.v[2 * s] = ld_vt(vp + 16 * s); t.v[2 * s + 1] = ld_vt(vp + 32 * vts + 16 * s); }
}
DI f32x16 qk_frag(const bf16x8 (&kf)[4], const bf16x8 (&qf)[4]) {
    f32x16 z = zero16();
#pragma unroll
    for (int s = 0; s < 4; ++s) z = MFMA32(kf[s], qf[s], z);
    return z;
}
DI void pv_frag(f32x16& o0, f32x16& o1, const bf16x8 (&v)[4], const f32x16& p) {
#pragma unroll
    for (int s = 0; s < 2; ++s) { const bf16x8 pf = pack8(p, s); o0 = MFMA32(v[2 * s], pf, o0); o1 = MFMA32(v[2 * s + 1], pf, o1); }
}
constexpr float SM_THR = 10.f;
template <bool MASKED = true> DI void softmax_step(f32x16& z, unsigned vm, float& m, float& l, f32x16& o0, f32x16& o1) {
    const float ninf = -__builtin_inff();
    if (MASKED) {
#pragma unroll
    for (int i = 0; i < 16; ++i) z[i] = ((vm >> i) & 1u) ? z[i] : ninf; }
    float t0 = __builtin_fmaxf(__builtin_fmaxf(z[0], z[1]), z[2]), t1 = __builtin_fmaxf(__builtin_fmaxf(z[3], z[4]), z[5]), t2 = __builtin_fmaxf(__builtin_fmaxf(z[6], z[7]), z[8]),
          t3 = __builtin_fmaxf(__builtin_fmaxf(z[9], z[10]), z[11]), t4 = __builtin_fmaxf(__builtin_fmaxf(z[12], z[13]), z[14]);
    float tm = __builtin_fmaxf(__builtin_fmaxf(__builtin_fmaxf(t0, t1), __builtin_fmaxf(t2, t3)), __builtin_fmaxf(t4, z[15]));
    tm = __builtin_fmaxf(tm, shx32(tm));
    const float mc = __builtin_fmaxf(m, tm);
    if (__any(mc > m + SM_THR)) {
        const float alpha = fexp2(m - mc);
        l *= alpha;
#pragma unroll
        for (int i = 0; i < 16; ++i) { o0[i] *= alpha; o1[i] *= alpha; }
        m = mc;
    }
    float ls = 0.f;
#pragma unroll
    for (int i = 0; i < 16; ++i) { z[i] = fexp2(z[i] - m); ls += z[i]; }
    l += ls;
}
DI float sm_meff(float m) { return m > -1e29f ? m : 0.f; }
DI f32x16 qk_frag_init(const bf16x8 (&kf)[4], const bf16x8 (&qf)[4], const f32x16& init) {
    f32x16 z = init;
#pragma unroll
    for (int s = 0; s < 4; ++s) z = MFMA32(kf[s], qf[s], z);
    return z;
}
DI float max_x32(float v) { auto rr = __builtin_amdgcn_permlane32_swap(__float_as_uint(v), __float_as_uint(v), false, false); return fmaxf(__uint_as_float(rr[0]), __uint_as_float(rr[1])); }
DI float add_x32(float v) { auto rr = __builtin_amdgcn_permlane32_swap(__float_as_uint(v), __float_as_uint(v), false, false); return __uint_as_float(rr[0]) + __uint_as_float(rr[1]); }
DI void softmax_core(f32x16& z, float& m, float& l, f32x16& o0, f32x16& o1) {
    float t0 = __builtin_fmaxf(__builtin_fmaxf(z[0], z[1]), z[2]), t1 = __builtin_fmaxf(__builtin_fmaxf(z[3], z[4]), z[5]), t2 = __builtin_fmaxf(__builtin_fmaxf(z[6], z[7]), z[8]),
          t3 = __builtin_fmaxf(__builtin_fmaxf(z[9], z[10]), z[11]), t4 = __builtin_fmaxf(__builtin_fmaxf(z[12], z[13]), z[14]);
    float tm = __builtin_fmaxf(__builtin_fmaxf(__builtin_fmaxf(t0, t1), __builtin_fmaxf(t2, t3)), __builtin_fmaxf(t4, z[15]));
    tm = max_x32(tm);
    const bool started = m > -1e29f, haskey = tm > -3e38f;
    if (__any(started ? (tm > SM_THR) : haskey)) {
        const float delta = started ? __builtin_fmaxf(tm, 0.f) : (haskey ? tm : 0.f);
        const float alpha = started ? fexp2(-delta) : 1.f;
        l *= alpha;
#pragma unroll
        for (int i = 0; i < 16; ++i) { o0[i] *= alpha; o1[i] *= alpha; z[i] -= delta; }
        m = started ? m + delta : (haskey ? tm : m);
    }
    float ls = 0.f;
#pragma unroll
    for (int i = 0; i < 16; ++i) { z[i] = fexp2(z[i]); ls += z[i]; }
    l += ls;
}
template <bool SKIP, class MaskFn>
DI void attn_tiles(f32x16& o0, f32x16& o1, float& m, float& l, const bf16x8 (&qf)[4], const bf16_t* kbase, size_t kpitch, const bf16_t* vtbase, size_t vts,
                   int kt_lo, int kt_hi, const MaskFn& mask, int r, int hh) {
    const bf16_t* kl = kbase + (size_t)r * kpitch + 8 * hh; const bf16_t* vl = vtbase + (size_t)r * vts + 4 * hh;
    int kt = kt_lo; unsigned vm = 0u;
    if (SKIP) { for (; kt <= kt_hi; ++kt) { vm = mask(kt); if (__any(vm != 0u)) break; } } else { if (kt <= kt_hi) vm = mask(kt); }
    if (kt > kt_hi) return;
    KV cur; load_kv(cur, kl + (size_t)(kt * 32) * kpitch, vl + kt * 32, vts);
    for (;;) {
        int kn = kt + 1; unsigned vmn = 0u;
        if (SKIP) { for (; kn <= kt_hi; ++kn) { vmn = mask(kn); if (__any(vmn != 0u)) break; } } else { if (kn <= kt_hi) vmn = mask(kn); }
        const bool more = kn <= kt_hi;
        KV nxt = cur; if (more) load_kv(nxt, kl + (size_t)(kn * 32) * kpitch, vl + kn * 32, vts);
        f32x16 z = qk_frag(cur.k, qf);
        softmax_step(z, vm, m, l, o0, o1);
        pv_frag(o0, o1, cur.v, z);
        if (!more) break;
        cur = nxt; vm = vmn; kt = kn;
    }
}
DI void load_q(bf16x8 (&qf)[4], const bf16_t* qp) {
#pragma unroll
    for (int s = 0; s < 4; ++s) qf[s] = ldg16(qp + 16 * s);
}

constexpr size_t MiB = 1u << 20;
constexpr size_t WS_CTL = 0, CTL_ZERO_BYTES = 2 * MiB;
constexpr size_t WS_ROPE = 2 * MiB, WS_WG = 3 * MiB, WS_TAU = 5 * MiB, WS_RR = WS_TAU + 128 * 1024, WS_BM = WS_TAU + 256 * 1024, WS_BIAS1 = WS_TAU + 512 * 1024;
constexpr size_t WS_KC = 6 * MiB, WS_VCT = WS_KC + 256 * 1024, WS_HID = WS_KC + 512 * 1024;
constexpr size_t WS_MEMB = 9 * MiB, WS_KMEM = 13 * MiB, WS_VMEMT = 15 * MiB;
constexpr size_t WS_KCMP = 17 * MiB, WS_VCMP = 21 * MiB;
constexpr size_t WS_VAT = 26 * MiB, WS_VBT = 42 * MiB, WS_VST = 46 * MiB, WS_VWT = 50 * MiB;
constexpr size_t WS_WIN = 54 * MiB, WS_WFI = 75 * MiB, WS_WFO = 97 * MiB, WS_WOUT = 108 * MiB, WS_WUP = 112 * MiB, WS_WMQ = 115 * MiB, WS_WMKV = 116 * MiB, WS_WMO = 118 * MiB,
                 WS_WC1 = 119 * MiB, WS_WC2 = 121 * MiB;
constexpr size_t WS_HB = 122 * MiB;
constexpr size_t WS_PA = 186 * MiB;
constexpr size_t WS_PG = 286 * MiB;
constexpr size_t WS_END = 478 * MiB;
static_assert(WS_VCMP == WS_KCMP + (size_t)MT * 64 * 2, "compact cmp buffers must be adjacent");
static_assert(WS_PA + (size_t)MT * PAP * 2 <= WS_PG && WS_PG + (size_t)MT * 3072 * 2 <= WS_END && WS_HB + 64 * MiB <= WS_PA, "ws map");
static_assert(WS_WIN + (size_t)2 * DINP * 1024 * 2 <= WS_WFI && WS_WFI + (size_t)2 * 5632 * 1024 * 2 <= WS_WFO && WS_WFO + (size_t)2 * 1024 * DFF * 2 <= WS_WOUT, "weights map");
constexpr int CW_TMO = 0, CW_BAR = 4096, CW_Q = 8192, CW_SS = 32768, CW_SSM = CW_SS + 7 * MT, CW_Q2 = CW_SSM + 2048;
static_assert((size_t)(CW_Q2 + 32 * 4 * 8 * 64) * 4 <= CTL_ZERO_BYTES, "ctl region");
struct Bufs {
    const float* in[21]; float* o_; unsigned char* ws;
#define BIN(name, idx) DI const float* name() const { return in[idx]; }
    BIN(x, 0) BIN(mem, 1) BIN(norm_mix, 2) BIN(w_in, 3) BIN(cmp_pos_k, 4) BIN(cmp_w1_k, 5) BIN(cmp_w2_k, 6) BIN(cmp_pos_v, 7) BIN(cmp_w1_v, 8) BIN(cmp_w2_v, 9) BIN(w_up, 10) BIN(w_out, 11)
    BIN(norm_mem_q, 12) BIN(norm_mem_kv, 13) BIN(w_mem_q, 14) BIN(w_mem_kv, 15) BIN(w_mem_o, 16) BIN(norm_ffn, 17) BIN(w_ffn_in, 18) BIN(w_ffn_out, 19) BIN(norm_final, 20)
#undef BIN
#define BWS(type, name, off) DI type* name() const { return (type*)(ws + (off)); }
    DI float* out() const { return o_; }
    DI gu32* ctl() const { return (gu32*)(ws + WS_CTL); }
    BWS(float, ss, WS_CTL + (size_t)CW_SS * 4) BWS(float, ssm, WS_CTL + (size_t)CW_SSM * 4)
    BWS(f32x2, rope, WS_ROPE) BWS(float, WG, WS_WG) BWS(unsigned, TAU, WS_TAU) BWS(unsigned, RR, WS_RR) BWS(unsigned long long, BM, WS_BM) BWS(float, BIAS1, WS_BIAS1)
    BWS(bf16_t, KC, WS_KC) BWS(bf16_t, VCT, WS_VCT) BWS(bf16_t, HID, WS_HID) BWS(bf16_t, MEMB, WS_MEMB) BWS(bf16_t, KMEM, WS_KMEM) BWS(bf16_t, VMEMT, WS_VMEMT)
    BWS(bf16_t, KCMP, WS_KCMP) BWS(bf16_t, VCMP, WS_VCMP) BWS(bf16_t, VAT, WS_VAT) BWS(bf16_t, VBT, WS_VBT) BWS(bf16_t, VST, WS_VST) BWS(bf16_t, VWT, WS_VWT)
    BWS(bf16_t, WIN, WS_WIN) BWS(bf16_t, WFI, WS_WFI) BWS(bf16_t, WFO, WS_WFO) BWS(bf16_t, WOUT, WS_WOUT) BWS(bf16_t, WUP, WS_WUP) BWS(bf16_t, WMQ, WS_WMQ)
    BWS(bf16_t, WMKV, WS_WMKV) BWS(bf16_t, WMO, WS_WMO) BWS(bf16_t, WC1, WS_WC1) BWS(bf16_t, WC2, WS_WC2)
    BWS(bf16_t, HB, WS_HB) BWS(bf16_t, O3, WS_HB) BWS(unsigned short, MB, WS_HB + 48 * MiB)
    BWS(bf16_t, PA, WS_PA) BWS(bf16_t, MG, WS_PA) BWS(bf16_t, QM, WS_PA + 64 * MiB) BWS(bf16_t, OM, WS_PA + 80 * MiB)
    BWS(bf16_t, PG, WS_PG) BWS(bf16_t, ACT, WS_PG)
#undef BWS
};

DI void sb_unit(const Bufs& P, int b, int h, int qb, int lane) {
    const int r = lane & 31, hh = lane >> 5, q0 = qb * 32, tq = q0 + r;
    const size_t row = (size_t)b * SQ + tq;
    bf16x8 qf[4]; load_q(qf, P.PA() + row * PAP + C_QA + h * 64 + 8 * hh);
    f32x16 o0 = zero16(), o1 = zero16();
    float R = 0.f;
    const bf16_t* kb = P.PA() + ((size_t)b * SQ + r) * PAP + C_KA + h * 64 + 8 * hh;
    const bf16_t* vb = P.VAT() + ((size_t)(b * 4 + h) * 64 + r) * SQ + 4 * hh;
    KV cur; load_kv(cur, kb + (size_t)(qb * 32) * PAP, vb + qb * 32, SQ);
    for (int kt = qb; kt >= 0; --kt) {
        const int k0 = kt * 32;
        KV nxt = cur; if (kt > 0) load_kv(nxt, kb + (size_t)(k0 - 32) * PAP, vb + k0 - 32, SQ);
        f32x16 z = qk_frag(cur.k, qf);
        float Lg[16];
#pragma unroll
        for (int i = 0; i < 16; ++i) {
            const bool valid = (k0 + crow(i, hh)) < tq;
            const float zz = z[i], sp = fmaxf(zz, 0.f) + 0.6931471805599453f * flog2(1.f + fexp2(-fabsf(zz) * LOG2E));
            Lg[i] = valid ? -sp : 0.f;
        }
        float T[4];
#pragma unroll
        for (int g = 0; g < 4; ++g) { Lg[4 * g + 2] += Lg[4 * g + 3]; Lg[4 * g + 1] += Lg[4 * g + 2]; Lg[4 * g] += Lg[4 * g + 1]; T[g] = Lg[4 * g]; }
        float PT[4];
#pragma unroll
        for (int g = 0; g < 4; ++g) PT[g] = shx32(T[g]);
        float above = R;
#pragma unroll
        for (int g = 3; g >= 0; --g) {
            const float ab = above + (hh == 0 ? PT[g] : 0.f);
#pragma unroll
            for (int e = 0; e < 4; ++e) {
                const int i = 4 * g + e; const bool valid = (k0 + crow(i, hh)) < tq;
                z[i] = valid ? fexp2((z[i] + Lg[i] + ab) * LOG2E) : 0.f;
            }
            above += T[g] + PT[g];
        }
        R = above;
        pv_frag(o0, o1, cur.v, z);
        if (__all(R < -60.f)) break;
        cur = nxt;
    }
    store_ot(P.O3() + row * 768 + h * 64, o0, o1, 1.f, hh);
}

DI unsigned mono_key(float s) { const unsigned u = __builtin_bit_cast(unsigned, s + 0.0f); return u ^ ((unsigned)((int)u >> 31) | 0x80000000u); }
DI float mono_inv(unsigned k) { const unsigned u = (k & 0x80000000u) ? (k ^ 0x80000000u) : ~k; return __builtin_bit_cast(float, u); }
DI float mono_inv_hi(unsigned k) { if (k == 0x7fffffffu) return __builtin_bit_cast(float, 0x80000001u); const float f = mono_inv(k); return (f != f) ? ((k & 0x80000000u) ? __builtin_inff() : -__builtin_inff()) : f; }
DI float relu_f(float x) { return __builtin_amdgcn_fmed3f(x, 0.f, __builtin_inff()); }
DI void idx_tile(float (&sc)[16], const bf16x8 (&kf)[4], const bf16x8 (&qi)[4][4], const float (&w)[4]) {
#pragma unroll
    for (int hd = 0; hd < 4; ++hd) {
        f32x16 z = zero16();
#pragma unroll
        for (int s = 0; s < 4; ++s) z = MFMA32(kf[s], qi[hd][s], z);
#pragma unroll
        for (int i = 0; i < 16; ++i) { const float rl = relu_f(z[i]); sc[i] = (hd == 0) ? w[0] * rl : __builtin_fmaf(w[hd], rl, sc[i]); }
    }
}

constexpr int KT_SLICE = 32 * 144;
DI void ktile_issue(u32x4 (&rg)[4], const bf16_t* kcol  , int k0, int lane) {
    const bf16_t* p = kcol + (size_t)(k0 + (lane >> 3)) * PAP + (lane & 7) * 8;
#pragma unroll
    for (int i = 0; i < 4; ++i) rg[i] = *(const GAS u32x4*)(p + (size_t)(8 * i) * PAP);
}
DI void ktile_commit(LAS unsigned char* slice, const u32x4 (&rg)[4], int lane) {
    LAS unsigned char* p = slice + (lane >> 3) * 144 + (lane & 7) * 16;
#pragma unroll
    for (int i = 0; i < 4; ++i) *(LAS u32x4*)(p + i * 8 * 144) = rg[i];
}
DI void ktile_frags(bf16x8 (&kf)[4], const LAS unsigned char* slice, int lane) {
    const LAS unsigned char* p = slice + (lane & 31) * 144 + (lane >> 5) * 16;
#pragma unroll
    for (int s2 = 0; s2 < 4; ++s2) kf[s2] = *(const LAS bf16x8*)(p + s2 * 32);
}
constexpr int HROW = 132;
constexpr int HWAVE = 32 * HROW * 4;
constexpr int DS_CAP = 64;
constexpr int DS_OFF_KSL = 4 * HWAVE, DS_OFF_FLAG = DS_OFF_KSL + 8 * KT_SLICE, DS_OFF_CNT = DS_OFF_FLAG + 512, DS_OFF_CAND = DS_OFF_CNT + 128, DS_LDS_END = DS_OFF_CAND + 32 * DS_CAP * 8;
template <int EXPT = 0, class F> DI void ds_tile_pass(const bf16_t* kcol, LAS unsigned char* kslice, int qb, int wave, int lane, const bf16x8 (&qi)[4][4], const float (&w)[4], const F& f) {
    if (wave > qb) return;
    u32x4 rg[4]; ktile_issue(rg, kcol, wave * 32, lane); ktile_commit(kslice, rg, lane);
    for (int kt = wave; kt <= qb; kt += 8) {
        const int k0 = kt * 32;
        bf16x8 kf[4]; ktile_frags(kf, kslice, lane);
        if (EXPT != 13 && kt + 8 <= qb) ktile_issue(rg, kcol, k0 + 256, lane);
        float sc[16]; if (EXPT == 12) { _Pragma("unroll") for (int i = 0; i < 16; ++i) sc[i] = __builtin_bit_cast(float, (int)kf[i & 3][i >> 2] << 16); } else idx_tile(sc, kf, qi, w);
        f(kt, k0, sc);
        if (EXPT != 13 && kt + 8 <= qb) ktile_commit(kslice, rg, lane);
    }
}
template <int EXP = 0, int CHK = 0> DI void dsa_select_wg(const Bufs& P, int b, int qb, int lane, int wave, LAS unsigned* hist4) {
    const int r = lane & 31, hh = lane >> 5, q0 = qb * 32, tq = q0 + r;
    const size_t row = (size_t)b * SQ + tq;
    const bool takeall = (tq + 1) <= 256;
    bf16x8 qi[4][4];
#pragma unroll
    for (int hd = 0; hd < 4; ++hd) load_q(qi[hd], P.PA() + row * PAP + C_QI + hd * 64 + 8 * hh);
    float w[4]; { const f32x4 wv = *(const GAS f32x4*)(P.WG() + row * 16); w[0] = wv.x; w[1] = wv.y; w[2] = wv.z; w[3] = wv.w; }
    LAS unsigned char* const base = (LAS unsigned char*)hist4;
    { LAS unsigned* z = hist4 + wave * 2112 + lane;
#pragma unroll
      for (int j = 0; j < 33; ++j) z[64 * j] = 0u; }
    LAS unsigned* const tieflag = (LAS unsigned*)(base + DS_OFF_FLAG);
    LAS unsigned* const chk = tieflag + 4;
    LAS unsigned* const ccnt_l = (LAS unsigned*)(base + DS_OFF_CNT);
    LAS unsigned* const cand = (LAS unsigned*)(base + DS_OFF_CAND);
    if (wave == 0) { if (lane == 0) *tieflag = 0u; if (lane < 32) { ccnt_l[lane] = 0u; if (CHK) { chk[3 * lane] = 0xffffffffu; chk[3 * lane + 1] = 0u; chk[3 * lane + 2] = 0u; } } }
    __syncthreads();
    unsigned prefix = 0u, krem = (CHK == 2) ? 255u : 256u, bc = 0u; int npass = 0; bool early = false;
    const bf16_t* kcol = P.PA() + (size_t)b * SQ * PAP + C_KI;
    LAS unsigned char* kslice = base + DS_OFF_KSL + wave * KT_SLICE;
    LAS unsigned* const mk = hist4;
    unsigned short* const mbp = (EXP >= 10 ? (unsigned short*)P.out() : P.MB()) + ((size_t)(b * 128 + qb) * 128) * 64 + lane;
    const unsigned sq = (unsigned)r >> 3;
    auto hist_pass = [&](int pass) -> bool {
        const int sh_d = 24 - 8 * pass, sh_p = (32 - 8 * pass) & 31;
        const unsigned klo = pass == 0 ? 0u : (prefix << sh_p), khi = pass == 0 ? 0xffffffffu : (klo | ((1u << sh_p) - 1u));
        float flo = mono_inv(klo); const float fhi = mono_inv_hi(khi);
        if (flo != flo) flo = -__builtin_inff();
        LAS unsigned* hrow = hist4 + pass * (32 * HROW) + r * HROW;
        auto hbody = [&](auto allv_c, int k0, const float (&sc)[16]) {
            constexpr bool ALLV = decltype(allv_c)::value;
            if (pass == 0) {
#pragma unroll
                for (int i = 0; i < 16; ++i) {
                    const unsigned d = mono_key(sc[i]) >> 24;
                    const unsigned val = (ALLV || (k0 + crow(i, hh)) <= tq) ? (1u << (16 * (d & 1u))) : 0u;
                    if (EXP == 14) { if (lane & 1) __hip_atomic_fetch_add(hrow + ((d >> 1) ^ sq), val, __ATOMIC_RELAXED, __HIP_MEMORY_SCOPE_WORKGROUP); }
                    else if (EXP == 15) { if (i & 1) __hip_atomic_fetch_add(hrow + ((d >> 1) ^ sq), val, __ATOMIC_RELAXED, __HIP_MEMORY_SCOPE_WORKGROUP); else asm volatile("" :: "v"(val), "v"(d)); }
                    else if (EXP != 1 && EXP != 11) __hip_atomic_fetch_add(hrow + ((d >> 1) ^ sq), val, __ATOMIC_RELAXED, __HIP_MEMORY_SCOPE_WORKGROUP); else asm volatile("" :: "v"(val), "v"(d));
                }
            } else {
#pragma unroll
                for (int i = 0; i < 16; ++i) {
                    const bool ok = (ALLV || (k0 + crow(i, hh)) <= tq) && sc[i] >= flo && sc[i] <= fhi;
                    if (ok) { const unsigned d = (mono_key(sc[i]) >> sh_d) & 255u;
                        __hip_atomic_fetch_add(hrow + ((d >> 1) ^ sq), 1u << (16 * (d & 1u)), __ATOMIC_RELAXED, __HIP_MEMORY_SCOPE_WORKGROUP); }
                }
            }
        };
        ds_tile_pass<EXP>(kcol, kslice, qb, wave, lane, qi, w, [&](int kt, int k0, const float (&sc)[16]) {
            if (kt < qb) hbody(std::true_type{}, k0, sc); else hbody(std::false_type{}, k0, sc);
        });
        __syncthreads();
        LAS unsigned* hhalf = hrow + 64 * hh;
        unsigned gs[16], tot = 0u;
#pragma unroll
        for (int j = 0; j < 16; ++j) { const u32x4 x = *(LAS u32x4*)(hhalf + 4 * j);
            gs[j] = ((x.x & 0xffffu) + (x.x >> 16)) + ((x.y & 0xffffu) + (x.y >> 16)) + ((x.z & 0xffffu) + (x.z >> 16)) + ((x.w & 0xffffu) + (x.w >> 16)); tot += gs[j]; }
        const unsigned oth = shx32u(tot), U = hh ? tot : oth;
        const bool mine = hh ? (krem <= U) : (krem > U);
        const unsigned target = hh ? krem : krem - U;
        unsigned cum = 0u; int fj = -1;
#pragma unroll
        for (int j = 15; j >= 0; --j) { const bool hit = (fj < 0) && (cum + gs[j] >= target); fj = hit ? j : fj; cum += (fj < 0) ? gs[j] : 0u; }
        u32x4 xg = *(LAS u32x4*)(hhalf + 4 * (fj < 0 ? 0 : fj));
        if (sq & 1u) xg = (u32x4){xg.y, xg.x, xg.w, xg.z};
        if (sq & 2u) xg = (u32x4){xg.z, xg.w, xg.x, xg.y};
        unsigned above = 0u, binc = 0u; int found = -1;
#pragma unroll
        for (int wi = 3; wi >= 0; --wi) { const unsigned x = xg[wi], hi = x >> 16, lo = x & 0xffffu;
            { const bool hit = (found < 0) && (cum + hi >= target); if (hit) { found = 2 * wi + 1; above = cum; binc = hi; } cum += (found < 0) ? hi : 0u; }
            { const bool hit = (found < 0) && (cum + lo >= target); if (hit) { found = 2 * wi; above = cum; binc = lo; } cum += (found < 0) ? lo : 0u; } }
        const bool okf = (fj >= 0) && (found >= 0);
        unsigned dm = (okf ? (unsigned)(8 * fj + found) : 0u) + 128u * hh, am = (okf ? above : 0u) + (hh ? 0u : U);
        const unsigned d_o = shx32u(dm), a_o = shx32u(am), b_o = shx32u(binc);
        const unsigned dig = mine ? dm : d_o, abv = mine ? am : a_o;
        bc = mine ? binc : b_o;
        krem -= abv; prefix = (prefix << 8) | dig; npass = pass + 1;
        return pass < 3 && __all(bc == krem || takeall);
    };
    early = hist_pass(0);
    if (!early && EXP != 3) early = hist_pass(1);
    const bool collect = !early && (EXP == 0 || EXP >= 10) && __all(bc <= (unsigned)DS_CAP || takeall);
    unsigned tau = 0u, rr = 0u;
    if (collect) {
        const unsigned klo = prefix << 16, khi = klo | 0xffffu;
        float flo = mono_inv(klo); const float fhi = mono_inv_hi(khi);
        if (flo != flo) flo = -__builtin_inff();
        __syncthreads();
        auto cbody = [&](auto allv_c, int kt, int k0, const float (&sc)[16]) {
            constexpr bool ALLV = decltype(allv_c)::value;
            unsigned gt = 0u;
#pragma unroll
            for (int i = 0; i < 16; ++i) {
                const bool valid = ALLV || (k0 + crow(i, hh)) <= tq;
                gt |= bitif(valid && (takeall || sc[i] > fhi), i);
                if (valid && !takeall && sc[i] >= flo && sc[i] <= fhi) {
                    const unsigned slot = __hip_atomic_fetch_add(ccnt_l + r, 1u, __ATOMIC_RELAXED, __HIP_MEMORY_SCOPE_WORKGROUP);
                    if (slot < (unsigned)DS_CAP) { cand[(r * DS_CAP + slot) * 2] = mono_key(sc[i]); cand[(r * DS_CAP + slot) * 2 + 1] = (unsigned)(kt * 1024 + lane * 16 + i); }
                }
            }
            mk[kt * 64 + lane] = gt;
        };
        ds_tile_pass<EXP>(kcol, kslice, qb, wave, lane, qi, w, [&](int kt, int k0, const float (&sc)[16]) {
            if (kt < qb) cbody(std::true_type{}, kt, k0, sc); else cbody(std::false_type{}, kt, k0, sc);
        });
        __syncthreads();
        {
            const int qq = wave * 4 + (lane >> 4), j16 = lane & 15;
            const unsigned need = (unsigned)__shfl((int)krem, qq & 31), tk = (unsigned)__shfl((int)(takeall ? 1u : 0u), qq & 31);
            const unsigned cnt = tk ? 0u : (ccnt_l[qq] < (unsigned)DS_CAP ? ccnt_l[qq] : (unsigned)DS_CAP);
            const LAS unsigned* cl = cand + qq * DS_CAP * 2;
            unsigned cmaxn = cnt;
#pragma unroll
            for (int o = 16; o < 64; o <<= 1) { const unsigned t2 = (unsigned)__shfl_xor((int)cmaxn, o); cmaxn = t2 > cmaxn ? t2 : cmaxn; }
            unsigned mykey[4], mypos[4], rank[4];
#pragma unroll
            for (int c = 0; c < 4; ++c) { const unsigned sidx = j16 + 16 * c; const bool have = sidx < cnt; mykey[c] = have ? cl[2 * sidx] : 0u; mypos[c] = have ? cl[2 * sidx + 1] : 0u; rank[c] = 0u; }
            for (unsigned j2 = 0; j2 < cmaxn; ++j2) {
                const bool in = j2 < cnt;
                const unsigned k2 = in ? cl[2 * j2] : 0u, p2 = in ? cl[2 * j2 + 1] : 0u;
                const unsigned i2 = (p2 >> 10) * 32u + (unsigned)crow((int)(p2 & 15u), (int)((p2 >> 9) & 1u));
#pragma unroll
                for (int c = 0; c < 4; ++c) { const unsigned ic = (mypos[c] >> 10) * 32u + (unsigned)crow((int)(mypos[c] & 15u), (int)((mypos[c] >> 9) & 1u));
                    rank[c] += (in && (k2 > mykey[c] || (k2 == mykey[c] && i2 < ic))) ? 1u : 0u; }
            }
#pragma unroll
            for (int c = 0; c < 4; ++c) { const unsigned sidx = j16 + 16 * c;
                if (sidx < cnt && rank[c] < need) __hip_atomic_fetch_or(mk + (mypos[c] >> 4), 1u << (mypos[c] & 15u), __ATOMIC_RELAXED, __HIP_MEMORY_SCOPE_WORKGROUP); }
        }
        __syncthreads();
        if (wave <= qb) for (int kt = wave; kt <= qb; kt += 8) mbp[(size_t)kt * 64] = (unsigned short)mk[kt * 64 + lane];
    } else {
        if (!early && EXP != 3) { early = hist_pass(2); if (!early) (void)hist_pass(3); }
        if (takeall) { tau = 0u; rr = 0xffffffffu; }
        else if (early) { tau = (prefix << (32 - 8 * npass)) - 1u; rr = 0u; }
        else { tau = prefix; rr = krem; }
        if (EXP != 0) { asm volatile("" :: "v"(tau), "v"(rr)); __syncthreads(); return; }
        const float tauf = mono_inv_hi(tau);
        __syncthreads();
        unsigned anyeq = 0u;
        ds_tile_pass<EXP>(kcol, kslice, qb, wave, lane, qi, w, [&](int kt, int k0, const float (&sc)[16]) {
            unsigned gt = 0u, eq = 0u;
#pragma unroll
            for (int i = 0; i < 16; ++i) { const bool valid = (k0 + crow(i, hh)) <= tq; gt |= bitif(valid && sc[i] > tauf, i); eq |= bitif(valid && sc[i] == tauf, i); }
            mbp[(size_t)kt * 64] = (unsigned short)gt;
            mk[kt * 64 + lane] = gt | (eq << 16);
            anyeq |= eq;
        });
        if (__any(anyeq != 0u && rr != 0u)) { if (lane == 0) __hip_atomic_fetch_or(tieflag, 1u, __ATOMIC_RELAXED, __HIP_MEMORY_SCOPE_WORKGROUP); }
        __syncthreads();
        if (*tieflag != 0u && wave == 0) {
            unsigned run = 0u;
            for (int kt = 0; kt <= qb; ++kt) {
                const unsigned wd = mk[kt * 64 + lane], gt = wd & 0xffffu, eq = wd >> 16;
                if (__any(eq != 0u)) {
                    unsigned cg[4], pk = 0u;
#pragma unroll
                    for (int g = 0; g < 4; ++g) { cg[g] = __builtin_popcount((eq >> (4 * g)) & 15u); pk |= cg[g] << (8 * g); }
                    const unsigned opk = shx32u(pk);
                    unsigned bs = run, bits = gt;
#pragma unroll
                    for (int g = 0; g < 4; ++g) {
                        const unsigned og = (opk >> (8 * g)) & 255u;
                        unsigned ord = bs + (hh ? og : 0u);
#pragma unroll
                        for (int e = 0; e < 4; ++e) { const int i = 4 * g + e; const unsigned ei = (eq >> i) & 1u; bits |= bitif(ei && ord < rr, i); ord += ei; }
                        bs += cg[g] + og;
                    }
                    run = bs;
                    mbp[(size_t)kt * 64] = (unsigned short)bits;
                    mk[kt * 64 + lane] = bits;
                } else mk[kt * 64 + lane] = gt;
            }
        }
    }
    __syncthreads();
    if (CHK) {
        unsigned cmin = 0xffffffffu, cmax = 0u, ccnt = 0u;
        asm volatile("s_waitcnt vmcnt(0)" ::: "memory");
        ds_tile_pass<EXP>(kcol, kslice, qb, wave, lane, qi, w, [&](int kt, int k0, const float (&sc)[16]) {
            const unsigned bits = (unsigned)__builtin_nontemporal_load(mbp + (size_t)kt * 64);
#pragma unroll
            for (int i = 0; i < 16; ++i) { const bool valid = (k0 + crow(i, hh)) <= tq; const unsigned uk = mono_key(sc[i]);
                if ((bits >> i) & 1u) cmin = uk < cmin ? uk : cmin; else if (valid) cmax = uk > cmax ? uk : cmax; }
            ccnt += __builtin_popcount(bits);
        });
        __hip_atomic_fetch_min(chk + 3 * r, cmin, __ATOMIC_RELAXED, __HIP_MEMORY_SCOPE_WORKGROUP); __hip_atomic_fetch_max(chk + 3 * r + 1, cmax, __ATOMIC_RELAXED, __HIP_MEMORY_SCOPE_WORKGROUP);
        __hip_atomic_fetch_add(chk + 3 * r + 2, ccnt, __ATOMIC_RELAXED, __HIP_MEMORY_SCOPE_WORKGROUP);
        __syncthreads();
        if (wave == 1 && hh == 0) { const unsigned want = (unsigned)((tq + 1) < 256 ? (tq + 1) : 256);
            const bool bad = (chk[3 * r + 2] != want) || (chk[3 * r] < chk[3 * r + 1]);
            if (bad) __hip_atomic_fetch_or((gu32*)P.ctl() + 2, 1u, RLX_AGENT); }
        __syncthreads();
    }
}
DI void dsa_mask_unit(const Bufs& P, int b, int qb, int lane, LAS unsigned char* kslice) {
    const int r = lane & 31, hh = lane >> 5, q0 = qb * 32, tq = q0 + r;
    const size_t row = (size_t)b * SQ + tq;
    bf16x8 qi[4][4];
#pragma unroll
    for (int hd = 0; hd < 4; ++hd) load_q(qi[hd], P.PA() + row * PAP + C_QI + hd * 64 + 8 * hh);
    float w[4]; { const f32x4 wv = *(const GAS f32x4*)(P.WG() + row * 16); w[0] = wv.x; w[1] = wv.y; w[2] = wv.z; w[3] = wv.w; }
    const unsigned tau = P.TAU()[row], rr = P.RR()[row];
    float tauf = mono_inv(tau); if (tauf != tauf) tauf = -__builtin_inff();
    unsigned run = 0u;
    const bf16_t* kcol = P.PA() + (size_t)b * SQ * PAP + C_KI;
    unsigned short* mb = P.MB() + ((size_t)(b * 128 + qb) * 128) * 64 + lane;
    u32x4 rg[4]; ktile_issue(rg, kcol, 0, lane); ktile_commit(kslice, rg, lane);
    for (int kt = 0; kt <= qb; ++kt) {
        const int k0 = kt * 32;
        bf16x8 kf[4]; ktile_frags(kf, kslice, lane);
        if (kt < qb) ktile_issue(rg, kcol, k0 + 32, lane);
        float sc[16]; idx_tile(sc, kf, qi, w);
        if (kt < qb) ktile_commit(kslice, rg, lane);
        unsigned gt = 0u, eq = 0u;
#pragma unroll
        for (int i = 0; i < 16; ++i) {
            const bool valid = (k0 + crow(i, hh)) <= tq;
            gt |= bitif(valid && sc[i] > tauf, i); eq |= bitif(valid && sc[i] == tauf, i);
        }
        unsigned bits = gt;
        if (__any(eq != 0u)) {
        unsigned cg[4], pk = 0u;
#pragma unroll
        for (int g = 0; g < 4; ++g) { cg[g] = __builtin_popcount((eq >> (4 * g)) & 15u); pk |= cg[g] << (8 * g); }
        const unsigned opk = shx32u(pk);
        unsigned base = run;
#pragma unroll
        for (int g = 0; g < 4; ++g) {
            const unsigned og = (opk >> (8 * g)) & 255u;
            unsigned ord = base + (hh ? og : 0u);
#pragma unroll
            for (int e = 0; e < 4; ++e) { const int i = 4 * g + e; const unsigned ei = (eq >> i) & 1u; bits |= bitif(ei && ord < rr, i); ord += ei; }
            base += cg[g] + og;
        }
        run = base;
        }
        mb[(size_t)kt * 64] = (unsigned short)bits;
    }
}
DI void dsa_attn_unit(const Bufs& P, int b, int h, int qb, int lane) {
    const int r = lane & 31, hh = lane >> 5, q0 = qb * 32;
    const size_t row = (size_t)b * SQ + q0 + r;
    bf16x8 qf[4]; load_q(qf, P.PA() + row * PAP + C_QB + h * 64 + 8 * hh);
    f32x16 o0 = zero16(), o1 = zero16(); float m = -1e30f, l = 0.f;
    const unsigned short* mb = P.MB() + ((size_t)(b * 128 + qb) * 128) * 64 + lane;
    auto mask = [&](int kt) -> unsigned { return (unsigned)mb[(size_t)kt * 64]; };
    attn_tiles<false>(o0, o1, m, l, qf, P.PA() + (size_t)b * SQ * PAP + C_KB, PAP, P.VBT() + (size_t)b * 64 * SQ, SQ, 0, qb, mask, r, hh);
    const float lt = l + shx32(l), inv = lt > 0.f ? 1.f / lt : 0.f;
    store_ot(P.O3() + row * 768 + 256 + h * 64, o0, o1, inv, hh);
}


template <int MODE>
DI void dsa_attn_probe(const Bufs& P, int b, int h, int qb, int lane) {
    const int r = lane & 31, hh = lane >> 5, q0 = qb * 32;
    const size_t row = (size_t)b * SQ + q0 + r;
    bf16x8 qf[4]; load_q(qf, P.PA() + row * PAP + C_QB + h * 64 + 8 * hh);
    f32x16 o0 = zero16(), o1 = zero16(); float m = -1e30f, l = 0.f;
    const unsigned short* mb = P.MB() + ((size_t)(b * 128 + qb) * 128) * 64 + lane;
    const bf16_t* kl = P.PA() + (size_t)b * SQ * PAP + C_KB + (size_t)r * PAP + 8 * hh; const bf16_t* vl = P.VBT() + (size_t)b * 64 * SQ + (size_t)r * SQ + 4 * hh;
    if (MODE == 1) {
        bf16x8 acc = qf[0];
        for (int kt = 0; kt <= qb; ++kt) { KV t; load_kv(t, kl + (size_t)(kt * 32) * PAP, vl + kt * 32, SQ); const unsigned vm = mb[(size_t)kt * 64];
#pragma unroll
            for (int j = 0; j < 4; ++j) acc = acc ^ t.k[j] ^ t.v[j]; acc[0] ^= (short)vm; }
        o0[0] = (float)acc[0] + (float)acc[1] + (float)acc[2] + (float)acc[3] + (float)acc[4] + (float)acc[5] + (float)acc[6] + (float)acc[7];
    } else {
        auto mask = [&](int kt) -> unsigned { return (unsigned)mb[0]; };
        attn_tiles<false>(o0, o1, m, l, qf, P.PA() + (size_t)b * SQ * PAP + C_KB, 0, P.VBT() + (size_t)b * 64 * SQ, SQ, 0, qb, mask, r, hh);
    }
    const float lt = l + shx32(l), inv = lt > 0.f ? 1.f / lt : 0.f;
    store_ot((bf16_t*)P.out() + row * 768 + 256 + h * 64, o0, o1, inv, hh);
}
template <int CHK = 0> DI void nsa_cmp_unit(const Bufs& P, int b, int qb, int lane, LAS float* impl) {
    const int r = lane & 31, hh = lane >> 5, q0 = qb * 32, tq = q0 + r;
    const size_t row = (size_t)b * SQ + tq;
    const bf16_t* kcb = P.KC() + (size_t)b * 256 * 64 + 8 * hh;
    const bf16_t* vcb = P.VCT() + ((size_t)b * 64 + r) * 256 + 4 * hh;
    const int cmax = (tq >= 31) ? ((tq - 31) >> 4) : -1;
    const int ctile_hi = qb >> 4;
    LAS float* imp = impl + lane;
#pragma unroll
    for (int a = 0; a < 32; ++a) imp[64 * a] = 0.f;
    for (int h = 0; h < 4; ++h) {
        bf16x8 qf[4]; load_q(qf, P.PA() + row * PAP + C_QC + h * 64 + 8 * hh);
        float m = -1e30f, l = 0.f;
        for (int kt = 0; kt <= ctile_hi; ++kt) {
            const int k0 = kt * 32;
            const f32x16 z = qk_tile(kcb + (size_t)(k0 + r) * 64, qf);
            float tm = -1e30f;
#pragma unroll
            for (int i = 0; i < 16; ++i) tm = ((k0 + crow(i, hh)) <= cmax) ? fmaxf(tm, z[i]) : tm;
            tm = fmaxf(tm, shx32(tm));
            const float mn = fmaxf(m, tm); float ls = 0.f;
#pragma unroll
            for (int i = 0; i < 16; ++i) ls += ((k0 + crow(i, hh)) <= cmax) ? fexp2(z[i] - mn) : 0.f;
            l = l * fexp2(m - mn) + ls; m = mn;
        }
        const float lt = l + shx32(l), inv = lt > 0.f ? 1.f / lt : 0.f;
        f32x16 o0 = zero16(), o1 = zero16();
        float carry = 0.f;
        for (int kt = 0; kt <= ctile_hi; ++kt) {
            const int k0 = kt * 32;
            f32x16 z = qk_tile(kcb + (size_t)(k0 + r) * 64, qf);
#pragma unroll
            for (int i = 0; i < 16; ++i) z[i] = ((k0 + crow(i, hh)) <= cmax) ? fexp2(z[i] - m) * inv : 0.f;
            float px[4];
#pragma unroll
            for (int g = 0; g < 4; ++g) px[g] = shx32(z[4 * g + 3]);
#pragma unroll
            for (int g = 0; g < 4; ++g) {
                const float G = (z[4 * g] + z[4 * g + 1]) + (z[4 * g + 2] + z[4 * g + 3]);
                const float prev = hh ? px[g] : (g == 0 ? carry : px[g - 1]);
                imp[64 * (4 * kt + g)] += G + prev;
            }
            carry = px[3];
            pv_tile(o0, o1, vcb + k0, 256, z);
        }
        const float gate = P.WG()[row * 16 + 4 + h * 3 + 0];
        store_ot(P.O3() + row * 768 + 512 + h * 64, o0, o1, gate, hh);
    }
    const int cur = tq >> 6;
    unsigned own = 0u;
    unsigned cand = 0u;
#pragma unroll
    for (int a = 0; a < 32; ++a) { const int j = 2 * a + hh; const bool adm = j <= cur, forced = (j == 0) || (j == cur) || (j == cur - 1);
        own |= bitif(adm && (forced || cur < 16), a); cand |= bitif(adm && !forced, a); }
    if (__any(cur >= 16)) {
        float iv[32];
#pragma unroll
        for (int a = 0; a < 32; ++a) iv[a] = imp[64 * a];
        for (int it = 0; it < 13; ++it) {
            float bv = -1e30f; int ba = 64;
#pragma unroll
            for (int a = 0; a < 32; ++a) { const bool c = (cand >> a) & 1u; if (c && iv[a] > bv) { bv = iv[a]; ba = a; } }
            const float pv_ = shx32(bv); const int pa = __shfl_xor(ba, 32);
            const int jo = 2 * ba + hh, jp = 2 * pa + (1 - hh);
            const bool win = (ba < 64) && ((pa >= 64) || (bv > pv_) || (bv == pv_ && jo < jp));
            const unsigned wb = (win ? 1u : 0u) << (ba & 31);
            if (cur >= 16) own |= wb;
            cand &= ~wb;
        }
    }
    if (CHK) {
        float smin = 1e30f, umax = -1e30f; int sj = -1, uj = 999;
#pragma unroll
        for (int a = 0; a < 32; ++a) { const int j = 2 * a + hh; const bool adm = j <= cur, forced = (j == 0) || (j == cur) || (j == cur - 1); const float v = imp[64 * a];
            if (adm && !forced) { if ((own >> a) & 1u) { if (v < smin || (v == smin && j > sj)) { smin = v; sj = j; } } else { if (v > umax || (v == umax && j < uj)) { umax = v; uj = j; } } } }
        const float psmin = shx32(smin), pumax = shx32(umax); const int psj = __shfl_xor(sj, 32), puj = __shfl_xor(uj, 32);
        if (psmin < smin || (psmin == smin && psj > sj)) { smin = psmin; sj = psj; }
        if (pumax > umax || (pumax == umax && puj < uj)) { umax = pumax; uj = puj; }
        const unsigned both = __builtin_popcount(own) + __builtin_popcount(shx32u(own));
        const unsigned want = (unsigned)(cur + 1 < 16 ? cur + 1 : 16);
        bool bad = both != want;
        if (sj >= 0 && uj < 999 && (umax > smin || (umax == smin && uj < sj))) bad = true;
        { const int j0 = 0, j1 = cur, j2 = cur - 1; const unsigned oo = shx32u(own);
          auto has = [&](int j) -> bool { if (j < 0) return true; const unsigned msk = ((j & 1) == hh) ? own : oo; return (msk >> (j >> 1)) & 1u; };
          if (!has(j0) || !has(j1) || !has(j2)) bad = true; }
        if (bad) __hip_atomic_fetch_or((gu32*)P.ctl() + 2, 2u, RLX_AGENT);
    }
    const unsigned oth = shx32u(own);
    if (hh == 0) {
        unsigned long long bm = 0ull;
#pragma unroll
        for (int a = 0; a < 32; ++a) { bm |= (unsigned long long)((own >> a) & 1u) << (2 * a); bm |= (unsigned long long)((oth >> a) & 1u) << (2 * a + 1); }
        P.BM()[row] = bm;
    }
}
DI void nsa_selwin_unit(const Bufs& P, int b, int h, int qb, int lane, bf16_t* obase) {
    const int r = lane & 31, hh = lane >> 5, q0 = qb * 32, tq = q0 + r;
    const size_t row = (size_t)b * SQ + tq;
    bf16x8 qf[4]; load_q(qf, P.PA() + row * PAP + C_QC + h * 64 + 8 * hh);
    const unsigned long long bm = P.BM()[row];
    f32x16 a0 = zero16(), a1 = zero16();
    {
        f32x16 o0 = zero16(), o1 = zero16(); float m = -1e30f, l = 0.f;
        auto mask = [&](int kt) -> unsigned {
            if (!((bm >> (kt >> 1)) & 1ull)) return 0u;
            unsigned v = 0u;
#pragma unroll
            for (int i = 0; i < 16; ++i) v |= bitif((kt * 32 + crow(i, hh)) <= tq, i);
            return v; };
        attn_tiles<true>(o0, o1, m, l, qf, P.PA() + (size_t)b * SQ * PAP + C_KSEL, PAP, P.VST() + (size_t)b * 64 * SQ, SQ, 0, qb, mask, r, hh);
        const float lt = l + shx32(l), g = (lt > 0.f ? 1.f / lt : 0.f) * P.WG()[row * 16 + 4 + h * 3 + 1];
#pragma unroll
        for (int i = 0; i < 16; ++i) { a0[i] = o0[i] * g; a1[i] = o1[i] * g; }
    }
    {
        f32x16 o0 = zero16(), o1 = zero16(); float m = -1e30f, l = 0.f;
        auto mask = [&](int kt) -> unsigned {
            unsigned v = 0u;
#pragma unroll
            for (int i = 0; i < 16; ++i) { const int key = kt * 32 + crow(i, hh); v |= bitif(key <= tq && key > tq - 512, i); }
            return v; };
        const int lo = (q0 - 511) > 0 ? ((q0 - 511) >> 5) : 0;
        attn_tiles<false>(o0, o1, m, l, qf, P.PA() + (size_t)b * SQ * PAP + C_KWIN, PAP, P.VWT() + (size_t)b * 64 * SQ, SQ, lo, qb, mask, r, hh);
        const float lt = l + shx32(l), g = (lt > 0.f ? 1.f / lt : 0.f) * P.WG()[row * 16 + 4 + h * 3 + 2];
#pragma unroll
        for (int i = 0; i < 16; ++i) { a0[i] += o0[i] * g; a1[i] += o1[i] * g; }
    }
    bf16_t* orow = obase + row * 768 + 512 + h * 64;
#pragma unroll
    for (int g = 0; g < 4; ++g) {
        const u32x2 c0 = *(const GAS u32x2*)(orow + 8 * g + 4 * hh), c1 = *(const GAS u32x2*)(orow + 32 + 8 * g + 4 * hh);
        a0[4 * g] += bflo(c0.x); a0[4 * g + 1] += bfhi(c0.x); a0[4 * g + 2] += bflo(c0.y); a0[4 * g + 3] += bfhi(c0.y);
        a1[4 * g] += bflo(c1.x); a1[4 * g + 1] += bfhi(c1.x); a1[4 * g + 2] += bflo(c1.y); a1[4 * g + 3] += bfhi(c1.y);
    }
    store_ot(orow, a0, a1, 1.f, hh);
}

constexpr int AW_KP = 144, AW_VP = 136, AW_KB = 64 * AW_KP, AW_BUF = AW_KB + 64 * AW_VP;
template <int KIND  , int EXP = 0>
DI void attn_wg(f32x16& o0, f32x16& o1, float& m, float& l, const bf16x8 (&qf)[4], const bf16_t* kglob  , const bf16_t* vtglob  ,
                int st_lo, int st_hi, int tq, int kt32_base_unused, const unsigned short* mb  , unsigned long long bm, int lane, int tid, LAS unsigned char* lds) {
    (void)kt32_base_unused;
    const int r = lane & 31, hh = lane >> 5;
    const int srow = tid >> 3, sch = tid & 7;
    const bf16_t* kg = kglob + (size_t)srow * PAP + sch * 8; const bf16_t* vg = vtglob + (size_t)srow * SQ + sch * 8;
    LAS unsigned char* const kw = lds + srow * AW_KP + sch * 16; LAS unsigned char* const vw = lds + AW_KB + srow * AW_VP + sch * 16;
    const int kro = r * AW_KP + hh * 16, vro = AW_KB + r * AW_VP + hh * 8;
    if (st_lo > st_hi) return;
    u32x4 kr = *(const GAS u32x4*)(kg + (size_t)(st_lo * 64) * PAP), vr = *(const GAS u32x4*)(vg + st_lo * 64);
    unsigned mw0 = 0u, mw1 = 0u;
    if (KIND == 0) { mw0 = mb[(size_t)(2 * st_lo) * 64]; mw1 = mb[(size_t)(2 * st_lo + 1) * 64]; }
    *(LAS u32x4*)kw = kr; *(LAS u32x2*)vw = (u32x2){vr.x, vr.y}; *(LAS u32x2*)(vw + 8) = (u32x2){vr.z, vr.w};
    __syncthreads();
    for (int st = st_lo; st <= st_hi; ++st) {
        LAS unsigned char* const buf = lds + ((st - st_lo) & 1) * AW_BUF;
        const bool more = st < st_hi;
        unsigned nw0 = 0u, nw1 = 0u;
        if (more) { if (EXP != 3) { kr = *(const GAS u32x4*)(kg + (size_t)((st + 1) * 64) * PAP); vr = *(const GAS u32x4*)(vg + (st + 1) * 64); }
            if (KIND == 0) { nw0 = mb[(size_t)(2 * st + 2) * 64]; nw1 = mb[(size_t)(2 * st + 3) * 64]; } }
#pragma unroll
        for (int j = 0; j < 2; ++j) {
            const int k0 = st * 64 + j * 32, q0w = tq - r;
            unsigned vm = 0xffffu; int mode;
            bool lanesel = true;
            if (KIND == 0) { vm = (2 * st + j <= (tq >> 5)) ? (j ? mw1 : mw0) : 0u; mode = 0; }
            else if (KIND == 1) {
                lanesel = ((bm >> st) & 1ull) != 0ull;
                if (k0 + 31 <= q0w) { mode = 2; vm = lanesel ? 0xffffu : 0u; }
                else { mode = 0; vm = 0u; if (lanesel) {
#pragma unroll
                    for (int i = 0; i < 16; ++i) vm |= bitif((k0 + crow(i, hh)) <= tq, i); } }
            } else {
                if (k0 + 31 <= q0w && k0 > q0w + 31 - 512) mode = 1;
                else { mode = 0; vm = 0u;
#pragma unroll
                    for (int i = 0; i < 16; ++i) { const int key = k0 + crow(i, hh); vm |= bitif(key <= tq && key > tq - 512, i); } }
            }
            if (!__any(vm != 0u)) continue;
            bf16x8 kf[4];
#pragma unroll
            for (int s2 = 0; s2 < 4; ++s2) kf[s2] = *(const LAS bf16x8*)(buf + kro + j * 32 * AW_KP + s2 * 32);
            const float nme = -sm_meff(m), ninf = -__builtin_inff();
            f32x16 init;
            if (mode == 1) {
#pragma unroll
                for (int i = 0; i < 16; ++i) init[i] = nme;
            } else if (mode == 2) {
                const float v = lanesel ? nme : ninf;
#pragma unroll
                for (int i = 0; i < 16; ++i) init[i] = v;
            } else {
                const unsigned nb = __builtin_bit_cast(unsigned, nme), ib = __builtin_bit_cast(unsigned, ninf); unsigned xb = nb ^ ib; asm volatile("" : "+v"(xb));
#pragma unroll
                for (int i = 0; i < 16; ++i) { const unsigned t = (unsigned)__builtin_amdgcn_sbfe((int)vm, i, 1); init[i] = __builtin_bit_cast(float, (t & xb) ^ ib); }
            }
            f32x16 z; if (EXP == 2) { _Pragma("unroll") for (int i = 0; i < 16; ++i) z[i] = __builtin_bit_cast(float, (int)kf[i & 3][i >> 2] << 16) + init[i]; } else z = qk_frag_init(kf, qf, init);
            if (EXP == 1) { asm volatile("" :: "v"(vm)); } else softmax_core(z, m, l, o0, o1);
            bf16x8 vf[4];
#pragma unroll
            for (int s2 = 0; s2 < 2; ++s2) {
#pragma unroll
                for (int db = 0; db < 2; ++db) {
                    const LAS unsigned char* vp = buf + vro + db * 32 * AW_VP + (j * 32 + 16 * s2) * 2;
                    const s16x4 lo = *(const LAS s16x4*)vp, hi = *(const LAS s16x4*)(vp + 16);
                    vf[2 * s2 + db] = __builtin_shufflevector(lo, hi, 0, 1, 2, 3, 4, 5, 6, 7);
                }
            }
            if (EXP == 2) { _Pragma("unroll") for (int i = 0; i < 16; ++i) { o0[i] += z[i] + __builtin_bit_cast(float, (int)vf[i & 3][i >> 2] << 16); } } else pv_frag(o0, o1, vf, z);
        }
        if (more) {
            const int off = ((st - st_lo + 1) & 1) * AW_BUF;
            *(LAS u32x4*)(kw + off) = kr; *(LAS u32x2*)(vw + off) = (u32x2){vr.x, vr.y}; *(LAS u32x2*)(vw + off + 8) = (u32x2){vr.z, vr.w};
            mw0 = nw0; mw1 = nw1;
        }
        __syncthreads();
    }
}
template <int EXP = 0> DI void dsa_attn_wg(const Bufs& P, int b, int qb64, int lane, int wave, int tid, LAS unsigned char* lds) {
    const int r = lane & 31, hh = lane >> 5, sub = wave >> 2, h = wave & 3, qb = 2 * qb64 + sub, tq = qb * 32 + r;
    const size_t row = (size_t)b * SQ + tq;
    bf16x8 qf[4]; load_q(qf, P.PA() + row * PAP + C_QB + h * 64 + 8 * hh);
    f32x16 o0 = zero16(), o1 = zero16(); float m = -1e30f, l = 0.f;
    const unsigned short* mb = P.MB() + ((size_t)(b * 128 + qb) * 128) * 64 + lane;
    attn_wg<0, EXP>(o0, o1, m, l, qf, P.PA() + (size_t)b * SQ * PAP + C_KB, P.VBT() + (size_t)b * 64 * SQ, 0, qb64, tq, 0, mb, 0ull, lane, tid, lds);
    const float lt = l + shx32(l), inv = lt > 0.f ? 1.f / lt : 0.f;
    store_ot((EXP ? (bf16_t*)P.out() : P.O3()) + row * 768 + 256 + h * 64, o0, o1, inv, hh);
}
DI void nsa_selwin_wg(const Bufs& P, int b, int qb64, int lane, int wave, int tid, LAS unsigned char* lds, bf16_t* obase) {
    const int r = lane & 31, hh = lane >> 5, sub = wave >> 2, h = wave & 3, qb = 2 * qb64 + sub, tq = qb * 32 + r;
    const size_t row = (size_t)b * SQ + tq;
    bf16x8 qf[4]; load_q(qf, P.PA() + row * PAP + C_QC + h * 64 + 8 * hh);
    const unsigned long long bm = P.BM()[row];
    f32x16 a0 = zero16(), a1 = zero16();
    {
        f32x16 o0 = zero16(), o1 = zero16(); float m = -1e30f, l = 0.f;
        attn_wg<1>(o0, o1, m, l, qf, P.PA() + (size_t)b * SQ * PAP + C_KSEL, P.VST() + (size_t)b * 64 * SQ, 0, qb64, tq, 0, nullptr, bm, lane, tid, lds);
        const float lt = l + shx32(l), g = (lt > 0.f ? 1.f / lt : 0.f) * P.WG()[row * 16 + 4 + h * 3 + 1];
#pragma unroll
        for (int i = 0; i < 16; ++i) { a0[i] = o0[i] * g; a1[i] = o1[i] * g; }
    }
    {
        f32x16 o0 = zero16(), o1 = zero16(); float m = -1e30f, l = 0.f;
        const int lo = (qb64 * 64 - 511) > 0 ? ((qb64 * 64 - 511) >> 6) : 0;
        attn_wg<2>(o0, o1, m, l, qf, P.PA() + (size_t)b * SQ * PAP + C_KWIN, P.VWT() + (size_t)b * 64 * SQ, lo, qb64, tq, 0, nullptr, 0ull, lane, tid, lds);
        const float lt = l + shx32(l), g = (lt > 0.f ? 1.f / lt : 0.f) * P.WG()[row * 16 + 4 + h * 3 + 2];
#pragma unroll
        for (int i = 0; i < 16; ++i) { a0[i] += o0[i] * g; a1[i] += o1[i] * g; }
    }
    bf16_t* orow = obase + row * 768 + 512 + h * 64;
#pragma unroll
    for (int g = 0; g < 4; ++g) {
        const u32x2 c0 = *(const GAS u32x2*)(orow + 8 * g + 4 * hh), c1 = *(const GAS u32x2*)(orow + 32 + 8 * g + 4 * hh);
        a0[4 * g] += bflo(c0.x); a0[4 * g + 1] += bfhi(c0.x); a0[4 * g + 2] += bflo(c0.y); a0[4 * g + 3] += bfhi(c0.y);
        a1[4 * g] += bflo(c1.x); a1[4 * g + 1] += bfhi(c1.x); a1[4 * g + 2] += bflo(c1.y); a1[4 * g + 3] += bfhi(c1.y);
    }
    store_ot(orow, a0, a1, 1.f, hh);
}
constexpr int MW_KP = 144, MW_VP = 520, MW_VOFF = 256 * MW_KP;
DI void mem_attn_wg(const Bufs& P, int l_, int b, int h, int qc, int lane, int wave, int tid, LAS unsigned char* lds) {
    const int r = lane & 31, hh = lane >> 5;
    const size_t row = (size_t)b * SQ + qc * 256 + wave * 32 + r;
    bf16x8 qf[4]; load_q(qf, P.QM() + row * 256 + h * 64 + 8 * hh);
    const bf16_t* kg = P.KMEM() + ((size_t)l_ * 2048 + (size_t)b * 256) * 256 + h * 64;
    const bf16_t* vg = P.VMEMT() + ((size_t)l_ * 32 + b * 4 + h) * 64 * 256;
#pragma unroll
    for (int i = 0; i < 4; ++i) { const int c = tid + 512 * i;
        { const int kr = c >> 3, ch = c & 7; *(LAS u32x4*)(lds + kr * MW_KP + ch * 16) = *(const GAS u32x4*)(kg + (size_t)kr * 256 + ch * 8); }
        { const int d = c >> 5, ch = c & 31; const u32x4 v = *(const GAS u32x4*)(vg + (size_t)d * 256 + ch * 8); LAS unsigned char* p = lds + MW_VOFF + d * MW_VP + ch * 16;
          *(LAS u32x2*)p = (u32x2){v.x, v.y}; *(LAS u32x2*)(p + 8) = (u32x2){v.z, v.w}; } }
    __syncthreads();
    f32x16 o0 = zero16(), o1 = zero16(); float m = -1e30f, l = 0.f;
    const LAS unsigned char* kl = lds + r * MW_KP + hh * 16; const LAS unsigned char* vl = lds + MW_VOFF + r * MW_VP + hh * 8;
    for (int kt = 0; kt < 8; ++kt) {
        bf16x8 kf[4];
#pragma unroll
        for (int s2 = 0; s2 < 4; ++s2) kf[s2] = *(const LAS bf16x8*)(kl + kt * 32 * MW_KP + s2 * 32);
        f32x16 z = qk_frag(kf, qf);
        softmax_step<false>(z, 0xffffu, m, l, o0, o1);
        bf16x8 vf[4];
#pragma unroll
        for (int s2 = 0; s2 < 2; ++s2) {
#pragma unroll
            for (int db = 0; db < 2; ++db) { const LAS unsigned char* vp = vl + db * 32 * MW_VP + (kt * 32 + 16 * s2) * 2;
                const s16x4 lo = *(const LAS s16x4*)vp, hi = *(const LAS s16x4*)(vp + 16); vf[2 * s2 + db] = __builtin_shufflevector(lo, hi, 0, 1, 2, 3, 4, 5, 6, 7); } }
        pv_frag(o0, o1, vf, z);
    }
    const float lt = l + shx32(l), inv = lt > 0.f ? 1.f / lt : 0.f;
    store_ot(P.OM() + row * 256 + h * 64, o0, o1, inv, hh);
    __syncthreads();
}
DI void mem_attn_unit(const Bufs& P, int l_, int b, int h, int qb, int lane) {
    const int r = lane & 31, hh = lane >> 5;
    const size_t row = (size_t)b * SQ + qb * 32 + r;
    bf16x8 qf[4]; load_q(qf, P.QM() + row * 256 + h * 64 + 8 * hh);
    f32x16 o0 = zero16(), o1 = zero16(); float m = -1e30f, l = 0.f;
    auto mask = [&](int) -> unsigned { return 0xffffu; };
    attn_tiles<false>(o0, o1, m, l, qf, P.KMEM() + ((size_t)l_ * 2048 + (size_t)b * 256) * 256 + h * 64, 256, P.VMEMT() + ((size_t)l_ * 32 + b * 4 + h) * 64 * 256, 256, 0, 7, mask, r, hh);
    const float lt = l + shx32(l), inv = lt > 0.f ? 1.f / lt : 0.f;
    store_ot(P.OM() + row * 256 + h * 64, o0, o1, inv, hh);
}
DI void st8(bf16_t* p, const f32x4& a, const f32x4& b) { u32x4 w; w.x = cvtpk(a[0], a[1]); w.y = cvtpk(a[2], a[3]); w.z = cvtpk(b[0], b[1]); w.w = cvtpk(b[2], b[3]); *(GAS u32x4*)p = w; }
DI void st8nt(bf16_t* p, const f32x4& a, const f32x4& b) { u32x4 w; w.x = cvtpk(a[0], a[1]); w.y = cvtpk(a[2], a[3]); w.z = cvtpk(b[0], b[1]); w.w = cvtpk(b[2], b[3]); __builtin_nontemporal_store(w, (GAS u32x4*)p); }
DI float sigm(float x) { return __builtin_amdgcn_rcpf(1.f + fexp2(-x * LOG2E)); }
DI float rs_of(float ssq) { return __builtin_amdgcn_rsqf(ssq * (1.f / 1024.f) + RMS_EPS); }

struct EpiIn {
    static constexpr bool PERM = true;
    const float* ss; Bufs P; LAS unsigned char* scr;
    DI void operator()(const f32x4 (&acc)[2][2][4][2], const pg8::Unit& u, int wr, int wc, int fr0, int fq0) const {
        int fr = fr0, fq = fq0; asm volatile("" : "+v"(fr), "+v"(fq));
        const int pn = u.pn, b = u.pm >> 4;
        float rsv[8];
#pragma unroll
        for (int i = 0; i < 8; ++i) rsv[i] = rs_of(ss[u.pm * 256 + (i >> 2) * 128 + wr * 64 + (i & 3) * 16 + fr]);
#pragma unroll
        for (int bj = 0; bj < 2; ++bj) {
            const int cl = bj * 128 + wc * 32 + fq * 8, g = cl >> 6, e = cl & 63;
            int mode = 5; float scale = 1.f; bf16_t* dst = nullptr; size_t pitch = 0;
            if (pn == 0) { mode = 0; scale = 0.125f; dst = P.PA() + C_QA + cl; pitch = PAP; }
            else if (pn == 1) { mode = 0; dst = P.PA() + C_KA + cl; pitch = PAP; }
            else if (pn == 2) { mode = 2; dst = P.VAT() + ((size_t)(b * 4 + g) * 64 + e) * SQ; }
            else if (pn == 3) { mode = 1; scale = C2; dst = P.PA() + C_QB + cl; pitch = PAP; }
            else if (pn == 4) { mode = 1; dst = P.PA() + C_QI + cl; pitch = PAP; }
            else if (pn == 5) { mode = 1; scale = C2; dst = P.PA() + C_QC + cl; pitch = PAP; }
            else if (pn == 6) { mode = 1;
                if (g == 0) { dst = P.PA() + C_KB + e; pitch = PAP; } else if (g == 1) { dst = P.PA() + C_KI + e; pitch = PAP; }
                else if (g == 2) { dst = P.KCMP() + e; pitch = 64; } else { dst = P.PA() + C_KSEL + e; pitch = PAP; } }
            else if (pn == 7) {
                if (g == 0) { mode = 1; dst = P.PA() + C_KWIN + e; pitch = PAP; } else if (g == 1) { mode = 0; dst = P.VCMP() + e; pitch = 64; }
                else if (g == 2) { mode = (e < 16) ? 4 : 5; } else mode = 5; }
            else if (pn == 8) { mode = 2; if (g == 0) dst = P.VBT() + ((size_t)b * 64 + e) * SQ; else if (g == 1) dst = P.VST() + ((size_t)b * 64 + e) * SQ; else if (g == 2) dst = P.VWT() + ((size_t)b * 64 + e) * SQ; else mode = 5; }
            else { mode = 3; dst = P.PG() + (size_t)(pn - 9) * 256 + cl; pitch = 3072; }
#pragma unroll
            for (int ai = 0; ai < 2; ++ai) {
                f32x4 c01s[4], c23s[4];
                if (mode == 1) {
#pragma unroll
                    for (int m = 0; m < 4; ++m) { const int t = (u.pm * 256 + ai * 128 + wr * 64 + m * 16 + fr) & (SQ - 1);
                        const f32x4* cs = (const f32x4*)(P.rope() + (size_t)t * 32 + (e >> 1)); c01s[m] = *(const GAS f32x4*)cs; c23s[m] = *(const GAS f32x4*)(cs + 1); }
                }
#pragma unroll
                for (int m = 0; m < 4; ++m) {
                    const int row = u.pm * 256 + ai * 128 + wr * 64 + m * 16 + fr;
                    const float rs = rsv[ai * 4 + m];
                    const int t = row & (SQ - 1);
                    const f32x4 v0 = acc[ai][bj][m][0] * rs, v1 = acc[ai][bj][m][1] * rs;
                    if (mode == 0) { st8(dst + (size_t)row * pitch, v0 * scale, v1 * scale); }
                    else if (mode == 1) {
                        const f32x4 c01 = c01s[m], c23 = c23s[m];
                        f32x4 r0, r1;
                        r0[0] = v0[0] * c01[0] - v0[1] * c01[1]; r0[1] = v0[1] * c01[0] + v0[0] * c01[1];
                        r0[2] = v0[2] * c01[2] - v0[3] * c01[3]; r0[3] = v0[3] * c01[2] + v0[2] * c01[3];
                        r1[0] = v1[0] * c23[0] - v1[1] * c23[1]; r1[1] = v1[1] * c23[0] + v1[0] * c23[1];
                        r1[2] = v1[2] * c23[2] - v1[3] * c23[3]; r1[3] = v1[3] * c23[2] + v1[2] * c23[3];
                        st8(dst + (size_t)row * pitch, r0 * scale, r1 * scale);
                    } else if (mode == 2) {
                        const unsigned w0 = cvtpk(v0[0], v0[1]), w1 = cvtpk(v0[2], v0[3]), w2 = cvtpk(v1[0], v1[1]), w3 = cvtpk(v1[2], v1[3]);
                        LAS unsigned short* sw = (LAS unsigned short*)(scr + (wr * 4 + wc) * 1024) + (fq * 8) * 16 + fr;
                        sw[0] = (unsigned short)w0; sw[16] = (unsigned short)(w0 >> 16); sw[32] = (unsigned short)w1; sw[48] = (unsigned short)(w1 >> 16);
                        sw[64] = (unsigned short)w2; sw[80] = (unsigned short)(w2 >> 16); sw[96] = (unsigned short)w3; sw[112] = (unsigned short)(w3 >> 16);
                        const int ln = fq * 16 + fr, dd = ln >> 1, hf = ln & 1;
                        const u32x4 tv = *(LAS u32x4*)(scr + (wr * 4 + wc) * 1024 + dd * 32 + hf * 16);
                        const int trow0 = (row - fr) & (SQ - 1);
                        *(GAS u32x4*)(dst + (ptrdiff_t)(dd - fq * 8) * SQ + trow0 + hf * 8) = tv;
                    } else if (mode == 3) {
                        f32x4 s0, s1;
#pragma unroll
                        for (int j = 0; j < 4; ++j) { s0[j] = sigm(v0[j]); s1[j] = sigm(v1[j]); }
                        st8nt(dst + (size_t)row * pitch, s0, s1);
                    } else if (mode == 4) {
                        f32x4 s0, s1;
                        if (e == 0) { s0 = v0 * 0.0625f; } else {
#pragma unroll
                            for (int j = 0; j < 4; ++j) s0[j] = sigm(v0[j]); }
#pragma unroll
                        for (int j = 0; j < 4; ++j) s1[j] = sigm(v1[j]);
                        GAS f32x4* wg = (GAS f32x4*)(P.WG() + (size_t)row * 16 + e);
                        wg[0] = s0; wg[1] = s1;
                    }
                }
                asm volatile("" ::: "memory");
            }
        }
    }
};
struct EpiMemKV {
    static constexpr bool PERM = true;
    Bufs P;
    DI void operator()(const f32x4 (&acc)[2][2][4][2], const pg8::Unit& u, int wr, int wc, int fr0, int fq0) const {
        int fr = fr0, fq = fq0; asm volatile("" : "+v"(fr), "+v"(fq));
        const int layer = u.pn >> 1, isv = u.pn & 1;
#pragma unroll
        for (int ai = 0; ai < 2; ++ai)
#pragma unroll
            for (int m = 0; m < 4; ++m) {
                const int row = u.pm * 256 + ai * 128 + wr * 64 + m * 16 + fr;
                const float rs = rs_of(P.ssm()[row]); const int b = row >> 8, mt = row & 255;
#pragma unroll
                for (int bj = 0; bj < 2; ++bj) {
                    const int cl = bj * 128 + wc * 32 + fq * 8, g = cl >> 6, e = cl & 63;
                    const f32x4 v0 = acc[ai][bj][m][0] * rs, v1 = acc[ai][bj][m][1] * rs;
                    if (!isv) st8(P.KMEM() + ((size_t)layer * 2048 + row) * 256 + cl, v0, v1);
                    else {
                        const unsigned w0 = cvtpk(v0[0], v0[1]), w1 = cvtpk(v0[2], v0[3]), w2 = cvtpk(v1[0], v1[1]), w3 = cvtpk(v1[2], v1[3]);
                        GAS bf16_t* d = (GAS bf16_t*)P.VMEMT() + (((size_t)layer * 32 + b * 4 + g) * 64 + e) * 256 + mt;
                        d[0] = (bf16_t)w0; d[256] = (bf16_t)(w0 >> 16); d[512] = (bf16_t)w1; d[768] = (bf16_t)(w1 >> 16);
                        d[1024] = (bf16_t)w2; d[1280] = (bf16_t)(w2 >> 16); d[1536] = (bf16_t)w3; d[1792] = (bf16_t)(w3 >> 16);
                    }
                    asm volatile("" ::: "memory");
                }
            }
    }
};
DI float gelu_tanh(float x) { const float u = 0.7978845608028654f * (x + 0.044715f * x * x * x); const float e = fexp2(-2.f * LOG2E * fabsf(u)); const float th = (1.f - e) * __builtin_amdgcn_rcpf(1.f + e);
    return 0.5f * x * (1.f + (u < 0.f ? -th : th)); }
struct EpiCmp1 {
    static constexpr bool PERM = true;
    bf16_t* HID; const float* bias;
    DI void operator()(const f32x4 (&acc)[2][2][4][2], const pg8::Unit& u, int wr, int wc, int fr0, int fq0) const {
        int fr = fr0, fq = fq0; asm volatile("" : "+v"(fr), "+v"(fq));
        const bool isv = u.pm >= 8;
#pragma unroll
        for (int bj = 0; bj < 2; ++bj) {
            const int cl = bj * 128 + wc * 32 + fq * 8;
            const bool keep = (bj == 1) == isv;
            const f32x4 b0 = *(const GAS f32x4*)(bias + cl), b1 = *(const GAS f32x4*)(bias + cl + 4);
#pragma unroll
            for (int ai = 0; ai < 2; ++ai)
#pragma unroll
                for (int m = 0; m < 4; ++m) {
                    const int row = u.pm * 256 + ai * 128 + wr * 64 + m * 16 + fr;
                    f32x4 h0, h1;
#pragma unroll
                    for (int j = 0; j < 4; ++j) { h0[j] = keep ? gelu_tanh(acc[ai][bj][m][0][j] + b0[j]) : 0.f; h1[j] = keep ? gelu_tanh(acc[ai][bj][m][1][j] + b1[j]) : 0.f; }
                    st8(HID + (size_t)row * 256 + (cl & 127) + (keep ? 0 : 128), h0, h1);
                }
        }
    }
};
struct EpiCmp2 {
    static constexpr bool PERM = true;
    bf16_t *KC, *VCT;
    DI void operator()(const f32x4 (&acc)[2][2][4][2], const pg8::Unit& u, int wr, int wc, int fr0, int fq0) const {
        int fr = fr0, fq = fq0; asm volatile("" : "+v"(fr), "+v"(fq));
        const bool isv = u.pm >= 8;
        if (wc >= 2) return;
#pragma unroll
        for (int ai = 0; ai < 2; ++ai)
#pragma unroll
            for (int m = 0; m < 4; ++m) {
                const int row = u.pm * 256 + ai * 128 + wr * 64 + m * 16 + fr, rl = row & 2047, b = rl >> 8, ci = rl & 255;
                const bool live = ci != 255;
                const f32x4 zf = {0.f, 0.f, 0.f, 0.f};
                (void)b;
                {
                    const int cl = wc * 32 + fq * 8;
                    const f32x4 v0 = live ? acc[ai][0][m][0] : zf, v1 = live ? acc[ai][0][m][1] : zf;
                    if (!isv) st8(KC + (size_t)rl * 64 + cl, v0, v1);
                }
            }
    }
    DI void vpart(const f32x4 (&acc)[2][2][4][2], const pg8::Unit& u, int wr, int wc, int fr0, int fq0) const {
        int fr = fr0, fq = fq0; asm volatile("" : "+v"(fr), "+v"(fq));
        if (u.pm < 8 || wc < 2) return;
#pragma unroll
        for (int ai = 0; ai < 2; ++ai)
#pragma unroll
            for (int m = 0; m < 4; ++m) {
                const int row = u.pm * 256 + ai * 128 + wr * 64 + m * 16 + fr, rl = row & 2047, b = rl >> 8, ci = rl & 255;
                const bool live = ci != 255;
                const f32x4 zf = {0.f, 0.f, 0.f, 0.f};
                const int d0 = (wc - 2) * 32 + fq * 8;
                const f32x4 v0 = live ? acc[ai][0][m][0] : zf, v1 = live ? acc[ai][0][m][1] : zf;
                const unsigned w0 = cvtpk(v0[0], v0[1]), w1 = cvtpk(v0[2], v0[3]), w2 = cvtpk(v1[0], v1[1]), w3 = cvtpk(v1[2], v1[3]);
                GAS bf16_t* d = (GAS bf16_t*)VCT + ((size_t)b * 64 + d0) * 256 + ci;
                d[0] = (bf16_t)w0; d[256] = (bf16_t)(w0 >> 16); d[512] = (bf16_t)w1; d[768] = (bf16_t)(w1 >> 16);
                d[1024] = (bf16_t)w2; d[1280] = (bf16_t)(w2 >> 16); d[1536] = (bf16_t)w3; d[1792] = (bf16_t)(w3 >> 16);
            }
    }
};
struct EpiCmp2All {
    static constexpr bool PERM = true;
    EpiCmp2 e;
    DI void operator()(const f32x4 (&acc)[2][2][4][2], const pg8::Unit& u, int wr, int wc, int fr0, int fq0) const {
        int fr = fr0, fq = fq0; asm volatile("" : "+v"(fr), "+v"(fq));
        if (u.pm < 8) e(acc, u, wr, wc, fr, fq); else e.vpart(acc, u, wr, wc, fr, fq);
    }
};
struct EpiMerge {
    static constexpr bool PERM = true;
    const bf16_t* PG; bf16_t* MG;
    DI void operator()(const f32x4 (&acc)[2][2][4][2], const pg8::Unit& u, int wr, int wc, int fr0, int fq0) const {
        int fr = fr0, fq = fq0; asm volatile("" : "+v"(fr), "+v"(fq));
        const int br = u.br;
#pragma unroll
        for (int ai = 0; ai < 2; ++ai)
#pragma unroll
            for (int bj = 0; bj < 2; ++bj) {
                const int rowb = u.pm * 256 + ai * 128 + wr * 64 + fr, col = u.pn * 256 + bj * 128 + wc * 32 + fq * 8;
                u32x4 gw[4], pw[4];
#pragma unroll
                for (int m = 0; m < 4; ++m) { gw[m] = *(const GAS u32x4*)(PG + (size_t)(rowb + m * 16) * 3072 + br * 1024 + col); pw[m] = (u32x4){0u, 0u, 0u, 0u}; }
                if (br > 0) {
#pragma unroll
                    for (int m = 0; m < 4; ++m) pw[m] = *(const GAS u32x4*)(MG + (size_t)(rowb + m * 16) * 1024 + col); }
#pragma unroll
                for (int m = 0; m < 4; ++m) {
                    f32x4 v0 = acc[ai][bj][m][0], v1 = acc[ai][bj][m][1];
                    v0[0] = v0[0] * bflo(gw[m].x) + bflo(pw[m].x); v0[1] = v0[1] * bfhi(gw[m].x) + bfhi(pw[m].x); v0[2] = v0[2] * bflo(gw[m].y) + bflo(pw[m].y); v0[3] = v0[3] * bfhi(gw[m].y) + bfhi(pw[m].y);
                    v1[0] = v1[0] * bflo(gw[m].z) + bflo(pw[m].z); v1[1] = v1[1] * bfhi(gw[m].z) + bfhi(pw[m].z); v1[2] = v1[2] * bflo(gw[m].w) + bflo(pw[m].w); v1[3] = v1[3] * bfhi(gw[m].w) + bfhi(pw[m].w);
                    st8(MG + (size_t)(rowb + m * 16) * 1024 + col, v0, v1);
                }
                asm volatile("" ::: "memory");
            }
    }
};
template <bool DRY = false> struct EpiResidT {
    static constexpr bool PERM = true;
    const float* hin; float* hout; bf16_t* HB; float* ssout;
    DI void operator()(const f32x4 (&acc)[2][2][4][2], const pg8::Unit& u, int wr, int wc, int fr0, int fq0) const {
        int fr = fr0, fq = fq0; asm volatile("" : "+v"(fr), "+v"(fq));
#pragma unroll
        for (int ai = 0; ai < 2; ++ai) {
            float sq[4] = {0.f, 0.f, 0.f, 0.f};
            const int rowb = u.pm * 256 + ai * 128 + wr * 64 + fr;
#pragma unroll
            for (int bj = 0; bj < 2; ++bj) {
                const size_t offb = (size_t)rowb * 1024 + u.pn * 256 + bj * 128 + wc * 32 + fq * 8;
                f32x4 ha[4], hb4[4];
#pragma unroll
                for (int m = 0; m < 4; ++m) { ha[m] = *(const GAS f32x4*)(hin + offb + (size_t)m * 16 * 1024); hb4[m] = *(const GAS f32x4*)(hin + offb + (size_t)m * 16 * 1024 + 4); }
#pragma unroll
                for (int m = 0; m < 4; ++m) {
                    const size_t off = offb + (size_t)m * 16 * 1024;
                    const f32x4 v0 = acc[ai][bj][m][0] + ha[m], v1 = acc[ai][bj][m][1] + hb4[m];
                    if (!DRY) { *(GAS f32x4*)(hout + off) = v0; *(GAS f32x4*)(hout + off + 4) = v1; }
                    st8(HB + off, v0, v1);
                    sq[m] += (v0[0] * v0[0] + v0[1] * v0[1]) + (v0[2] * v0[2] + v0[3] * v0[3]) + (v1[0] * v1[0] + v1[1] * v1[1]) + (v1[2] * v1[2] + v1[3] * v1[3]);
                }
                asm volatile("" ::: "memory");
            }
#pragma unroll
            for (int m = 0; m < 4; ++m) { float q = sq[m]; q += __shfl_xor(q, 16); q += __shfl_xor(q, 32); if (fq == 0) atomicAdd(ssout + rowb + m * 16, q); }
        }
    }
};
typedef EpiResidT<false> EpiResid;
struct EpiMemQ {
    static constexpr bool PERM = true;
    const float* ss; bf16_t* QM;
    DI void operator()(const f32x4 (&acc)[2][2][4][2], const pg8::Unit& u, int wr, int wc, int fr0, int fq0) const {
        int fr = fr0, fq = fq0; asm volatile("" : "+v"(fr), "+v"(fq));
#pragma unroll
        for (int ai = 0; ai < 2; ++ai)
#pragma unroll
            for (int m = 0; m < 4; ++m) {
                const int row = u.pm * 256 + ai * 128 + wr * 64 + m * 16 + fr;
                const float rs = rs_of(ss[row]) * C2;
#pragma unroll
                for (int bj = 0; bj < 2; ++bj) st8(QM + (size_t)row * 256 + bj * 128 + wc * 32 + fq * 8, acc[ai][bj][m][0] * rs, acc[ai][bj][m][1] * rs);
            }
    }
};
struct EpiFfnIn {
    static constexpr bool PERM = true;
    const float* ss; bf16_t* ACT;
    DI void operator()(const f32x4 (&acc)[2][2][4][2], const pg8::Unit& u, int wr, int wc, int fr0, int fq0) const {
        int fr = fr0, fq = fq0; asm volatile("" : "+v"(fr), "+v"(fq));
#pragma unroll
        for (int ai = 0; ai < 2; ++ai)
#pragma unroll
            for (int m = 0; m < 4; ++m) {
                const int row = u.pm * 256 + ai * 128 + wr * 64 + m * 16 + fr;
                const float rs = rs_of(ss[row]);
                f32x4 o0, o1;
#pragma unroll
                for (int j = 0; j < 4; ++j) { const float g0 = acc[ai][0][m][0][j] * rs, g1 = acc[ai][0][m][1][j] * rs;
                    o0[j] = g0 * sigm(g0) * (acc[ai][1][m][0][j] * rs); o1[j] = g1 * sigm(g1) * (acc[ai][1][m][1][j] * rs); }
                st8nt(ACT + (size_t)row * DFF + u.pn * 128 + wc * 32 + fq * 8, o0, o1);
            }
    }
};
constexpr int LDS_SCRATCH = 139264, MISC_OFF = LDS_SCRATCH, LDS_BYTES = 147456;
static_assert(8 * HWAVE <= LDS_SCRATCH && DS_LDS_END <= LDS_SCRATCH && 128 * 64 * 4 <= 4 * HWAVE && pg8::STAGE_BYTES <= LDS_SCRATCH, "LDS map");

#define XB_TMO      128
#define XB_XCNT(j)  (256  + 64 * (j))
#define XB_XSUB(j)  (1280 + 64 * (j))
#define XB_XGEN(j)  (2304 + 64 * (j))
#define XB_TOP      3328
#define XB_TOPGEN   3392
#define XCD_BAR_WORDS 3456
#define XB_SPIN_CAP (1u << 18)

__device__ __forceinline__ unsigned xb_ld(unsigned* p)              { return __hip_atomic_load(p, __ATOMIC_RELAXED, __HIP_MEMORY_SCOPE_AGENT); }
__device__ __forceinline__ unsigned xb_add(unsigned* p, unsigned v) { return __hip_atomic_fetch_add(p, v, __ATOMIC_RELAXED, __HIP_MEMORY_SCOPE_AGENT); }
__device__ __forceinline__ unsigned xb_xcc_id() { return (unsigned)__builtin_amdgcn_s_getreg((3 << 11) | 20) & 0xFu; }
#define XB_SPIN(cond, bar) do { unsigned _sp = 0; while (cond) { __builtin_amdgcn_s_sleep(1); \
    if ((++_sp & 255u) == 0u) { if (xb_ld(&(bar)[XB_TMO])) break; if (_sp > XB_SPIN_CAP) { atomicAdd(&(bar)[XB_TMO], 1u); break; } } } } while (0)

struct XcdBarrier {
    unsigned* bar; unsigned x;
    volatile LAS unsigned* st;
};

__device__ __forceinline__ XcdBarrier xcd_barrier_post(unsigned* bar, volatile LAS unsigned* st) {
    XcdBarrier b; b.bar = bar; b.x = xb_xcc_id(); b.st = st;
    if (threadIdx.x == 0) (void)xb_add(&bar[XB_XCNT(b.x)], 1u);
    return b;
}
__device__ __forceinline__ void xcd_barrier_complete(unsigned* bar, unsigned x, unsigned& nloc, unsigned& nx) {
    const unsigned G = gridDim.x * gridDim.y * gridDim.z;
    unsigned sum, cnt, mine, sp = 0u;
    for (;;) {
        sum = 0u; cnt = 0u; mine = 0u;
#pragma unroll
        for (unsigned j = 0; j < 16; ++j) { const unsigned c = xb_ld(&bar[XB_XCNT(j)]); sum += c; cnt += (c > 0u) ? 1u : 0u; mine = (j == x) ? c : mine; }
        if (sum == G) break;
        __builtin_amdgcn_s_sleep(1);
        if ((++sp & 255u) == 0u) { if (xb_ld(&bar[XB_TMO])) break; if (sp > XB_SPIN_CAP) { atomicAdd(&bar[XB_TMO], 1u); break; } }
    }
    nloc = mine > 0u ? mine : 1u; nx = cnt > 0u ? cnt : 1u;
}

__device__ __forceinline__ void xcd_barrier(const XcdBarrier& b) {
    asm volatile("s_waitcnt vmcnt(0)" ::: "memory");
    __syncthreads();
    if (threadIdx.x == 0) {
        unsigned* bar = b.bar;
        __builtin_amdgcn_s_waitcnt(0);
        unsigned nloc = b.st[0], nx = b.st[1];
        if (nloc == 0u) { xcd_barrier_complete(bar, b.x, nloc, nx); b.st[0] = nloc; b.st[1] = nx; }
        const unsigned old = xb_add(&bar[XB_XSUB(b.x)], 1u);
        const unsigned gen = old / nloc;
        if (old + 1u == (gen + 1u) * nloc) {
            __builtin_amdgcn_fence(__ATOMIC_RELEASE, "agent");
            asm volatile("s_waitcnt vmcnt(0)" ::: "memory");
            const unsigned og = xb_add(&bar[XB_TOP], 1u);
            const unsigned tg = og / nx;
            if (og + 1u == (tg + 1u) * nx) xb_add(&bar[XB_TOPGEN], 1u);
            else XB_SPIN(xb_ld(&bar[XB_TOPGEN]) == tg, bar);
            __builtin_amdgcn_fence(__ATOMIC_ACQUIRE, "agent");
            xb_add(&bar[XB_XGEN(b.x)], 1u);
            asm volatile("s_waitcnt vmcnt(0)" ::: "memory");
        } else {
            XB_SPIN(xb_ld(&bar[XB_XGEN(b.x)]) == gen, bar);
            __builtin_amdgcn_fence(__ATOMIC_ACQUIRE, "agent");
            asm volatile("s_waitcnt vmcnt(0)" ::: "memory");
        }
    }
    __syncthreads();
}
DI float wave_sum(float v) {
#pragma unroll
    for (int o = 1; o < 64; o <<= 1) v += __shfl_xor(v, o);
    return v;
}
DI int ropeperm(int e) { return (e & 1) ? (e >> 1) + 32 : (e >> 1); }
DI int win_srccol(int n) {
    const int pn = n >> 8, c = n & 255, g = c >> 6, e = c & 63, rp = ropeperm(e);
    switch (pn) {
        case 0: return c; case 1: return 256 + c; case 2: return 512 + c;
        case 3: return 768 + g * 64 + rp; case 4: return 1152 + g * 64 + rp; case 5: return 1476 + g * 64 + rp;
        case 6: return g == 0 ? 1024 + rp : g == 1 ? 1408 + rp : g == 2 ? 1732 + rp : 1860 + rp;
        case 7: return g == 0 ? 1988 + rp : g == 1 ? 1796 + e : g == 2 ? (e < 4 ? 1472 + e : e < 16 ? 2116 + (e - 4) : -1) : -1;
        case 8: return g == 0 ? 1088 + e : g == 1 ? 1924 + e : g == 2 ? 2052 + e : -1;
        default: return 2128 + (n - 2304);
    }
}
constexpr int CV_P = 136;
template <class ColFn> DI void conv_weight(bf16_t* dst, int N, int K, int ld, const float* gain, bool kperm, int kmax, const ColFn& colp, int gwave, int gwaves, int lane, LAS unsigned char* scr) {
    const int nkt = K >> 6, total = (N >> 6) * nkt;
    for (int t = gwave; t < total; t += gwaves) {
        const int n0 = (t / nkt) << 6, k0 = (t % nkt) << 6;
        const float* cp = colp(n0 + lane);
        const bool live = (cp != nullptr) && (k0 < kmax);
        const float* cq = live ? cp + (size_t)k0 * ld : nullptr;
#pragma unroll
        for (int c = 0; c < 2; ++c) {
            float x[32];
#pragma unroll
            for (int j = 0; j < 32; ++j) { const int kk = 32 * c + j, rr = kperm ? ropeperm(kk) : kk; x[j] = live ? cq[(size_t)rr * ld] : 0.f; }
            if (gain) {
#pragma unroll
                for (int j = 0; j < 32; ++j) x[j] *= gain[k0 + 32 * c + j];
            }
#pragma unroll
            for (int j = 0; j < 32; j += 2) *(LAS unsigned*)(scr + lane * CV_P + (32 * c + j) * 2) = cvtpk(x[j], x[j + 1]);
        }
        asm volatile("s_waitcnt lgkmcnt(0)" ::: "memory");
#pragma unroll
        for (int i = 0; i < 8; ++i) {
            const int n = 8 * i + (lane >> 3), ch = lane & 7;
            const u32x2 lo = *(LAS u32x2*)(scr + n * CV_P + ch * 16), hi = *(LAS u32x2*)(scr + n * CV_P + ch * 16 + 8);
            *(GAS u32x4*)(dst + (size_t)(n0 + n) * K + k0 + ch * 8) = (u32x4){lo.x, lo.y, hi.x, hi.y};
        }
        asm volatile("s_waitcnt lgkmcnt(0)" ::: "memory");
    }
}
DI void prologue(const Bufs& P, int gtid, int gthreads, int gwave, int gwaves, int lane, LAS unsigned char* scr) {
    for (int l = 0; l < 2; ++l) {
        { const float* W = P.w_in() + (size_t)l * 1024 * DIN;
          conv_weight(P.WIN() + (size_t)l * DINP * 1024, DINP, 1024, DIN, P.norm_mix() + l * 1024, false, 1024, [&](int n) -> const float* { const int sc = win_srccol(n); return sc < 0 ? nullptr : W + sc; }, gwave, gwaves, lane, scr); }
        { const float* W = P.w_ffn_in() + (size_t)l * 1024 * 5632;
          conv_weight(P.WFI() + (size_t)l * 5632 * 1024, 5632, 1024, 5632, P.norm_ffn() + l * 1024, false, 1024, [&](int n) -> const float* { const int c = n & 255, idx = (n >> 8) * 128 + (c & 127); return W + ((c & 128) ? DFF + idx : idx); }, gwave, gwaves, lane, scr); }
        { const float* W = P.w_ffn_out() + (size_t)l * DFF * 1024;
          conv_weight(P.WFO() + (size_t)l * 1024 * DFF, 1024, DFF, 1024, nullptr, false, DFF, [&](int n) -> const float* { return W + n; }, gwave, gwaves, lane, scr); }
        { const float* W = P.w_out() + (size_t)l * 1024 * 1024;
          conv_weight(P.WOUT() + (size_t)l * 1024 * 1024, 1024, 1024, 1024, nullptr, false, 1024, [&](int n) -> const float* { return W + n; }, gwave, gwaves, lane, scr); }
        for (int br = 0; br < 3; ++br) { const float* W = P.w_up() + ((size_t)l * 3 + br) * 256 * 1024;
          conv_weight(P.WUP() + ((size_t)l * 3 + br) * 1024 * 256, 1024, 256, 1024, nullptr, false, 256, [&](int n) -> const float* { return W + n; }, gwave, gwaves, lane, scr); }
        { const float* W = P.w_mem_q() + (size_t)l * 1024 * 256;
          conv_weight(P.WMQ() + (size_t)l * 256 * 1024, 256, 1024, 256, P.norm_mem_q() + l * 1024, false, 1024, [&](int n) -> const float* { return W + n; }, gwave, gwaves, lane, scr); }
        { const float* W = P.w_mem_kv() + (size_t)l * 1024 * 512;
          conv_weight(P.WMKV() + (size_t)l * 512 * 1024, 512, 1024, 512, P.norm_mem_kv() + l * 1024, false, 1024, [&](int n) -> const float* { return W + n; }, gwave, gwaves, lane, scr); }
        { const float* W = P.w_mem_o() + (size_t)l * 256 * 1024;
          conv_weight(P.WMO() + (size_t)l * 1024 * 256, 1024, 256, 1024, nullptr, false, 256, [&](int n) -> const float* { return W + n; }, gwave, gwaves, lane, scr); }
        { const float* Wk = P.cmp_w1_k() + (size_t)l * 2048 * 128; const float* Wv = P.cmp_w1_v() + (size_t)l * 2048 * 128;
          conv_weight(P.WC1() + (size_t)l * 256 * 2048, 128, 2048, 128, nullptr, true, 2048, [&](int n) -> const float* { return Wk + n; }, gwave, gwaves, lane, scr);
          conv_weight(P.WC1() + (size_t)l * 256 * 2048 + (size_t)128 * 2048, 128, 2048, 128, nullptr, false, 2048, [&](int n) -> const float* { return Wv + n; }, gwave, gwaves, lane, scr); }
        { const float* Wk = P.cmp_w2_k() + (size_t)l * 128 * 64; const float* Wv = P.cmp_w2_v() + (size_t)l * 128 * 64;
          conv_weight(P.WC2() + (size_t)l * 256 * 256, 256, 256, 64, nullptr, false, 128, [&](int n) -> const float* { return n < 64 ? Wk + ropeperm(n) : n < 128 ? Wv + (n - 64) : nullptr; }, gwave, gwaves, lane, scr); }
        for (int o = gwave; o < 256; o += gwaves) {
            const float* W = (o < 128 ? P.cmp_w1_k() : P.cmp_w1_v()) + (size_t)l * 2048 * 128; const float* pos = (o < 128 ? P.cmp_pos_k() : P.cmp_pos_v()) + (size_t)l * 2048; const int n = o & 127;
            float s = 0.f;
#pragma unroll 16
            for (int k = lane; k < 2048; k += 64) s += pos[k] * W[(size_t)k * 128 + n];
            s = wave_sum(s); if (lane == 0) P.BIAS1()[l * 256 + o] = s;
        }
    }
    for (int i = gtid; i < SQ * 32; i += gthreads) {
        const int pos = i >> 5, f = i & 31;
        const float inv = exp2f(-(float)f * (13.287712379549449f / 32.f));
        const float ang = (float)pos * inv;
        const double rev = (double)ang * 0.15915494309189535; const double fr = rev - __builtin_rint(rev);
        const float frf = (float)fr;
        P.rope()[i] = (f32x2){__builtin_amdgcn_cosf(frf), __builtin_amdgcn_sinf(frf)};
    }
    for (int row = 2 * gwave; row < MT + 2048; row += 2 * gwaves) {
        f32x4 v[2][4];
#pragma unroll
        for (int q = 0; q < 2; ++q) { const int rw = row + q; const bool ism = rw >= MT; const int rr = ism ? rw - MT : rw;
            const float* src = (ism ? P.mem() : P.x()) + (size_t)rr * 1024;
#pragma unroll
            for (int j = 0; j < 4; ++j) v[q][j] = *(const GAS f32x4*)(src + 256 * j + 4 * lane); }
#pragma unroll
        for (int q = 0; q < 2; ++q) { const int rw = row + q; const bool ism = rw >= MT; const int rr = ism ? rw - MT : rw;
            bf16_t* dst = (ism ? P.MEMB() : P.HB()) + (size_t)rr * 1024;
            float s = 0.f;
#pragma unroll
            for (int j = 0; j < 4; ++j) { const f32x4 t = v[q][j]; s += (t.x * t.x + t.y * t.y) + (t.z * t.z + t.w * t.w);
                u32x2 w; w.x = cvtpk(t.x, t.y); w.y = cvtpk(t.z, t.w); *(GAS u32x2*)(dst + 256 * j + 4 * lane) = w; }
            s = wave_sum(s); if (lane == 0) { if (ism) P.ssm()[rr] = s; else P.ss()[rr] = s; } }
    }
}

#ifndef PROBE_DUP
#define PROBE_DUP 0
#endif
#ifndef MK_ONE_LAUNCH
#define MK_ONE_LAUNCH 1
#endif
constexpr int NPH_LAYER = 11, PH_FINAL = 2 + 2 * NPH_LAYER, NPHASES = PH_FINAL + 1;
struct Args { Bufs P; int ph_lo, ph_hi; };

__global__ void __launch_bounds__(512, 2) mk_fwd(Args args) {
    extern __shared__ __attribute__((aligned(16))) unsigned char lds_raw[];
    LAS unsigned char* lds = (LAS unsigned char*)lds_raw;
    volatile LAS unsigned* MISC = (volatile LAS unsigned*)(lds + MISC_OFF);
    const Bufs& P = args.P;
    const int G = gridDim.x;
#define TID ((int)threadIdx.x)
#define LANE (TID & 63)
#define WAVE (__builtin_amdgcn_readfirstlane(TID >> 6))
    if (TID < 32) MISC[TID] = 0u;
    __syncthreads();
    XcdBarrier bar; bar.bar = (unsigned*)(P.ctl() + CW_BAR); bar.x = 0; bar.st = nullptr;
    if (MK_ONE_LAUNCH) bar = xcd_barrier_post((unsigned*)(P.ctl() + CW_BAR), MISC + 8);
    const int lo = args.ph_lo, hi = args.ph_hi;
#ifndef PHMASK
#define PHMASK 0xFFFFFFFFu
#endif
#define EN(i) (((PHMASK) >> (i)) & 1u)
#define IN(k) (lo <= (k) && (k) < hi)
#define SEAM(k) do { if (IN(k) && IN((k) + 1)) xcd_barrier(bar); } while (0)
#define QCTR(ph, slot) (Q.ctl() + CW_Q + ((ph) * 4 + (slot)) * 64)
#define QCTRB(ph, slot, b) (Q.ctl() + CW_Q2 + ((((ph) * 4 + (slot)) * 8 + (int)(b)) * 64))
#define FOR_WG_UNITS(ph, slot, nper, BODY) do { const unsigned myx_ = xb_xcc_id() & 7u; \
        for (unsigned qi_ = 0; qi_ < 8u; ++qi_) { const int bq = (int)((myx_ + qi_) & 7u); \
            for (;;) { if (TID == 0) MISC[16] = __hip_atomic_fetch_add(QCTRB(ph, slot, bq), 1u, RLX_AGENT); __syncthreads(); const unsigned u = MISC[16]; __syncthreads(); \
                if (u >= (unsigned)(nper)) break; BODY; } } } while (0)
#define FOR_UNITS(ph, slot, nper, BODY) do { const unsigned myx_ = xb_xcc_id() & 7u; \
        for (unsigned qi_ = 0; qi_ < 8u; ++qi_) { const int bq = (int)((myx_ + qi_) & 7u); gu32* ctr_ = QCTRB(ph, slot, bq); \
            for (;;) { const unsigned u = pull(ctr_, ln); if (u >= (unsigned)(nper)) break; BODY; } } } while (0)

    if (EN(0) && IN(0)) { prologue(P, (int)blockIdx.x * 512 + TID, G * 512, (int)blockIdx.x * 8 + WAVE, G * 8, LANE, lds + WAVE * 16384); if (PROBE_DUP == 8) prologue(P, (int)blockIdx.x * 512 + TID, G * 512, (int)blockIdx.x * 8 + WAVE, G * 8, LANE, lds + WAVE * 16384); }
    SEAM(0);
    if (EN(1) && IN(1)) {
        { pg8::Gemm g{P.HB(), P.WIN(), MT, DINP, 1024, 1024, 1024}; pg8::StaticOrder S; S.init(MT, DINP, G, (int)blockIdx.x); EpiIn E{P.ss(), P, lds + pg8::STAGE_BYTES};
          pg8::gemm_phase<EpiIn, pg8::StaticOrder, true>(lds, g, S, E);
          if (PROBE_DUP == 21) pg8::gemm_phase<EpiIn, pg8::StaticOrder, true>(lds, g, S, E);
          if (PROBE_DUP == 25) { EpiMemQ E2{P.ss(), (bf16_t*)P.out()}; pg8::gemm_phase<EpiMemQ, pg8::StaticOrder, true>(lds, g, S, E2); } }
        { pg8::Gemm g{P.MEMB(), P.WMKV(), 2048, 1024, 1024, 1024, 1024}; pg8::StaticOrder S; S.init(2048, 1024, G, (int)((blockIdx.x + G / 2) % G));   EpiMemKV E{P};
          pg8::gemm_phase<EpiMemKV, pg8::StaticOrder, false>(lds, g, S, E); }
    }
    SEAM(1);
#pragma unroll
    for (int l = 0; l < 2; ++l) {
        const int pb = 2 + l * NPH_LAYER;
        float* ss_mix = P.ss() + (size_t)(3 * l) * MT; float* ss_a = P.ss() + (size_t)(3 * l + 1) * MT; float* ss_b = P.ss() + (size_t)(3 * l + 2) * MT; float* ss_c = P.ss() + (size_t)(3 * l + 3) * MT;
        (void)ss_mix;
        if (EN(2) && IN(pb + 0)) {
            Bufs Q = P; asm volatile("" : "+s"(Q.ws), "+s"(Q.o_));
            { pg8::Gemm g{Q.KCMP(), Q.WC1() + (size_t)l * 256 * 2048, 4096, 256, 2048, 1024, 2048}; pg8::StaticOrder S; S.init(4096, 256, G, (int)blockIdx.x); EpiCmp1 E{Q.HID(), Q.BIAS1() + l * 256};
              pg8::gemm_phase<EpiCmp1, pg8::StaticOrder, false>(lds, g, S, E); }
            __syncthreads(); __builtin_amdgcn_fence(__ATOMIC_ACQUIRE, "agent"); asm volatile("s_waitcnt vmcnt(0)" ::: "memory"); __syncthreads();
            { pg8::Gemm g{Q.HID(), Q.WC2() + (size_t)l * 256 * 256, 4096, 256, 256, 256, 256}; pg8::StaticOrder S; S.init(4096, 256, G, (int)blockIdx.x); EpiCmp2All E{{Q.KC(), Q.VCT()}};
              pg8::gemm_phase<EpiCmp2All, pg8::StaticOrder, false>(lds, g, S, E); }
            int td = TID; asm volatile("" : "+v"(td)); const int ln = td & 63;
            if (PROBE_DUP == 40 || PROBE_DUP == 42) FOR_WG_UNITS(pb + 0, 2, 128, (dsa_select_wg<0, 1>(Q, bq, 127 - (int)u, ln, WAVE, (LAS unsigned*)lds)));
            else if (PROBE_DUP == 41) FOR_WG_UNITS(pb + 0, 2, 128, (dsa_select_wg<0, 2>(Q, bq, 127 - (int)u, ln, WAVE, (LAS unsigned*)lds)));
            else FOR_WG_UNITS(pb + 0, 2, 128, dsa_select_wg<0>(Q, bq, 127 - (int)u, ln, WAVE, (LAS unsigned*)lds));
            if (PROBE_DUP == 3 && l == 0) FOR_WG_UNITS(pb + 0, 3, 128, dsa_select_wg<0>(Q, bq, 127 - (int)u, ln, WAVE, (LAS unsigned*)lds));
            if (PROBE_DUP == 31 && l == 0) FOR_WG_UNITS(pb + 0, 3, 128, dsa_select_wg<11>(Q, bq, 127 - (int)u, ln, WAVE, (LAS unsigned*)lds));
            if (PROBE_DUP == 32 && l == 0) FOR_WG_UNITS(pb + 0, 3, 128, dsa_select_wg<12>(Q, bq, 127 - (int)u, ln, WAVE, (LAS unsigned*)lds));
            if (PROBE_DUP == 33 && l == 0) FOR_WG_UNITS(pb + 0, 3, 128, dsa_select_wg<13>(Q, bq, 127 - (int)u, ln, WAVE, (LAS unsigned*)lds));
            if (PROBE_DUP == 35 && l == 0) FOR_WG_UNITS(pb + 0, 3, 128, dsa_select_wg<14>(Q, bq, 127 - (int)u, ln, WAVE, (LAS unsigned*)lds));
            if (PROBE_DUP == 36 && l == 0) FOR_WG_UNITS(pb + 0, 3, 128, dsa_select_wg<15>(Q, bq, 127 - (int)u, ln, WAVE, (LAS unsigned*)lds));
            if (PROBE_DUP == 34 && l == 0) FOR_WG_UNITS(pb + 0, 3, 128, dsa_select_wg<10>(Q, bq, 127 - (int)u, ln, WAVE, (LAS unsigned*)lds));
            FOR_UNITS(pb + 0, 1, 512, sb_unit(Q, bq, (int)(u >> 7), (int)(u & 127u), ln));
            if (PROBE_DUP == 2 && l == 0) FOR_UNITS(pb + 0, 0, 512, sb_unit(Q, bq, (int)(u >> 7), (int)(u & 127u), ln));
        }
        SEAM(pb + 0);
        if (EN(3) && IN(pb + 1)) {
            Bufs Q = P; asm volatile("" : "+s"(Q.ws), "+s"(Q.o_));
            int td = TID; asm volatile("" : "+v"(td)); const int ln = td & 63;
            if (PROBE_DUP == 40 || PROBE_DUP == 41 || PROBE_DUP == 43) FOR_UNITS(pb + 1, 1, 128, nsa_cmp_unit<1>(Q, bq, 127 - (int)u, ln, (LAS float*)(lds + WAVE * HWAVE)));
            else FOR_UNITS(pb + 1, 1, 128, nsa_cmp_unit<0>(Q, bq, 127 - (int)u, ln, (LAS float*)(lds + WAVE * HWAVE)));
            FOR_WG_UNITS(pb + 1, 0, 64, dsa_attn_wg(Q, bq, 63 - (int)u, ln, WAVE, td, lds));
            if (PROBE_DUP == 6 && l == 0) FOR_WG_UNITS(pb + 1, 3, 64, dsa_attn_wg(Q, bq, 63 - (int)u, ln, WAVE, td, lds));
            if (PROBE_DUP == 61 && l == 0) FOR_WG_UNITS(pb + 1, 3, 64, dsa_attn_wg<1>(Q, bq, 63 - (int)u, ln, WAVE, td, lds));
            if (PROBE_DUP == 62 && l == 0) FOR_WG_UNITS(pb + 1, 3, 64, dsa_attn_wg<2>(Q, bq, 63 - (int)u, ln, WAVE, td, lds));
            if (PROBE_DUP == 63 && l == 0) FOR_WG_UNITS(pb + 1, 3, 64, dsa_attn_wg<3>(Q, bq, 63 - (int)u, ln, WAVE, td, lds));
        }
        SEAM(pb + 1);
        if (EN(5) && IN(pb + 2)) {
            Bufs Q = P; asm volatile("" : "+s"(Q.ws), "+s"(Q.o_));
            int td = TID; asm volatile("" : "+v"(td)); const int ln = td & 63;
            FOR_WG_UNITS(pb + 2, 1, 64, nsa_selwin_wg(Q, bq, 63 - (int)u, ln, WAVE, td, lds, Q.O3()));
            if (PROBE_DUP == 5 && l == 0) FOR_WG_UNITS(pb + 2, 3, 64, nsa_selwin_wg(Q, bq, 63 - (int)u, ln, WAVE, td, lds, (bf16_t*)Q.out()));
        }
        SEAM(pb + 2);
        if (EN(6) && IN(pb + 3)) {
            Bufs Q = P; asm volatile("" : "+s"(Q.ws), "+s"(Q.o_));
            pg8::ChainOrder3 S; S.init(MT, 1024, G, (int)blockIdx.x);
            pg8::Gemm g{Q.O3(), Q.WUP() + (size_t)l * 3 * 1024 * 256, MT, 1024, 256, 768, 256, (size_t)256 * 2, (size_t)1024 * 256 * 2};
            EpiMerge E{Q.PG(), Q.MG()};
            pg8::gemm_phase<EpiMerge, pg8::ChainOrder3, true>(lds, g, S, E);
        }
        SEAM(pb + 3);
        if (EN(7) && IN(pb + 4)) {
            Bufs Q = P; asm volatile("" : "+s"(Q.ws), "+s"(Q.o_));
            pg8::Gemm g{Q.MG(), Q.WOUT() + (size_t)l * 1024 * 1024, MT, 1024, 1024, 1024, 1024}; pg8::StaticOrder S; S.init(MT, 1024, G, (int)blockIdx.x);
            EpiResid E{l == 0 ? Q.x() : (const float*)Q.out(), Q.out(), Q.HB(), ss_a};
            pg8::gemm_phase<EpiResid, pg8::StaticOrder, true>(lds, g, S, E);
            if (PROBE_DUP == 24 && l == 0) { EpiResid E2{Q.x(), Q.out(), Q.HB(), (float*)Q.TAU()}; pg8::gemm_phase<EpiResid, pg8::StaticOrder, true>(lds, g, S, E2); }
        }
        SEAM(pb + 4);
        if (EN(8) && IN(pb + 5)) {
            Bufs Q = P; asm volatile("" : "+s"(Q.ws), "+s"(Q.o_));
            pg8::Gemm g{Q.HB(), Q.WMQ() + (size_t)l * 256 * 1024, MT, 256, 1024, 1024, 1024}; pg8::StaticOrder S; S.init(MT, 256, G, (int)blockIdx.x); EpiMemQ E{ss_a, Q.QM()};
            pg8::gemm_phase<EpiMemQ, pg8::StaticOrder, false>(lds, g, S, E);
            if (PROBE_DUP == 28 && l == 0) pg8::gemm_phase<EpiMemQ, pg8::StaticOrder, false>(lds, g, S, E);
        }
        SEAM(pb + 5);
        if (EN(9) && IN(pb + 6)) {
            Bufs Q = P; asm volatile("" : "+s"(Q.ws), "+s"(Q.o_));
            int td = TID; asm volatile("" : "+v"(td)); const int ln = td & 63;
            FOR_WG_UNITS(pb + 6, 0, 64, mem_attn_wg(Q, l, bq, (int)(u & 3u), (int)(u >> 2), ln, WAVE, td, lds));
            if (PROBE_DUP == 7 && l == 0) FOR_WG_UNITS(pb + 6, 3, 64, mem_attn_wg(Q, l, bq, (int)(u & 3u), (int)(u >> 2), ln, WAVE, td, lds));
        }
        SEAM(pb + 6);
        if (EN(10) && IN(pb + 7)) {
            Bufs Q = P; asm volatile("" : "+s"(Q.ws), "+s"(Q.o_));
            pg8::Gemm g{Q.OM(), Q.WMO() + (size_t)l * 1024 * 256, MT, 1024, 256, 256, 256}; pg8::StaticOrder S; S.init(MT, 1024, G, (int)blockIdx.x);
            EpiResid E{Q.out(), Q.out(), Q.HB(), ss_b};
            pg8::gemm_phase<EpiResid, pg8::StaticOrder, true>(lds, g, S, E);
            if (PROBE_DUP == 27 && l == 0) { EpiResidT<true> E2{Q.out(), Q.out(), Q.PA(), (float*)Q.TAU()}; pg8::gemm_phase<EpiResidT<true>, pg8::StaticOrder, true>(lds, g, S, E2); }
        }
        SEAM(pb + 7);
        if (EN(11) && IN(pb + 8)) {
            Bufs Q = P; asm volatile("" : "+s"(Q.ws), "+s"(Q.o_));
            pg8::Gemm g{Q.HB(), Q.WFI() + (size_t)l * 5632 * 1024, MT, 5632, 1024, 1024, 1024}; pg8::StaticOrder S; S.init(MT, 5632, G, (int)blockIdx.x); EpiFfnIn E{ss_b, Q.ACT()};
            pg8::gemm_phase<EpiFfnIn, pg8::StaticOrder, true>(lds, g, S, E);
            if (PROBE_DUP == 22 && l == 0) pg8::gemm_phase<EpiFfnIn, pg8::StaticOrder, true>(lds, g, S, E);
        }
        SEAM(pb + 8);
        if (EN(12) && IN(pb + 9)) {
            Bufs Q = P; asm volatile("" : "+s"(Q.ws), "+s"(Q.o_));
            pg8::Gemm g{Q.ACT(), Q.WFO() + (size_t)l * 1024 * DFF, MT, 1024, DFF, DFF, DFF}; pg8::StaticOrder S; S.init(MT, 1024, G, (int)blockIdx.x);
            EpiResid E{Q.out(), Q.out(), Q.HB(), ss_c};
            pg8::gemm_phase<EpiResid, pg8::StaticOrder, true>(lds, g, S, E);
            if (PROBE_DUP == 26 && l == 0) { EpiResidT<true> E2{Q.out(), Q.out(), Q.PA(), (float*)Q.TAU()}; pg8::gemm_phase<EpiResidT<true>, pg8::StaticOrder, true>(lds, g, S, E2); }
        }
        SEAM(pb + 9);
        if (EN(13) && IN(pb + 10) && l == 0) {
            Bufs Q = P; asm volatile("" : "+s"(Q.ws), "+s"(Q.o_));
            pg8::Gemm g{Q.HB(), Q.WIN() + (size_t)DINP * 1024, MT, DINP, 1024, 1024, 1024}; pg8::StaticOrder S; S.init(MT, DINP, G, (int)blockIdx.x); EpiIn E{ss_c, Q, lds + pg8::STAGE_BYTES};
            pg8::gemm_phase<EpiIn, pg8::StaticOrder, true>(lds, g, S, E);
        }
        if (l == 0) SEAM(pb + 10);
    }
    if (PROBE_DUP == 30) { for (int i = 0; i < 20; ++i) xcd_barrier(bar); }
    if (EN(15) && IN(PH_FINAL)) {
        const float* ssf = P.ss() + (size_t)6 * MT;
        const int lane = LANE, gwave = (int)blockIdx.x * 8 + WAVE, gwaves = G * 8;
        const unsigned chkflag = (PROBE_DUP >= 40 && PROBE_DUP <= 43) ? __hip_atomic_load(P.ctl() + 2, RLX_AGENT) : 0u;
        for (int row = gwave; row < MT; row += gwaves) {
            const float rs = rs_of(ssf[row]); float* o = P.out() + (size_t)row * 1024;
#pragma unroll
            for (int j = 0; j < 4; ++j) { const f32x4 v = *(const GAS f32x4*)(o + 256 * j + 4 * lane), g = *(const GAS f32x4*)(P.norm_final() + 256 * j + 4 * lane); *(GAS f32x4*)(o + 256 * j + 4 * lane) = v * rs * g; }
            if (chkflag && row == 0 && lane < 2) o[lane] = (chkflag & (1u << lane)) ? __builtin_nanf("") : o[lane];
        }
    }
#undef IN
#undef SEAM
#undef QCTR
}

extern "C" void kernel_launch(void* const* d_in, const int* in_sizes, int n_in, void* d_out, int out_size, void* d_ws, size_t ws_size, hipStream_t stream) {
    static int grid = 0;
    if (grid == 0) {
        if (n_in != 21 || in_sizes[0] != MT * DM || out_size != MT * DM || ws_size < WS_END) {
            fprintf(stderr, "kernel_launch: unexpected problem: n_in %d in0 %d out %d ws %zu (need %zu); nothing launched\n", n_in, n_in > 0 ? in_sizes[0] : -1, out_size, ws_size, (size_t)WS_END); grid = -1; return; }
        int dev = 0, cus = 0, per_cu = 0;
        if (hipGetDevice(&dev) != hipSuccess || hipDeviceGetAttribute(&cus, hipDeviceAttributeMultiprocessorCount, dev) != hipSuccess) { grid = -1; return; }
        if (hipFuncSetAttribute((const void*)mk_fwd, hipFuncAttributeMaxDynamicSharedMemorySize, LDS_BYTES) != hipSuccess) { fprintf(stderr, "kernel_launch: hipFuncSetAttribute failed\n"); grid = -1; return; }
        if (hipOccupancyMaxActiveBlocksPerMultiprocessor(&per_cu, (const void*)mk_fwd, 512, LDS_BYTES) != hipSuccess || per_cu < 1)
            fprintf(stderr, "kernel_launch: note: occupancy query reports %d workgroups per CU\n", per_cu);
        (void)hipGetLastError();
        grid = cus;
    }
    if (grid < 0) return;
    if (hipMemsetAsync((char*)d_ws + WS_CTL, 0, CTL_ZERO_BYTES, stream) != hipSuccess) { fprintf(stderr, "kernel_launch: memset failed\n"); return; }
    Args a{};
    for (int i = 0; i < 21; ++i) a.P.in[i] = (const float*)d_in[i];
    a.P.o_ = (float*)d_out; a.P.ws = (unsigned char*)d_ws;
#if MK_ONE_LAUNCH
    a.ph_lo = 0; a.ph_hi = NPHASES;
    hipLaunchKernelGGL(mk_fwd, dim3(grid), dim3(512), LDS_BYTES, stream, a);
#else
    for (int ph = 0; ph < NPHASES; ++ph) { a.ph_lo = ph; a.ph_hi = ph + 1; hipLaunchKernelGGL(mk_fwd, dim3(grid), dim3(512), LDS_BYTES, stream, a); }
#endif
    const hipError_t le = hipPeekAtLastError();
    if (le != hipSuccess) fprintf(stderr, "kernel_launch: launch failed: %s\n", hipGetErrorName(le));
}
```

```cpp
#include <hip/hip_runtime.h>
#include <cstdio>
#include <cstdint>
#include <type_traits>

#define DI __device__ __forceinline__
#define GAS __attribute__((address_space(1)))
#define LAS __attribute__((address_space(3)))
typedef unsigned short bf16_t;
typedef short bf16x8 __attribute__((ext_vector_type(8)));
typedef short s16x4 __attribute__((ext_vector_type(4)));
typedef float f32x4 __attribute__((ext_vector_type(4)));
typedef float f32x2 __attribute__((ext_vector_type(2)));
typedef float f32x16 __attribute__((ext_vector_type(16)));
typedef unsigned u32x4 __attribute__((ext_vector_type(4)));
typedef unsigned u32x2 __attribute__((ext_vector_type(2)));
typedef GAS unsigned gu32;
typedef __bf16 bf16x2_t __attribute__((ext_vector_type(2)));
#define RLX_AGENT __ATOMIC_RELAXED, __HIP_MEMORY_SCOPE_AGENT

DI unsigned cvtpk(float lo, float hi) { f32x2 v = {lo, hi}; bf16x2_t b = __builtin_convertvector(v, bf16x2_t); return __builtin_bit_cast(unsigned, b); }
DI float bf2f(bf16_t h) { return __builtin_bit_cast(float, (unsigned)h << 16); }
DI float bflo(unsigned w) { return __builtin_bit_cast(float, w << 16); }
DI float bfhi(unsigned w) { return __builtin_bit_cast(float, w & 0xffff0000u); }

namespace pg8 {
constexpr int BM = 256, BK = 64, HALF = 128, HTB = HALF * BK * 2  , STAGE_BYTES = 8 * HTB, NXCD = 8, WGM = 8;

__host__ __device__ __forceinline__ int lds_byte(int r, int c) { const int st = (r >> 4) * 2 + (c >> 5), rr = r & 15, cc = c & 31, ob = rr * 64 + cc * 2; return st * 1024 + (ob ^ (((ob >> 9) & 1) << 5)); }
__host__ __device__ __forceinline__ void stage_rc(int b, int& R, int& C) { const int st = b / 1024, sb = b % 1024, swz = sb ^ (((sb >> 9) & 1) << 5); R = (st >> 1) * 16 + swz / 64; C = (st & 1) * 32 + (swz % 64) / 2; }
__host__ __device__ __forceinline__ int perm32(int rho) { const int n = rho >> 4, i = rho & 15; return 8 * (i >> 2) + 4 * n + (i & 3); }

struct Unit { int pm, pn, br; };
struct Gemm { const bf16_t* A; const bf16_t* Bt; int M, N, K, lda, ldb; size_t brA = 0, brB = 0; };

struct StaticOrder {
    int nM, nN, nwg, G, c;
    __host__ __device__ __forceinline__ void init(int M, int N, int G_, int c_) { nM = M / BM; nN = N / BM; nwg = nM * nN; G = G_; c = c_; }
    __host__ __device__ __forceinline__ bool next(int i, Unit& u) const {
        const long L = (long)i * G + c; if (L >= nwg) return false;
        int wgid = (int)L; { const int q = nwg / NXCD, r = nwg % NXCD, xcd = wgid % NXCD, off = wgid / NXCD; wgid = (xcd < r ? xcd * (q + 1) : r * (q + 1) + (xcd - r) * q) + off; }
        const int nig = WGM * nN, gid = wgid / nig, fm = gid * WGM, gsz = (nM - fm) < WGM ? (nM - fm) : WGM;
        u.pm = fm + ((wgid % nig) % gsz); u.pn = (wgid % nig) / gsz; u.br = 0; return true;
    }
    __device__ __forceinline__ void a_ready(const Unit&) const {}
    __device__ __forceinline__ void done(const Unit&) const {}
};

struct ChainOrder3 : StaticOrder {
    __host__ __device__ __forceinline__ bool next(int i, Unit& u) const { const int t = i / 3; if (!StaticOrder::next(t, u)) return false; u.br = i - 3 * t; return true; }
};

template <class Epi, class Sched, bool ALIGN_EPI = false>
__device__ __forceinline__ void gemm_phase(LAS unsigned char* lds, const Gemm g, const Sched& S, const Epi& E) {
    int tid = threadIdx.x; asm volatile("" : "+v"(tid));
    const int wid = __builtin_amdgcn_readfirstlane(tid >> 6), lane = tid & 63, wr = wid >> 2, wc = wid & 3, fr = lane & 15, fq = lane >> 4;
    const int K = g.K, nt = K / BK;
    unsigned voffA[2], voffB[2];
#pragma unroll
    for (int i = 0; i < 2; ++i) { int R, C; stage_rc(tid * 16 + i * 8192, R, C); const int Rb = Epi::PERM ? ((R & ~31) + perm32(R & 31)) : R;
        voffA[i] = (unsigned)(R * g.lda + C) * 2u; voffB[i] = (unsigned)(Rb * g.ldb + C) * 2u; }
    const size_t kstep = (size_t)(BK * 2);
    const size_t hstepA = (size_t)HALF * g.lda * 2, hstepB = (size_t)HALF * g.ldb * 2;
    const size_t tstepA = 2 * hstepA, tstepB = 2 * hstepB;
    const unsigned ldsw = (unsigned)wid * 1024u;
    const int aoff = lds_byte(wr * 64 + fr, fq * 8), boff = lds_byte(wc * 32 + fr, fq * 8);
#define PG8_SA(b, h) (((b) * 2 + (h)) * HTB)
#define PG8_SB(b, h) ((4 + (b) * 2 + (h)) * HTB)
#define PG8_STAGE(bufoff, gbase, voff) do { _Pragma("unroll") for (int _i = 0; _i < 2; ++_i) \
        __builtin_amdgcn_global_load_lds((const unsigned*)((const char*)(gbase) + (voff)[_i]), (LAS unsigned*)(lds + (bufoff) + ldsw + _i * 8192), 16, 0, 0); } while (0)
#define PG8_LDA(dst, b, h) do { _Pragma("unroll") for (int m = 0; m < 4; ++m) _Pragma("unroll") for (int k = 0; k < 2; ++k) dst[m][k] = *(const LAS bf16x8*)(lds + PG8_SA(b, h) + aoff + m * 2048 + k * 1024); } while (0)
#define PG8_LDB(dst, b, h) do { _Pragma("unroll") for (int n = 0; n < 2; ++n) _Pragma("unroll") for (int k = 0; k < 2; ++k) dst[n][k] = *(const LAS bf16x8*)(lds + PG8_SB(b, h) + boff + n * 2048 + k * 1024); } while (0)
#define PG8_MMA(ai, bj, At, Bt) do { __builtin_amdgcn_s_setprio(1); _Pragma("unroll") for (int m = 0; m < 4; ++m) _Pragma("unroll") for (int n = 0; n < 2; ++n) _Pragma("unroll") for (int k = 0; k < 2; ++k) \
        acc[ai][bj][m][n] = __builtin_amdgcn_mfma_f32_16x16x32_bf16(Bt[n][k], At[m][k], acc[ai][bj][m][n], 0, 0, 0); __builtin_amdgcn_s_setprio(0); } while (0)
#define PG8_WAIT_V(n) asm volatile("s_waitcnt vmcnt(" #n ")" ::: "memory")
#define PG8_WAIT_L(n) asm volatile("s_waitcnt lgkmcnt(" #n ")" ::: "memory")
#define PG8_BAR __builtin_amdgcn_s_barrier()
#define PG8_SCHED __builtin_amdgcn_sched_barrier(0)
    Unit cur, nxt; int ui = 0;
    if (!S.next(0, cur)) return;
    f32x4 acc[2][2][4][2];
#pragma unroll
    for (int a = 0; a < 2; ++a)
#pragma unroll
        for (int b = 0; b < 2; ++b)
#pragma unroll
            for (int m = 0; m < 4; ++m)
#pragma unroll
                for (int n = 0; n < 2; ++n) acc[a][b][m][n] = (f32x4){0.f, 0.f, 0.f, 0.f};
    bf16x8 At[4][2], B0[2][2], B1[2][2];
    const char* cA = (const char*)g.A + (size_t)cur.pm * tstepA + (size_t)cur.br * g.brA; const char* cB = (const char*)g.Bt + (size_t)cur.pn * tstepB + (size_t)cur.br * g.brB;
    S.a_ready(cur);
    PG8_STAGE(PG8_SB(0, 0), cB, voffB); PG8_STAGE(PG8_SB(0, 1), cB + hstepB, voffB); PG8_STAGE(PG8_SA(0, 0), cA, voffA); PG8_STAGE(PG8_SA(0, 1), cA + hstepA, voffA);
    if (wr == 1) PG8_BAR;
    PG8_WAIT_V(2); PG8_BAR;
    PG8_STAGE(PG8_SB(1, 0), cB + kstep, voffB); PG8_STAGE(PG8_SA(1, 0), cA + kstep, voffA); PG8_STAGE(PG8_SB(1, 1), cB + hstepB + kstep, voffB);
    PG8_WAIT_V(6); PG8_BAR;
    for (;;) {
        const bool has_next = S.next(ui + 1, nxt);
        const char* nA = has_next ? (const char*)g.A + (size_t)nxt.pm * tstepA + (size_t)nxt.br * g.brA : cA; const char* nB = has_next ? (const char*)g.Bt + (size_t)nxt.pn * tstepB + (size_t)nxt.br * g.brB : cB;
#pragma clang loop unroll(disable)
        for (int t = 0; t < nt; t += 2) {
            const bool last = (t == nt - 2);
            const char* a1 = cA + (size_t)(t + 1) * kstep;
            const char* a2 = last ? nA : cA + (size_t)(t + 2) * kstep; const char* b2 = last ? nB : cB + (size_t)(t + 2) * kstep;
            const char* a3 = a2 + kstep; const char* b3 = b2 + kstep;
            if (last && has_next) S.a_ready(nxt);
            PG8_LDB(B0, 0, 0); PG8_LDB(B1, 0, 1); PG8_SCHED; PG8_LDA(At, 0, 0); PG8_STAGE(PG8_SA(1, 1), a1 + hstepA, voffA);
            PG8_WAIT_V(8); PG8_WAIT_L(0); PG8_BAR; PG8_MMA(0, 0, At, B0); PG8_MMA(0, 1, At, B1); PG8_BAR; PG8_SCHED;
            PG8_LDA(At, 0, 1); PG8_STAGE(PG8_SB(0, 0), b2, voffB); PG8_STAGE(PG8_SB(0, 1), b2 + hstepB, voffB); PG8_STAGE(PG8_SA(0, 0), a2, voffA);
            PG8_WAIT_V(8); PG8_WAIT_L(0); PG8_BAR; PG8_MMA(1, 0, At, B0); PG8_MMA(1, 1, At, B1); PG8_BAR; PG8_SCHED;
            PG8_LDB(B0, 1, 0); PG8_LDB(B1, 1, 1); PG8_SCHED; PG8_LDA(At, 1, 0); PG8_STAGE(PG8_SA(0, 1), a2 + hstepA, voffA);
            PG8_WAIT_V(8); PG8_WAIT_L(0); PG8_BAR; PG8_MMA(0, 0, At, B0); PG8_MMA(0, 1, At, B1); PG8_BAR; PG8_SCHED;
            PG8_LDA(At, 1, 1); PG8_STAGE(PG8_SB(1, 0), b3, voffB); PG8_STAGE(PG8_SB(1, 1), b3 + hstepB, voffB); PG8_STAGE(PG8_SA(1, 0), a3, voffA);
            PG8_WAIT_V(8); PG8_WAIT_L(0); PG8_BAR; PG8_MMA(1, 0, At, B0); PG8_MMA(1, 1, At, B1); PG8_BAR; PG8_SCHED;
        }
        if constexpr (ALIGN_EPI) { if (wr == 0) PG8_BAR; }
        E(acc, cur, wr, wc, fr, fq); S.done(cur);
        if (!has_next) break;
#pragma unroll
        for (int a = 0; a < 2; ++a)
#pragma unroll
            for (int b = 0; b < 2; ++b)
#pragma unroll
                for (int m = 0; m < 4; ++m)
#pragma unroll
                    for (int n = 0; n < 2; ++n) acc[a][b][m][n] = (f32x4){0.f, 0.f, 0.f, 0.f};
        cur = nxt; cA = nA; cB = nB; ++ui;
        if constexpr (ALIGN_EPI) { if (wr == 1) PG8_BAR; }
    }
    PG8_WAIT_V(0);
    if constexpr (!ALIGN_EPI) { if (wr == 0) PG8_BAR; }
    PG8_BAR;
#undef PG8_SA
#undef PG8_SB
#undef PG8_STAGE
#undef PG8_LDA
#undef PG8_LDB
#undef PG8_MMA
#undef PG8_WAIT_V
#undef PG8_WAIT_L
#undef PG8_BAR
#undef PG8_SCHED
}
}
constexpr int NB = 8, SQ = 4096, DM = 1024, MT = NB * SQ;
constexpr int DIN = 5200, DINP = 5376, DFF = 2816, NMEM = 256;
constexpr int PAP = 1600;
constexpr int C_QA = 0, C_KA = 256, C_QB = 512, C_QI = 768, C_QC = 1024, C_KB = 1280, C_KI = 1344, C_KSEL = 1472, C_KWIN = 1536;
constexpr float LOG2E = 1.4426950408889634f;
constexpr float C2 = 0.125f * LOG2E;
constexpr float RMS_EPS = 1e-6f;

#define MFMA32(a, b, c) __builtin_amdgcn_mfma_f32_32x32x16_bf16((a), (b), (c), 0, 0, 0)
DI int crow(int i, int hh) { return (i & 3) + 8 * (i >> 2) + 4 * hh; }
DI bf16x8 ldg16(const bf16_t* p) { return *(const GAS bf16x8*)p; }
DI bf16x8 ld_vt(const bf16_t* p) { const s16x4 lo = *(const GAS s16x4*)p, hi = *(const GAS s16x4*)(p + 8); return __builtin_shufflevector(lo, hi, 0, 1, 2, 3, 4, 5, 6, 7); }
DI bf16x8 pack8(const f32x16& x, int s) { u32x4 p; p.x = cvtpk(x[8 * s], x[8 * s + 1]); p.y = cvtpk(x[8 * s + 2], x[8 * s + 3]); p.z = cvtpk(x[8 * s + 4], x[8 * s + 5]); p.w = cvtpk(x[8 * s + 6], x[8 * s + 7]); return __builtin_bit_cast(bf16x8, p); }
DI unsigned shx32u(unsigned v) { auto rr = __builtin_amdgcn_permlane32_swap(v, v, false, false); return (threadIdx.x & 32u) ? rr[0] : rr[1]; }
DI float shx32(float v) { return __uint_as_float(shx32u(__float_as_uint(v))); }
DI f32x16 zero16() { f32x16 z; _Pragma("unroll") for (int i = 0; i < 16; ++i) z[i] = 0.f; return z; }
DI unsigned pull(gu32* ctr, int lane) { unsigned v = 0; if (lane == 0) v = __hip_atomic_fetch_add(ctr, 1u, RLX_AGENT); return (unsigned)__builtin_amdgcn_readfirstlane((int)v); }
DI unsigned bitif(bool c, int i) { unsigned b = c ? 1u : 0u; asm("" : "+v"(b)); return b << i; }
DI float fexp2(float x) { return __builtin_amdgcn_exp2f(x); }
DI float flog2(float x) { return __builtin_amdgcn_logf(x); }

DI f32x16 qk_tile(const bf16_t* kp, const bf16x8 (&qf)[4]) {
    bf16x8 kf[4];
#pragma unroll
    for (int s = 0; s < 4; ++s) kf[s] = ldg16(kp + 16 * s);
    f32x16 z = zero16();
#pragma unroll
    for (int s = 0; s < 4; ++s) z = MFMA32(kf[s], qf[s], z);
    return z;
}
DI void pv_tile(f32x16& o0, f32x16& o1, const bf16_t* vp, size_t vts, const f32x16& p) {
#pragma unroll
    for (int s = 0; s < 2; ++s) {
        const bf16x8 pf = pack8(p, s);
        const bf16x8 v0 = ld_vt(vp + 16 * s), v1 = ld_vt(vp + 32 * vts + 16 * s);
        o0 = MFMA32(v0, pf, o0); o1 = MFMA32(v1, pf, o1);
    }
}
DI void store_ot(bf16_t* orow, const f32x16& o0, const f32x16& o1, float sc, int hh) {
#pragma unroll
    for (int g = 0; g < 4; ++g) {
        u32x2 w0, w1;
        w0.x = cvtpk(o0[4 * g] * sc, o0[4 * g + 1] * sc); w0.y = cvtpk(o0[4 * g + 2] * sc, o0[4 * g + 3] * sc);
        w1.x = cvtpk(o1[4 * g] * sc, o1[4 * g + 1] * sc); w1.y = cvtpk(o1[4 * g + 2] * sc, o1[4 * g + 3] * sc);
        *(GAS u32x2*)(orow + 8 * g + 4 * hh) = w0; *(GAS u32x2*)(orow + 32 + 8 * g + 4 * hh) = w1;
    }
}

struct KV { bf16x8 k[4]; bf16x8 v[4]; };
DI void load_k4(bf16x8 (&k)[4], const bf16_t* kp) {
#pragma unroll
    for (int s = 0; s < 4; ++s) k[s] = ldg16(kp + 16 * s);
}
DI void load_kv(KV& t, const bf16_t* kp, const bf16_t* vp, size_t vts) {
    load_k4(t.k, kp);
#pragma unroll
    for (int s = 0; s < 2; ++s) { t.v[2 * s] = ld_vt(vp + 16 * s); t.v[2 * s + 1] = ld_vt(vp + 32 * vts + 16 * s); }
}
DI f32x16 qk_frag(const bf16x8 (&kf)[4], const bf16x8 (&qf)[4]) {
    f32x16 z = zero16();
#pragma unroll
    for (int s = 0; s < 4; ++s) z = MFMA32(kf[s], qf[s], z);
    return z;
}
DI void pv_frag(f32x16& o0, f32x16& o1, const bf16x8 (&v)[4], const f32x16& p) {
#pragma unroll
    for (int s = 0; s < 2; ++s) { const bf16x8 pf = pack8(p, s); o0 = MFMA32(v[2 * s], pf, o0); o1 = MFMA32(v[2 * s + 1], pf, o1); }
}
constexpr float SM_THR = 10.f;
template <bool MASKED = true> DI void softmax_step(f32x16& z, unsigned vm, float& m, float& l, f32x16& o0, f32x16& o1) {
    const float ninf = -__builtin_inff();
    if (MASKED) {
#pragma unroll
    for (int i = 0; i < 16; ++i) z[i] = ((vm >> i) & 1u) ? z[i] : ninf; }
    float t0 = __builtin_fmaxf(__builtin_fmaxf(z[0], z[1]), z[2]), t1 = __builtin_fmaxf(__builtin_fmaxf(z[3], z[4]), z[5]), t2 = __builtin_fmaxf(__builtin_fmaxf(z[6], z[7]), z[8]),
          t3 = __builtin_fmaxf(__builtin_fmaxf(z[9], z[10]), z[11]), t4 = __builtin_fmaxf(__builtin_fmaxf(z[12], z[13]), z[14]);
    float tm = __builtin_fmaxf(__builtin_fmaxf(__builtin_fmaxf(t0, t1), __builtin_fmaxf(t2, t3)), __builtin_fmaxf(t4, z[15]));
    tm = __builtin_fmaxf(tm, shx32(tm));
    const float mc = __builtin_fmaxf(m, tm);
    if (__any(mc > m + SM_THR)) {
        const float alpha = fexp2(m - mc);
        l *= alpha;
#pragma unroll
        for (int i = 0; i < 16; ++i) { o0[i] *= alpha; o1[i] *= alpha; }
        m = mc;
    }
    float ls = 0.f;
#pragma unroll
    for (int i = 0; i < 16; ++i) { z[i] = fexp2(z[i] - m); ls += z[i]; }
    l += ls;
}
DI float sm_meff(float m) { return m > -1e29f ? m : 0.f; }
DI f32x16 qk_frag_init(const bf16x8 (&kf)[4], const bf16x8 (&qf)[4], const f32x16& init) {
    f32x16 z = init;
#pragma unroll
    for (int s = 0; s < 4; ++s) z = MFMA32(kf[s], qf[s], z);
    return z;
}
DI float max_x32(float v) { auto rr = __builtin_amdgcn_permlane32_swap(__float_as_uint(v), __float_as_uint(v), false, false); return fmaxf(__uint_as_float(rr[0]), __uint_as_float(rr[1])); }
DI float add_x32(float v) { auto rr = __builtin_amdgcn_permlane32_swap(__float_as_uint(v), __float_as_uint(v), false, false); return __uint_as_float(rr[0]) + __uint_as_float(rr[1]); }
DI void softmax_core(f32x16& z, float& m, float& l, f32x16& o0, f32x16& o1) {
    float t0 = __builtin_fmaxf(__builtin_fmaxf(z[0], z[1]), z[2]), t1 = __builtin_fmaxf(__builtin_fmaxf(z[3], z[4]), z[5]), t2 = __builtin_fmaxf(__builtin_fmaxf(z[6], z[7]), z[8]),
          t3 = __builtin_fmaxf(__builtin_fmaxf(z[9], z[10]), z[11]), t4 = __builtin_fmaxf(__builtin_fmaxf(z[12], z[13]), z[14]);
    float tm = __builtin_fmaxf(__builtin_fmaxf(__builtin_fmaxf(t0, t1), __builtin_fmaxf(t2, t3)), __builtin_fmaxf(t4, z[15]));
    tm = max_x32(tm);
    const bool started = m > -1e29f, haskey = tm > -3e38f;
    if (__any(started ? (tm > SM_THR) : haskey)) {
        const float delta = started ? __builtin_fmaxf(tm, 0.f) : (haskey ? tm : 0.f);
        const float alpha = started ? fexp2(-delta) : 1.f;
        l *= alpha;
#pragma unroll
        for (int i = 0; i < 16; ++i) { o0[i] *= alpha; o1[i] *= alpha; z[i] -= delta; }
        m = started ? m + delta : (haskey ? tm : m);
    }
    float ls = 0.f;
#pragma unroll
    for (int i = 0; i < 16; ++i) { z[i] = fexp2(z[i]); ls += z[i]; }
    l += ls;
}
template <bool SKIP, class MaskFn>
DI void attn_tiles(f32x16& o0, f32x16& o1, float& m, float& l, const bf16x8 (&qf)[4], const bf16_t* kbase, size_t kpitch, const bf16_t* vtbase, size_t vts,
                   int kt_lo, int kt_hi, const MaskFn& mask, int r, int hh) {
    const bf16_t* kl = kbase + (size_t)r * kpitch + 8 * hh; const bf16_t* vl = vtbase + (size_t)r * vts + 4 * hh;
    int kt = kt_lo; unsigned vm = 0u;
    if (SKIP) { for (; kt <= kt_hi; ++kt) { vm = mask(kt); if (__any(vm != 0u)) break; } } else { if (kt <= kt_hi) vm = mask(kt); }
    if (kt > kt_hi) return;
    KV cur; load_kv(cur, kl + (size_t)(kt * 32) * kpitch, vl + kt * 32, vts);
    for (;;) {
        int kn = kt + 1; unsigned vmn = 0u;
        if (SKIP) { for (; kn <= kt_hi; ++kn) { vmn = mask(kn); if (__any(vmn != 0u)) break; } } else { if (kn <= kt_hi) vmn = mask(kn); }
        const bool more = kn <= kt_hi;
        KV nxt = cur; if (more) load_kv(nxt, kl + (size_t)(kn * 32) * kpitch, vl + kn * 32, vts);
        f32x16 z = qk_frag(cur.k, qf);
        softmax_step(z, vm, m, l, o0, o1);
        pv_frag(o0, o1, cur.v, z);
        if (!more) break;
        cur = nxt; vm = vmn; kt = kn;
    }
}
DI void load_q(bf16x8 (&qf)[4], const bf16_t* qp) {
#pragma unroll
    for (int s = 0; s < 4; ++s) qf[s] = ldg16(qp + 16 * s);
}

constexpr size_t MiB = 1u << 20;
constexpr size_t WS_CTL = 0, CTL_ZERO_BYTES = 2 * MiB;
constexpr size_t WS_ROPE = 2 * MiB, WS_WG = 3 * MiB, WS_TAU = 5 * MiB, WS_RR = WS_TAU + 128 * 1024, WS_BM = WS_TAU + 256 * 1024, WS_BIAS1 = WS_TAU + 512 * 1024;
constexpr size_t WS_KC = 6 * MiB, WS_VCT = WS_KC + 256 * 1024, WS_HID = WS_KC + 512 * 1024;
constexpr size_t WS_MEMB = 9 * MiB, WS_KMEM = 13 * MiB, WS_VMEMT = 15 * MiB;
constexpr size_t WS_KCMP = 17 * MiB, WS_VCMP = 21 * MiB;
constexpr size_t WS_VAT = 26 * MiB, WS_VBT = 42 * MiB, WS_VST = 46 * MiB, WS_VWT = 50 * MiB;
constexpr size_t WS_WIN = 54 * MiB, WS_WFI = 75 * MiB, WS_WFO = 97 * MiB, WS_WOUT = 108 * MiB, WS_WUP = 112 * MiB, WS_WMQ = 115 * MiB, WS_WMKV = 116 * MiB, WS_WMO = 118 * MiB,
                 WS_WC1 = 119 * MiB, WS_WC2 = 121 * MiB;
constexpr size_t WS_HB = 122 * MiB;
constexpr size_t WS_PA = 186 * MiB;
constexpr size_t WS_PG = 286 * MiB;
constexpr size_t WS_END = 478 * MiB;
static_assert(WS_VCMP == WS_KCMP + (size_t)MT * 64 * 2, "compact cmp buffers must be adjacent");
static_assert(WS_PA + (size_t)MT * PAP * 2 <= WS_PG && WS_PG + (size_t)MT * 3072 * 2 <= WS_END && WS_HB + 64 * MiB <= WS_PA, "ws map");
static_assert(WS_WIN + (size_t)2 * DINP * 1024 * 2 <= WS_WFI && WS_WFI + (size_t)2 * 5632 * 1024 * 2 <= WS_WFO && WS_WFO + (size_t)2 * 1024 * DFF * 2 <= WS_WOUT, "weights map");
constexpr int CW_TMO = 0, CW_BAR = 4096, CW_Q = 8192, CW_SS = 32768, CW_SSM = CW_SS + 7 * MT, CW_Q2 = CW_SSM + 2048;
static_assert((size_t)(CW_Q2 + 32 * 4 * 8 * 64) * 4 <= CTL_ZERO_BYTES, "ctl region");
struct Bufs {
    const float* in[21]; float* o_; unsigned char* ws;
#define BIN(name, idx) DI const float* name() const { return in[idx]; }
    BIN(x, 0) BIN(mem, 1) BIN(norm_mix, 2) BIN(w_in, 3) BIN(cmp_pos_k, 4) BIN(cmp_w1_k, 5) BIN(cmp_w2_k, 6) BIN(cmp_pos_v, 7) BIN(cmp_w1_v, 8) BIN(cmp_w2_v, 9) BIN(w_up, 10) BIN(w_out, 11)
    BIN(norm_mem_q, 12) BIN(norm_mem_kv, 13) BIN(w_mem_q, 14) BIN(w_mem_kv, 15) BIN(w_mem_o, 16) BIN(norm_ffn, 17) BIN(w_ffn_in, 18) BIN(w_ffn_out, 19) BIN(norm_final, 20)
#undef BIN
#define BWS(type, name, off) DI type* name() const { return (type*)(ws + (off)); }
    DI float* out() const { return o_; }
    DI gu32* ctl() const { return (gu32*)(ws + WS_CTL); }
    BWS(float, ss, WS_CTL + (size_t)CW_SS * 4) BWS(float, ssm, WS_CTL + (size_t)CW_SSM * 4)
    BWS(f32x2, rope, WS_ROPE) BWS(float, WG, WS_WG) BWS(unsigned, TAU, WS_TAU) BWS(unsigned, RR, WS_RR) BWS(unsigned long long, BM, WS_BM) BWS(float, BIAS1, WS_BIAS1)
    BWS(bf16_t, KC, WS_KC) BWS(bf16_t, VCT, WS_VCT) BWS(bf16_t, HID, WS_HID) BWS(bf16_t, MEMB, WS_MEMB) BWS(bf16_t, KMEM, WS_KMEM) BWS(bf16_t, VMEMT, WS_VMEMT)
    BWS(bf16_t, KCMP, WS_KCMP) BWS(bf16_t, VCMP, WS_VCMP) BWS(bf16_t, VAT, WS_VAT) BWS(bf16_t, VBT, WS_VBT) BWS(bf16_t, VST, WS_VST) BWS(bf16_t, VWT, WS_VWT)
    BWS(bf16_t, WIN, WS_WIN) BWS(bf16_t, WFI, WS_WFI) BWS(bf16_t, WFO, WS_WFO) BWS(bf16_t, WOUT, WS_WOUT) BWS(bf16_t, WUP, WS_WUP) BWS(bf16_t, WMQ, WS_WMQ)
    BWS(bf16_t, WMKV, WS_WMKV) BWS(bf16_t, WMO, WS_WMO) BWS(bf16_t, WC1, WS_WC1) BWS(bf16_t, WC2, WS_WC2)
    BWS(bf16_t, HB, WS_HB) BWS(bf16_t, O3, WS_HB) BWS(unsigned short, MB, WS_HB + 48 * MiB)
    BWS(bf16_t, PA, WS_PA) BWS(bf16_t, MG, WS_PA) BWS(bf16_t, QM, WS_PA + 64 * MiB) BWS(bf16_t, OM, WS_PA + 80 * MiB)
    BWS(bf16_t, PG, WS_PG) BWS(bf16_t, ACT, WS_PG)
#undef BWS
};

DI void sb_unit(const Bufs& P, int b, int h, int qb, int lane) {
    const int r = lane & 31, hh = lane >> 5, q0 = qb * 32, tq = q0 + r;
    const size_t row = (size_t)b * SQ + tq;
    bf16x8 qf[4]; load_q(qf, P.PA() + row * PAP + C_QA + h * 64 + 8 * hh);
    f32x16 o0 = zero16(), o1 = zero16();
    float R = 0.f;
    const bf16_t* kb = P.PA() + ((size_t)b * SQ + r) * PAP + C_KA + h * 64 + 8 * hh;
    const bf16_t* vb = P.VAT() + ((size_t)(b * 4 + h) * 64 + r) * SQ + 4 * hh;
    KV cur; load_kv(cur, kb + (size_t)(qb * 32) * PAP, vb + qb * 32, SQ);
    for (int kt = qb; kt >= 0; --kt) {
        const int k0 = kt * 32;
        KV nxt = cur; if (kt > 0) load_kv(nxt, kb + (size_t)(k0 - 32) * PAP, vb + k0 - 32, SQ);
        f32x16 z = qk_frag(cur.k, qf);
        float Lg[16];
#pragma unroll
        for (int i = 0; i < 16; ++i) {
            const bool valid = (k0 + crow(i, hh)) < tq;
            const float zz = z[i], sp = fmaxf(zz, 0.f) + 0.6931471805599453f * flog2(1.f + fexp2(-fabsf(zz) * LOG2E));
            Lg[i] = valid ? -sp : 0.f;
        }
        float T[4];
#pragma unroll
        for (int g = 0; g < 4; ++g) { Lg[4 * g + 2] += Lg[4 * g + 3]; Lg[4 * g + 1] += Lg[4 * g + 2]; Lg[4 * g] += Lg[4 * g + 1]; T[g] = Lg[4 * g]; }
        float PT[4];
#pragma unroll
        for (int g = 0; g < 4; ++g) PT[g] = shx32(T[g]);
        float above = R;
#pragma unroll
        for (int g = 3; g >= 0; --g) {
            const float ab = above + (hh == 0 ? PT[g] : 0.f);
#pragma unroll
            for (int e = 0; e < 4; ++e) {
                const int i = 4 * g + e; const bool valid = (k0 + crow(i, hh)) < tq;
                z[i] = valid ? fexp2((z[i] + Lg[i] + ab) * LOG2E) : 0.f;
            }
            above += T[g] + PT[g];
        }
        R = above;
        pv_frag(o0, o1, cur.v, z);
        if (__all(R < -60.f)) break;
        cur = nxt;
    }
    store_ot(P.O3() + row * 768 + h * 64, o0, o1, 1.f, hh);
}

DI unsigned mono_key(float s) { const unsigned u = __builtin_bit_cast(unsigned, s + 0.0f); return u ^ ((unsigned)((int)u >> 31) | 0x80000000u); }
DI float mono_inv(unsigned k) { const unsigned u = (k & 0x80000000u) ? (k ^ 0x80000000u) : ~k; return __builtin_bit_cast(float, u); }
DI float mono_inv_hi(unsigned k) { if (k == 0x7fffffffu) return __builtin_bit_cast(float, 0x80000001u); const float f = mono_inv(k); return (f != f) ? ((k & 0x80000000u) ? __builtin_inff() : -__builtin_inff()) : f; }
DI float relu_f(float x) { return __builtin_amdgcn_fmed3f(x, 0.f, __builtin_inff()); }
DI void idx_tile(float (&sc)[16], const bf16x8 (&kf)[4], const bf16x8 (&qi)[4][4], const float (&w)[4]) {
#pragma unroll
    for (int hd = 0; hd < 4; ++hd) {
        f32x16 z = zero16();
#pragma unroll
        for (int s = 0; s < 4; ++s) z = MFMA32(kf[s], qi[hd][s], z);
#pragma unroll
        for (int i = 0; i < 16; ++i) { const float rl = relu_f(z[i]); sc[i] = (hd == 0) ? w[0] * rl : __builtin_fmaf(w[hd], rl, sc[i]); }
    }
}

constexpr int KT_SLICE = 32 * 144;
DI void ktile_issue(u32x4 (&rg)[4], const bf16_t* kcol  , int k0, int lane) {
    const bf16_t* p = kcol + (size_t)(k0 + (lane >> 3)) * PAP + (lane & 7) * 8;
#pragma unroll
    for (int i = 0; i < 4; ++i) rg[i] = *(const GAS u32x4*)(p + (size_t)(8 * i) * PAP);
}
DI void ktile_commit(LAS unsigned char* slice, const u32x4 (&rg)[4], int lane) {
    LAS unsigned char* p = slice + (lane >> 3) * 144 + (lane & 7) * 16;
#pragma unroll
    for (int i = 0; i < 4; ++i) *(LAS u32x4*)(p + i * 8 * 144) = rg[i];
}
DI void ktile_frags(bf16x8 (&kf)[4], const LAS unsigned char* slice, int lane) {
    const LAS unsigned char* p = slice + (lane & 31) * 144 + (lane >> 5) * 16;
#pragma unroll
    for (int s2 = 0; s2 < 4; ++s2) kf[s2] = *(const LAS bf16x8*)(p + s2 * 32);
}
constexpr int HROW = 132;
constexpr int HWAVE = 32 * HROW * 4;
constexpr int DS_CAP = 64;
constexpr int DS_OFF_KSL = 4 * HWAVE, DS_OFF_FLAG = DS_OFF_KSL + 8 * KT_SLICE, DS_OFF_CNT = DS_OFF_FLAG + 512, DS_OFF_CAND = DS_OFF_CNT + 128, DS_LDS_END = DS_OFF_CAND + 32 * DS_CAP * 8;
template <int EXPT = 0, class F> DI void ds_tile_pass(const bf16_t* kcol, LAS unsigned char* kslice, int qb, int wave, int lane, const bf16x8 (&qi)[4][4], const float (&w)[4], const F& f) {
    if (wave > qb) return;
    u32x4 rg[4]; ktile_issue(rg, kcol, wave * 32, lane); ktile_commit(kslice, rg, lane);
    for (int kt = wave; kt <= qb; kt += 8) {
        const int k0 = kt * 32;
        bf16x8 kf[4]; ktile_frags(kf, kslice, lane);
        if (EXPT != 13 && kt + 8 <= qb) ktile_issue(rg, kcol, k0 + 256, lane);
        float sc[16]; if (EXPT == 12) { _Pragma("unroll") for (int i = 0; i < 16; ++i) sc[i] = __builtin_bit_cast(float, (int)kf[i & 3][i >> 2] << 16); } else idx_tile(sc, kf, qi, w);
        f(kt, k0, sc);
        if (EXPT != 13 && kt + 8 <= qb) ktile_commit(kslice, rg, lane);
    }
}
template <int EXP = 0, int CHK = 0> DI void dsa_select_wg(const Bufs& P, int b, int qb, int lane, int wave, LAS unsigned* hist4) {
    const int r = lane & 31, hh = lane >> 5, q0 = qb * 32, tq = q0 + r;
    const size_t row = (size_t)b * SQ + tq;
    const bool takeall = (tq + 1) <= 256;
    bf16x8 qi[4][4];
#pragma unroll
    for (int hd = 0; hd < 4; ++hd) load_q(qi[hd], P.PA() + row * PAP + C_QI + hd * 64 + 8 * hh);
    float w[4]; { const f32x4 wv = *(const GAS f32x4*)(P.WG() + row * 16); w[0] = wv.x; w[1] = wv.y; w[2] = wv.z; w[3] = wv.w; }
    LAS unsigned char* const base = (LAS unsigned char*)hist4;
    { LAS unsigned* z = hist4 + wave * 2112 + lane;
#pragma unroll
      for (int j = 0; j < 33; ++j) z[64 * j] = 0u; }
    LAS unsigned* const tieflag = (LAS unsigned*)(base + DS_OFF_FLAG);
    LAS unsigned* const chk = tieflag + 4;
    LAS unsigned* const ccnt_l = (LAS unsigned*)(base + DS_OFF_CNT);
    LAS unsigned* const cand = (LAS unsigned*)(base + DS_OFF_CAND);
    if (wave == 0) { if (lane == 0) *tieflag = 0u; if (lane < 32) { ccnt_l[lane] = 0u; if (CHK) { chk[3 * lane] = 0xffffffffu; chk[3 * lane + 1] = 0u; chk[3 * lane + 2] = 0u; } } }
    __syncthreads();
    unsigned prefix = 0u, krem = (CHK == 2) ? 255u : 256u, bc = 0u; int npass = 0; bool early = false;
    const bf16_t* kcol = P.PA() + (size_t)b * SQ * PAP + C_KI;
    LAS unsigned char* kslice = base + DS_OFF_KSL + wave * KT_SLICE;
    LAS unsigned* const mk = hist4;
    unsigned short* const mbp = (EXP >= 10 ? (unsigned short*)P.out() : P.MB()) + ((size_t)(b * 128 + qb) * 128) * 64 + lane;
    const unsigned sq = (unsigned)r >> 3;
    auto hist_pass = [&](int pass) -> bool {
        const int sh_d = 24 - 8 * pass, sh_p = (32 - 8 * pass) & 31;
        const unsigned klo = pass == 0 ? 0u : (prefix << sh_p), khi = pass == 0 ? 0xffffffffu : (klo | ((1u << sh_p) - 1u));
        float flo = mono_inv(klo); const float fhi = mono_inv_hi(khi);
        if (flo != flo) flo = -__builtin_inff();
        LAS unsigned* hrow = hist4 + pass * (32 * HROW) + r * HROW;
        auto hbody = [&](auto allv_c, int k0, const float (&sc)[16]) {
            constexpr bool ALLV = decltype(allv_c)::value;
            if (pass == 0) {
#pragma unroll
                for (int i = 0; i < 16; ++i) {
                    const unsigned d = mono_key(sc[i]) >> 24;
                    const unsigned val = (ALLV || (k0 + crow(i, hh)) <= tq) ? (1u << (16 * (d & 1u))) : 0u;
                    if (EXP == 14) { if (lane & 1) __hip_atomic_fetch_add(hrow + ((d >> 1) ^ sq), val, __ATOMIC_RELAXED, __HIP_MEMORY_SCOPE_WORKGROUP); }
                    else if (EXP == 15) { if (i & 1) __hip_atomic_fetch_add(hrow + ((d >> 1) ^ sq), val, __ATOMIC_RELAXED, __HIP_MEMORY_SCOPE_WORKGROUP); else asm volatile("" :: "v"(val), "v"(d)); }
                    else if (EXP != 1 && EXP != 11) __hip_atomic_fetch_add(hrow + ((d >> 1) ^ sq), val, __ATOMIC_RELAXED, __HIP_MEMORY_SCOPE_WORKGROUP); else asm volatile("" :: "v"(val), "v"(d));
                }
            } else {
#pragma unroll
                for (int i = 0; i < 16; ++i) {
                    const bool ok = (ALLV || (k0 + crow(i, hh)) <= tq) && sc[i] >= flo && sc[i] <= fhi;
                    if (ok) { const unsigned d = (mono_key(sc[i]) >> sh_d) & 255u;
                        __hip_atomic_fetch_add(hrow + ((d >> 1) ^ sq), 1u << (16 * (d & 1u)), __ATOMIC_RELAXED, __HIP_MEMORY_SCOPE_WORKGROUP); }
                }
            }
        };
        ds_tile_pass<EXP>(kcol, kslice, qb, wave, lane, qi, w, [&](int kt, int k0, const float (&sc)[16]) {
            if (kt < qb) hbody(std::true_type{}, k0, sc); else hbody(std::false_type{}, k0, sc);
        });
        __syncthreads();
        LAS unsigned* hhalf = hrow + 64 * hh;
        unsigned gs[16], tot = 0u;
#pragma unroll
        for (int j = 0; j < 16; ++j) { const u32x4 x = *(LAS u32x4*)(hhalf + 4 * j);
            gs[j] = ((x.x & 0xffffu) + (x.x >> 16)) + ((x.y & 0xffffu) + (x.y >> 16)) + ((x.z & 0xffffu) + (x.z >> 16)) + ((x.w & 0xffffu) + (x.w >> 16)); tot += gs[j]; }
        const unsigned oth = shx32u(tot), U = hh ? tot : oth;
        const bool mine = hh ? (krem <= U) : (krem > U);
        const unsigned target = hh ? krem : krem - U;
        unsigned cum = 0u; int fj = -1;
#pragma unroll
        for (int j = 15; j >= 0; --j) { const bool hit = (fj < 0) && (cum + gs[j] >= target); fj = hit ? j : fj; cum += (fj < 0) ? gs[j] : 0u; }
        u32x4 xg = *(LAS u32x4*)(hhalf + 4 * (fj < 0 ? 0 : fj));
        if (sq & 1u) xg = (u32x4){xg.y, xg.x, xg.w, xg.z};
        if (sq & 2u) xg = (u32x4){xg.z, xg.w, xg.x, xg.y};
        unsigned above = 0u, binc = 0u; int found = -1;
#pragma unroll
        for (int wi = 3; wi >= 0; --wi) { const unsigned x = xg[wi], hi = x >> 16, lo = x & 0xffffu;
            { const bool hit = (found < 0) && (cum + hi >= target); if (hit) { found = 2 * wi + 1; above = cum; binc = hi; } cum += (found < 0) ? hi : 0u; }
            { const bool hit = (found < 0) && (cum + lo >= target); if (hit) { found = 2 * wi; above = cum; binc = lo; } cum += (found < 0) ? lo : 0u; } }
        const bool okf = (fj >= 0) && (found >= 0);
        unsigned dm = (okf ? (unsigned)(8 * fj + found) : 0u) + 128u * hh, am = (okf ? above : 0u) + (hh ? 0u : U);
        const unsigned d_o = shx32u(dm), a_o = shx32u(am), b_o = shx32u(binc);
        const unsigned dig = mine ? dm : d_o, abv = mine ? am : a_o;
        bc = mine ? binc : b_o;
        krem -= abv; prefix = (prefix << 8) | dig; npass = pass + 1;
        return pass < 3 && __all(bc == krem || takeall);
    };
    early = hist_pass(0);
    if (!early && EXP != 3) early = hist_pass(1);
    const bool collect = !early && (EXP == 0 || EXP >= 10) && __all(bc <= (unsigned)DS_CAP || takeall);
    unsigned tau = 0u, rr = 0u;
    if (collect) {
        const unsigned klo = prefix << 16, khi = klo | 0xffffu;
        float flo = mono_inv(klo); const float fhi = mono_inv_hi(khi);
        if (flo != flo) flo = -__builtin_inff();
        __syncthreads();
        auto cbody = [&](auto allv_c, int kt, int k0, const float (&sc)[16]) {
            constexpr bool ALLV = decltype(allv_c)::value;
            unsigned gt = 0u;
#pragma unroll
            for (int i = 0; i < 16; ++i) {
                const bool valid = ALLV || (k0 + crow(i, hh)) <= tq;
                gt |= bitif(valid && (takeall || sc[i] > fhi), i);
                if (valid && !takeall && sc[i] >= flo && sc[i] <= fhi) {
                    const unsigned slot = __hip_atomic_fetch_add(ccnt_l + r, 1u, __ATOMIC_RELAXED, __HIP_MEMORY_SCOPE_WORKGROUP);
                    if (slot < (unsigned)DS_CAP) { cand[(r * DS_CAP + slot) * 2] = mono_key(sc[i]); cand[(r * DS_CAP + slot) * 2 + 1] = (unsigned)(kt * 1024 + lane * 16 + i); }
                }
            }
            mk[kt * 64 + lane] = gt;
        };
        ds_tile_pass<EXP>(kcol, kslice, qb, wave, lane, qi, w, [&](int kt, int k0, const float (&sc)[16]) {
            if (kt < qb) cbody(std::true_type{}, kt, k0, sc); else cbody(std::false_type{}, kt, k0, sc);
        });
        __syncthreads();
        {
            const int qq = wave * 4 + (lane >> 4), j16 = lane & 15;
            const unsigned need = (unsigned)__shfl((int)krem, qq & 31), tk = (unsigned)__shfl((int)(takeall ? 1u : 0u), qq & 31);
            const unsigned cnt = tk ? 0u : (ccnt_l[qq] < (unsigned)DS_CAP ? ccnt_l[qq] : (unsigned)DS_CAP);
            const LAS unsigned* cl = cand + qq * DS_CAP * 2;
            unsigned cmaxn = cnt;
#pragma unroll
            for (int o = 16; o < 64; o <<= 1) { const unsigned t2 = (unsigned)__shfl_xor((int)cmaxn, o); cmaxn = t2 > cmaxn ? t2 : cmaxn; }
            unsigned mykey[4], mypos[4], rank[4];
#pragma unroll
            for (int c = 0; c < 4; ++c) { const unsigned sidx = j16 + 16 * c; const bool have = sidx < cnt; mykey[c] = have ? cl[2 * sidx] : 0u; mypos[c] = have ? cl[2 * sidx + 1] : 0u; rank[c] = 0u; }
            for (unsigned j2 = 0; j2 < cmaxn; ++j2) {
                const bool in = j2 < cnt;
                const unsigned k2 = in ? cl[2 * j2] : 0u, p2 = in ? cl[2 * j2 + 1] : 0u;
                const unsigned i2 = (p2 >> 10) * 32u + (unsigned)crow((int)(p2 & 15u), (int)((p2 >> 9) & 1u));
#pragma unroll
                for (int c = 0; c < 4; ++c) { const unsigned ic = (mypos[c] >> 10) * 32u + (unsigned)crow((int)(mypos[c] & 15u), (int)((mypos[c] >> 9) & 1u));
                    rank[c] += (in && (k2 > mykey[c] || (k2 == mykey[c] && i2 < ic))) ? 1u : 0u; }
            }
#pragma unroll
            for (int c = 0; c < 4; ++c) { const unsigned sidx = j16 + 16 * c;
                if (sidx < cnt && rank[c] < need) __hip_atomic_fetch_or(mk + (mypos[c] >> 4), 1u << (mypos[c] & 15u), __ATOMIC_RELAXED, __HIP_MEMORY_SCOPE_WORKGROUP); }
        }
        __syncthreads();
        if (wave <= qb) for (int kt = wave; kt <= qb; kt += 8) mbp[(size_t)kt * 64] = (unsigned short)mk[kt * 64 + lane];
    } else {
        if (!early && EXP != 3) { early = hist_pass(2); if (!early) (void)hist_pass(3); }
        if (takeall) { tau = 0u; rr = 0xffffffffu; }
        else if (early) { tau = (prefix << (32 - 8 * npass)) - 1u; rr = 0u; }
        else { tau = prefix; rr = krem; }
        if (EXP != 0) { asm volatile("" :: "v"(tau), "v"(rr)); __syncthreads(); return; }
        const float tauf = mono_inv_hi(tau);
        __syncthreads();
        unsigned anyeq = 0u;
        ds_tile_pass<EXP>(kcol, kslice, qb, wave, lane, qi, w, [&](int kt, int k0, const float (&sc)[16]) {
            unsigned gt = 0u, eq = 0u;
#pragma unroll
            for (int i = 0; i < 16; ++i) { const bool valid = (k0 + crow(i, hh)) <= tq; gt |= bitif(valid && sc[i] > tauf, i); eq |= bitif(valid && sc[i] == tauf, i); }
            mbp[(size_t)kt * 64] = (unsigned short)gt;
            mk[kt * 64 + lane] = gt | (eq << 16);
            anyeq |= eq;
        });
        if (__any(anyeq != 0u && rr != 0u)) { if (lane == 0) __hip_atomic_fetch_or(tieflag, 1u, __ATOMIC_RELAXED, __HIP_MEMORY_SCOPE_WORKGROUP); }
        __syncthreads();
        if (*tieflag != 0u && wave == 0) {
            unsigned run = 0u;
            for (int kt = 0; kt <= qb; ++kt) {
                const unsigned wd = mk[kt * 64 + lane], gt = wd & 0xffffu, eq = wd >> 16;
                if (__any(eq != 0u)) {
                    unsigned cg[4], pk = 0u;
#pragma unroll
                    for (int g = 0; g < 4; ++g) { cg[g] = __builtin_popcount((eq >> (4 * g)) & 15u); pk |= cg[g] << (8 * g); }
                    const unsigned opk = shx32u(pk);
                    unsigned bs = run, bits = gt;
#pragma unroll
                    for (int g = 0; g < 4; ++g) {
                        const unsigned og = (opk >> (8 * g)) & 255u;
                        unsigned ord = bs + (hh ? og : 0u);
#pragma unroll
                        for (int e = 0; e < 4; ++e) { const int i = 4 * g + e; const unsigned ei = (eq >> i) & 1u; bits |= bitif(ei && ord < rr, i); ord += ei; }
                        bs += cg[g] + og;
                    }
                    run = bs;
                    mbp[(size_t)kt * 64] = (unsigned short)bits;
                    mk[kt * 64 + lane] = bits;
                } else mk[kt * 64 + lane] = gt;
            }
        }
    }
    __syncthreads();
    if (CHK) {
        unsigned cmin = 0xffffffffu, cmax = 0u, ccnt = 0u;
        asm volatile("s_waitcnt vmcnt(0)" ::: "memory");
        ds_tile_pass<EXP>(kcol, kslice, qb, wave, lane, qi, w, [&](int kt, int k0, const float (&sc)[16]) {
            const unsigned bits = (unsigned)__builtin_nontemporal_load(mbp + (size_t)kt * 64);
#pragma unroll
            for (int i = 0; i < 16; ++i) { const bool valid = (k0 + crow(i, hh)) <= tq; const unsigned uk = mono_key(sc[i]);
                if ((bits >> i) & 1u) cmin = uk < cmin ? uk : cmin; else if (valid) cmax = uk > cmax ? uk : cmax; }
            ccnt += __builtin_popcount(bits);
        });
        __hip_atomic_fetch_min(chk + 3 * r, cmin, __ATOMIC_RELAXED, __HIP_MEMORY_SCOPE_WORKGROUP); __hip_atomic_fetch_max(chk + 3 * r + 1, cmax, __ATOMIC_RELAXED, __HIP_MEMORY_SCOPE_WORKGROUP);
        __hip_atomic_fetch_add(chk + 3 * r + 2, ccnt, __ATOMIC_RELAXED, __HIP_MEMORY_SCOPE_WORKGROUP);
        __syncthreads();
        if (wave == 1 && hh == 0) { const unsigned want = (unsigned)((tq + 1) < 256 ? (tq + 1) : 256);
            const bool bad = (chk[3 * r + 2] != want) || (chk[3 * r] < chk[3 * r + 1]);
            if (bad) __hip_atomic_fetch_or((gu32*)P.ctl() + 2, 1u, RLX_AGENT); }
        __syncthreads();
    }
}
DI void dsa_mask_unit(const Bufs& P, int b, int qb, int lane, LAS unsigned char* kslice) {
    const int r = lane & 31, hh = lane >> 5, q0 = qb * 32, tq = q0 + r;
    const size_t row = (size_t)b * SQ + tq;
    bf16x8 qi[4][4];
#pragma unroll
    for (int hd = 0; hd < 4; ++hd) load_q(qi[hd], P.PA() + row * PAP + C_QI + hd * 64 + 8 * hh);
    float w[4]; { const f32x4 wv = *(const GAS f32x4*)(P.WG() + row * 16); w[0] = wv.x; w[1] = wv.y; w[2] = wv.z; w[3] = wv.w; }
    const unsigned tau = P.TAU()[row], rr = P.RR()[row];
    float tauf = mono_inv(tau); if (tauf != tauf) tauf = -__builtin_inff();
    unsigned run = 0u;
    const bf16_t* kcol = P.PA() + (size_t)b * SQ * PAP + C_KI;
    unsigned short* mb = P.MB() + ((size_t)(b * 128 + qb) * 128) * 64 + lane;
    u32x4 rg[4]; ktile_issue(rg, kcol, 0, lane); ktile_commit(kslice, rg, lane);
    for (int kt = 0; kt <= qb; ++kt) {
        const int k0 = kt * 32;
        bf16x8 kf[4]; ktile_frags(kf, kslice, lane);
        if (kt < qb) ktile_issue(rg, kcol, k0 + 32, lane);
        float sc[16]; idx_tile(sc, kf, qi, w);
        if (kt < qb) ktile_commit(kslice, rg, lane);
        unsigned gt = 0u, eq = 0u;
#pragma unroll
        for (int i = 0; i < 16; ++i) {
            const bool valid = (k0 + crow(i, hh)) <= tq;
            gt |= bitif(valid && sc[i] > tauf, i); eq |= bitif(valid && sc[i] == tauf, i);
        }
        unsigned bits = gt;
        if (__any(eq != 0u)) {
        unsigned cg[4], pk = 0u;
#pragma unroll
        for (int g = 0; g < 4; ++g) { cg[g] = __builtin_popcount((eq >> (4 * g)) & 15u); pk |= cg[g] << (8 * g); }
        const unsigned opk = shx32u(pk);
        unsigned base = run;
#pragma unroll
        for (int g = 0; g < 4; ++g) {
            const unsigned og = (opk >> (8 * g)) & 255u;
            unsigned ord = base + (hh ? og : 0u);
#pragma unroll
            for (int e = 0; e < 4; ++e) { const int i = 4 * g + e; const unsigned ei = (eq >> i) & 1u; bits |= bitif(ei && ord < rr, i); ord += ei; }
            base += cg[g] + og;
        }
        run = base;
        }
        mb[(size_t)kt * 64] = (unsigned short)bits;
    }
}
DI void dsa_attn_unit(const Bufs& P, int b, int h, int qb, int lane) {
    const int r = lane & 31, hh = lane >> 5, q0 = qb * 32;
    const size_t row = (size_t)b * SQ + q0 + r;
    bf16x8 qf[4]; load_q(qf, P.PA() + row * PAP + C_QB + h * 64 + 8 * hh);
    f32x16 o0 = zero16(), o1 = zero16(); float m = -1e30f, l = 0.f;
    const unsigned short* mb = P.MB() + ((size_t)(b * 128 + qb) * 128) * 64 + lane;
    auto mask = [&](int kt) -> unsigned { return (unsigned)mb[(size_t)kt * 64]; };
    attn_tiles<false>(o0, o1, m, l, qf, P.PA() + (size_t)b * SQ * PAP + C_KB, PAP, P.VBT() + (size_t)b * 64 * SQ, SQ, 0, qb, mask, r, hh);
    const float lt = l + shx32(l), inv = lt > 0.f ? 1.f / lt : 0.f;
    store_ot(P.O3() + row * 768 + 256 + h * 64, o0, o1, inv, hh);
}


template <int MODE>
DI void dsa_attn_probe(const Bufs& P, int b, int h, int qb, int lane) {
    const int r = lane & 31, hh = lane >> 5, q0 = qb * 32;
    const size_t row = (size_t)b * SQ + q0 + r;
    bf16x8 qf[4]; load_q(qf, P.PA() + row * PAP + C_QB + h * 64 + 8 * hh);
    f32x16 o0 = zero16(), o1 = zero16(); float m = -1e30f, l = 0.f;
    const unsigned short* mb = P.MB() + ((size_t)(b * 128 + qb) * 128) * 64 + lane;
    const bf16_t* kl = P.PA() + (size_t)b * SQ * PAP + C_KB + (size_t)r * PAP + 8 * hh; const bf16_t* vl = P.VBT() + (size_t)b * 64 * SQ + (size_t)r * SQ + 4 * hh;
    if (MODE == 1) {
        bf16x8 acc = qf[0];
        for (int kt = 0; kt <= qb; ++kt) { KV t; load_kv(t, kl + (size_t)(kt * 32) * PAP, vl + kt * 32, SQ); const unsigned vm = mb[(size_t)kt * 64];
#pragma unroll
            for (int j = 0; j < 4; ++j) acc = acc ^ t.k[j] ^ t.v[j]; acc[0] ^= (short)vm; }
        o0[0] = (float)acc[0] + (float)acc[1] + (float)acc[2] + (float)acc[3] + (float)acc[4] + (float)acc[5] + (float)acc[6] + (float)acc[7];
    } else {
        auto mask = [&](int kt) -> unsigned { return (unsigned)mb[0]; };
        attn_tiles<false>(o0, o1, m, l, qf, P.PA() + (size_t)b * SQ * PAP + C_KB, 0, P.VBT() + (size_t)b * 64 * SQ, SQ, 0, qb, mask, r, hh);
    }
    const float lt = l + shx32(l), inv = lt > 0.f ? 1.f / lt : 0.f;
    store_ot((bf16_t*)P.out() + row * 768 + 256 + h * 64, o0, o1, inv, hh);
}
template <int CHK = 0> DI void nsa_cmp_unit(const Bufs& P, int b, int qb, int lane, LAS float* impl) {
    const int r = lane & 31, hh = lane >> 5, q0 = qb * 32, tq = q0 + r;
    const size_t row = (size_t)b * SQ + tq;
    const bf16_t* kcb = P.KC() + (size_t)b * 256 * 64 + 8 * hh;
    const bf16_t* vcb = P.VCT() + ((size_t)b * 64 + r) * 256 + 4 * hh;
    const int cmax = (tq >= 31) ? ((tq - 31) >> 4) : -1;
    const int ctile_hi = qb >> 4;
    LAS float* imp = impl + lane;
#pragma unroll
    for (int a = 0; a < 32; ++a) imp[64 * a] = 0.f;
    for (int h = 0; h < 4; ++h) {
        bf16x8 qf[4]; load_q(qf, P.PA() + row * PAP + C_QC + h * 64 + 8 * hh);
        float m = -1e30f, l = 0.f;
        for (int kt = 0; kt <= ctile_hi; ++kt) {
            const int k0 = kt * 32;
            const f32x16 z = qk_tile(kcb + (size_t)(k0 + r) * 64, qf);
            float tm = -1e30f;
#pragma unroll
            for (int i = 0; i < 16; ++i) tm = ((k0 + crow(i, hh)) <= cmax) ? fmaxf(tm, z[i]) : tm;
            tm = fmaxf(tm, shx32(tm));
            const float mn = fmaxf(m, tm); float ls = 0.f;
#pragma unroll
            for (int i = 0; i < 16; ++i) ls += ((k0 + crow(i, hh)) <= cmax) ? fexp2(z[i] - mn) : 0.f;
            l = l * fexp2(m - mn) + ls; m = mn;
        }
        const float lt = l + shx32(l), inv = lt > 0.f ? 1.f / lt : 0.f;
        f32x16 o0 = zero16(), o1 = zero16();
        float carry = 0.f;
        for (int kt = 0; kt <= ctile_hi; ++kt) {
            const int k0 = kt * 32;
            f32x16 z = qk_tile(kcb + (size_t)(k0 + r) * 64, qf);
#pragma unroll
            for (int i = 0; i < 16; ++i) z[i] = ((k0 + crow(i, hh)) <= cmax) ? fexp2(z[i] - m) * inv : 0.f;
            float px[4];
#pragma unroll
            for (int g = 0; g < 4; ++g) px[g] = shx32(z[4 * g + 3]);
#pragma unroll
            for (int g = 0; g < 4; ++g) {
                const float G = (z[4 * g] + z[4 * g + 1]) + (z[4 * g + 2] + z[4 * g + 3]);
                const float prev = hh ? px[g] : (g == 0 ? carry : px[g - 1]);
                imp[64 * (4 * kt + g)] += G + prev;
            }
            carry = px[3];
            pv_tile(o0, o1, vcb + k0, 256, z);
        }
        const float gate = P.WG()[row * 16 + 4 + h * 3 + 0];
        store_ot(P.O3() + row * 768 + 512 + h * 64, o0, o1, gate, hh);
    }
    const int cur = tq >> 6;
    unsigned own = 0u;
    unsigned cand = 0u;
#pragma unroll
    for (int a = 0; a < 32; ++a) { const int j = 2 * a + hh; const bool adm = j <= cur, forced = (j == 0) || (j == cur) || (j == cur - 1);
        own |= bitif(adm && (forced || cur < 16), a); cand |= bitif(adm && !forced, a); }
    if (__any(cur >= 16)) {
        float iv[32];
#pragma unroll
        for (int a = 0; a < 32; ++a) iv[a] = imp[64 * a];
        for (int it = 0; it < 13; ++it) {
            float bv = -1e30f; int ba = 64;
#pragma unroll
            for (int a = 0; a < 32; ++a) { const bool c = (cand >> a) & 1u; if (c && iv[a] > bv) { bv = iv[a]; ba = a; } }
            const float pv_ = shx32(bv); const int pa = __shfl_xor(ba, 32);
            const int jo = 2 * ba + hh, jp = 2 * pa + (1 - hh);
            const bool win = (ba < 64) && ((pa >= 64) || (bv > pv_) || (bv == pv_ && jo < jp));
            const unsigned wb = (win ? 1u : 0u) << (ba & 31);
            if (cur >= 16) own |= wb;
            cand &= ~wb;
        }
    }
    if (CHK) {
        float smin = 1e30f, umax = -1e30f; int sj = -1, uj = 999;
#pragma unroll
        for (int a = 0; a < 32; ++a) { const int j = 2 * a + hh; const bool adm = j <= cur, forced = (j == 0) || (j == cur) || (j == cur - 1); const float v = imp[64 * a];
            if (adm && !forced) { if ((own >> a) & 1u) { if (v < smin || (v == smin && j > sj)) { smin = v; sj = j; } } else { if (v > umax || (v == umax && j < uj)) { umax = v; uj = j; } } } }
        const float psmin = shx32(smin), pumax = shx32(umax); const int psj = __shfl_xor(sj, 32), puj = __shfl_xor(uj, 32);
        if (psmin < smin || (psmin == smin && psj > sj)) { smin = psmin; sj = psj; }
        if (pumax > umax || (pumax == umax && puj < uj)) { umax = pumax; uj = puj; }
        const unsigned both = __builtin_popcount(own) + __builtin_popcount(shx32u(own));
        const unsigned want = (unsigned)(cur + 1 < 16 ? cur + 1 : 16);
        bool bad = both != want;
        if (sj >= 0 && uj < 999 && (umax > smin || (umax == smin && uj < sj))) bad = true;
        { const int j0 = 0, j1 = cur, j2 = cur - 1; const unsigned oo = shx32u(own);
          auto has = [&](int j) -> bool { if (j < 0) return true; const unsigned msk = ((j & 1) == hh) ? own : oo; return (msk >> (j >> 1)) & 1u; };
          if (!has(j0) || !has(j1) || !has(j2)) bad = true; }
        if (bad) __hip_atomic_fetch_or((gu32*)P.ctl() + 2, 2u, RLX_AGENT);
    }
    const unsigned oth = shx32u(own);
    if (hh == 0) {
        unsigned long long bm = 0ull;
#pragma unroll
        for (int a = 0; a < 32; ++a) { bm |= (unsigned long long)((own >> a) & 1u) << (2 * a); bm |= (unsigned long long)((oth >> a) & 1u) << (2 * a + 1); }
        P.BM()[row] = bm;
    }
}
DI void nsa_selwin_unit(const Bufs& P, int b, int h, int qb, int lane, bf16_t* obase) {
    const int r = lane & 31, hh = lane >> 5, q0 = qb * 32, tq = q0 + r;
    const size_t row = (size_t)b * SQ + tq;
    bf16x8 qf[4]; load_q(qf, P.PA() + row * PAP + C_QC + h * 64 + 8 * hh);
    const unsigned long long bm = P.BM()[row];
    f32x16 a0 = zero16(), a1 = zero16();
    {
        f32x16 o0 = zero16(), o1 = zero16(); float m = -1e30f, l = 0.f;
        auto mask = [&](int kt) -> unsigned {
            if (!((bm >> (kt >> 1)) & 1ull)) return 0u;
            unsigned v = 0u;
#pragma unroll
            for (int i = 0; i < 16; ++i) v |= bitif((kt * 32 + crow(i, hh)) <= tq, i);
            return v; };
        attn_tiles<true>(o0, o1, m, l, qf, P.PA() + (size_t)b * SQ * PAP + C_KSEL, PAP, P.VST() + (size_t)b * 64 * SQ, SQ, 0, qb, mask, r, hh);
        const float lt = l + shx32(l), g = (lt > 0.f ? 1.f / lt : 0.f) * P.WG()[row * 16 + 4 + h * 3 + 1];
#pragma unroll
        for (int i = 0; i < 16; ++i) { a0[i] = o0[i] * g; a1[i] = o1[i] * g; }
    }
    {
        f32x16 o0 = zero16(), o1 = zero16(); float m = -1e30f, l = 0.f;
        auto mask = [&](int kt) -> unsigned {
            unsigned v = 0u;
#pragma unroll
            for (int i = 0; i < 16; ++i) { const int key = kt * 32 + crow(i, hh); v |= bitif(key <= tq && key > tq - 512, i); }
            return v; };
        const int lo = (q0 - 511) > 0 ? ((q0 - 511) >> 5) : 0;
        attn_tiles<false>(o0, o1, m, l, qf, P.PA() + (size_t)b * SQ * PAP + C_KWIN, PAP, P.VWT() + (size_t)b * 64 * SQ, SQ, lo, qb, mask, r, hh);
        const float lt = l + shx32(l), g = (lt > 0.f ? 1.f / lt : 0.f) * P.WG()[row * 16 + 4 + h * 3 + 2];
#pragma unroll
        for (int i = 0; i < 16; ++i) { a0[i] += o0[i] * g; a1[i] += o1[i] * g; }
    }
    bf16_t* orow = obase + row * 768 + 512 + h * 64;
#pragma unroll
    for (int g = 0; g < 4; ++g) {
        const u32x2 c0 = *(const GAS u32x2*)(orow + 8 * g + 4 * hh), c1 = *(const GAS u32x2*)(orow + 32 + 8 * g + 4 * hh);
        a0[4 * g] += bflo(c0.x); a0[4 * g + 1] += bfhi(c0.x); a0[4 * g + 2] += bflo(c0.y); a0[4 * g + 3] += bfhi(c0.y);
        a1[4 * g] += bflo(c1.x); a1[4 * g + 1] += bfhi(c1.x); a1[4 * g + 2] += bflo(c1.y); a1[4 * g + 3] += bfhi(c1.y);
    }
    store_ot(orow, a0, a1, 1.f, hh);
}

constexpr int AW_KP = 144, AW_VP = 136, AW_KB = 64 * AW_KP, AW_BUF = AW_KB + 64 * AW_VP;
template <int KIND  , int EXP = 0>
DI void attn_wg(f32x16& o0, f32x16& o1, float& m, float& l, const bf16x8 (&qf)[4], const bf16_t* kglob  , const bf16_t* vtglob  ,
                int st_lo, int st_hi, int tq, int kt32_base_unused, const unsigned short* mb  , unsigned long long bm, int lane, int tid, LAS unsigned char* lds) {
    (void)kt32_base_unused;
    const int r = lane & 31, hh = lane >> 5;
    const int srow = tid >> 3, sch = tid & 7;
    const bf16_t* kg = kglob + (size_t)srow * PAP + sch * 8; const bf16_t* vg = vtglob + (size_t)srow * SQ + sch * 8;
    LAS unsigned char* const kw = lds + srow * AW_KP + sch * 16; LAS unsigned char* const vw = lds + AW_KB + srow * AW_VP + sch * 16;
    const int kro = r * AW_KP + hh * 16, vro = AW_KB + r * AW_VP + hh * 8;
    if (st_lo > st_hi) return;
    u32x4 kr = *(const GAS u32x4*)(kg + (size_t)(st_lo * 64) * PAP), vr = *(const GAS u32x4*)(vg + st_lo * 64);
    unsigned mw0 = 0u, mw1 = 0u;
    if (KIND == 0) { mw0 = mb[(size_t)(2 * st_lo) * 64]; mw1 = mb[(size_t)(2 * st_lo + 1) * 64]; }
    *(LAS u32x4*)kw = kr; *(LAS u32x2*)vw = (u32x2){vr.x, vr.y}; *(LAS u32x2*)(vw + 8) = (u32x2){vr.z, vr.w};
    __syncthreads();
    for (int st = st_lo; st <= st_hi; ++st) {
        LAS unsigned char* const buf = lds + ((st - st_lo) & 1) * AW_BUF;
        const bool more = st < st_hi;
        unsigned nw0 = 0u, nw1 = 0u;
        if (more) { if (EXP != 3) { kr = *(const GAS u32x4*)(kg + (size_t)((st + 1) * 64) * PAP); vr = *(const GAS u32x4*)(vg + (st + 1) * 64); }
            if (KIND == 0) { nw0 = mb[(size_t)(2 * st + 2) * 64]; nw1 = mb[(size_t)(2 * st + 3) * 64]; } }
#pragma unroll
        for (int j = 0; j < 2; ++j) {
            const int k0 = st * 64 + j * 32, q0w = tq - r;
            unsigned vm = 0xffffu; int mode;
            bool lanesel = true;
            if (KIND == 0) { vm = (2 * st + j <= (tq >> 5)) ? (j ? mw1 : mw0) : 0u; mode = 0; }
            else if (KIND == 1) {
                lanesel = ((bm >> st) & 1ull) != 0ull;
                if (k0 + 31 <= q0w) { mode = 2; vm = lanesel ? 0xffffu : 0u; }
                else { mode = 0; vm = 0u; if (lanesel) {
#pragma unroll
                    for (int i = 0; i < 16; ++i) vm |= bitif((k0 + crow(i, hh)) <= tq, i); } }
            } else {
                if (k0 + 31 <= q0w && k0 > q0w + 31 - 512) mode = 1;
                else { mode = 0; vm = 0u;
#pragma unroll
                    for (int i = 0; i < 16; ++i) { const int key = k0 + crow(i, hh); vm |= bitif(key <= tq && key > tq - 512, i); } }
            }
            if (!__any(vm != 0u)) continue;
            bf16x8 kf[4];
#pragma unroll
            for (int s2 = 0; s2 < 4; ++s2) kf[s2] = *(const LAS bf16x8*)(buf + kro + j * 32 * AW_KP + s2 * 32);
            const float nme = -sm_meff(m), ninf = -__builtin_inff();
            f32x16 init;
            if (mode == 1) {
#pragma unroll
                for (int i = 0; i < 16; ++i) init[i] = nme;
            } else if (mode == 2) {
                const float v = lanesel ? nme : ninf;
#pragma unroll
                for (int i = 0; i < 16; ++i) init[i] = v;
            } else {
                const unsigned nb = __builtin_bit_cast(unsigned, nme), ib = __builtin_bit_cast(unsigned, ninf); unsigned xb = nb ^ ib; asm volatile("" : "+v"(xb));
#pragma unroll
                for (int i = 0; i < 16; ++i) { const unsigned t = (unsigned)__builtin_amdgcn_sbfe((int)vm, i, 1); init[i] = __builtin_bit_cast(float, (t & xb) ^ ib); }
            }
            f32x16 z; if (EXP == 2) { _Pragma("unroll") for (int i = 0; i < 16; ++i) z[i] = __builtin_bit_cast(float, (int)kf[i & 3][i >> 2] << 16) + init[i]; } else z = qk_frag_init(kf, qf, init);
            if (EXP == 1) { asm volatile("" :: "v"(vm)); } else softmax_core(z, m, l, o0, o1);
            bf16x8 vf[4];
#pragma unroll
            for (int s2 = 0; s2 < 2; ++s2) {
#pragma unroll
                for (int db = 0; db < 2; ++db) {
                    const LAS unsigned char* vp = buf + vro + db * 32 * AW_VP + (j * 32 + 16 * s2) * 2;
                    const s16x4 lo = *(const LAS s16x4*)vp, hi = *(const LAS s16x4*)(vp + 16);
                    vf[2 * s2 + db] = __builtin_shufflevector(lo, hi, 0, 1, 2, 3, 4, 5, 6, 7);
                }
            }
            if (EXP == 2) { _Pragma("unroll") for (int i = 0; i < 16; ++i) { o0[i] += z[i] + __builtin_bit_cast(float, (int)vf[i & 3][i >> 2] << 16); } } else pv_frag(o0, o1, vf, z);
        }
        if (more) {
            const int off = ((st - st_lo + 1) & 1) * AW_BUF;
            *(LAS u32x4*)(kw + off) = kr; *(LAS u32x2*)(vw + off) = (u32x2){vr.x, vr.y}; *(LAS u32x2*)(vw + off + 8) = (u32x2){vr.z, vr.w};
            mw0 = nw0; mw1 = nw1;
        }
        __syncthreads();
    }
}
template <int EXP = 0> DI void dsa_attn_wg(const Bufs& P, int b, int qb64, int lane, int wave, int tid, LAS unsigned char* lds) {
    const int r = lane & 31, hh = lane >> 5, sub = wave >> 2, h = wave & 3, qb = 2 * qb64 + sub, tq = qb * 32 + r;
    const size_t row = (size_t)b * SQ + tq;
    bf16x8 qf[4]; load_q(qf, P.PA() + row * PAP + C_QB + h * 64 + 8 * hh);
    f32x16 o0 = zero16(), o1 = zero16(); float m = -1e30f, l = 0.f;
    const unsigned short* mb = P.MB() + ((size_t)(b * 128 + qb) * 128) * 64 + lane;
    attn_wg<0, EXP>(o0, o1, m, l, qf, P.PA() + (size_t)b * SQ * PAP + C_KB, P.VBT() + (size_t)b * 64 * SQ, 0, qb64, tq, 0, mb, 0ull, lane, tid, lds);
    const float lt = l + shx32(l), inv = lt > 0.f ? 1.f / lt : 0.f;
    store_ot((EXP ? (bf16_t*)P.out() : P.O3()) + row * 768 + 256 + h * 64, o0, o1, inv, hh);
}
DI void nsa_selwin_wg(const Bufs& P, int b, int qb64, int lane, int wave, int tid, LAS unsigned char* lds, bf16_t* obase) {
    const int r = lane & 31, hh = lane >> 5, sub = wave >> 2, h = wave & 3, qb = 2 * qb64 + sub, tq = qb * 32 + r;
    const size_t row = (size_t)b * SQ + tq;
    bf16x8 qf[4]; load_q(qf, P.PA() + row * PAP + C_QC + h * 64 + 8 * hh);
    const unsigned long long bm = P.BM()[row];
    f32x16 a0 = zero16(), a1 = zero16();
    {
        f32x16 o0 = zero16(), o1 = zero16(); float m = -1e30f, l = 0.f;
        attn_wg<1>(o0, o1, m, l, qf, P.PA() + (size_t)b * SQ * PAP + C_KSEL, P.VST() + (size_t)b * 64 * SQ, 0, qb64, tq, 0, nullptr, bm, lane, tid, lds);
        const float lt = l + shx32(l), g = (lt > 0.f ? 1.f / lt : 0.f) * P.WG()[row * 16 + 4 + h * 3 + 1];
#pragma unroll
        for (int i = 0; i < 16; ++i) { a0[i] = o0[i] * g; a1[i] = o1[i] * g; }
    }
    {
        f32x16 o0 = zero16(), o1 = zero16(); float m = -1e30f, l = 0.f;
        const int lo = (qb64 * 64 - 511) > 0 ? ((qb64 * 64 - 511) >> 6) : 0;
        attn_wg<2>(o0, o1, m, l, qf, P.PA() + (size_t)b * SQ * PAP + C_KWIN, P.VWT() + (size_t)b * 64 * SQ, lo, qb64, tq, 0, nullptr, 0ull, lane, tid, lds);
        const float lt = l + shx32(l), g = (lt > 0.f ? 1.f / lt : 0.f) * P.WG()[row * 16 + 4 + h * 3 + 2];
#pragma unroll
        for (int i = 0; i < 16; ++i) { a0[i] += o0[i] * g; a1[i] += o1[i] * g; }
    }
    bf16_t* orow = obase + row * 768 + 512 + h * 64;
#pragma unroll
    for (int g = 0; g < 4; ++g) {
        const u32x2 c0 = *(const GAS u32x2*)(orow + 8 * g + 4 * hh), c1 = *(const GAS u32x2*)(orow + 32 + 8 * g + 4 * hh);
        a0[4 * g] += bflo(c0.x); a0[4 * g + 1] += bfhi(c0.x); a0[4 * g + 2] += bflo(c0.y); a0[4 * g + 3] += bfhi(c0.y);
        a1[4 * g] += bflo(c1.x); a1[4 * g + 1] += bfhi(c1.x); a1[4 * g + 2] += bflo(c1.y); a1[4 * g + 3] += bfhi(c1.y);
    }
    store_ot(orow, a0, a1, 1.f, hh);
}
constexpr int MW_KP = 144, MW_VP = 520, MW_VOFF = 256 * MW_KP;
DI void mem_attn_wg(const Bufs& P, int l_, int b, int h, int qc, int lane, int wave, int tid, LAS unsigned char* lds) {
    const int r = lane & 31, hh = lane >> 5;
    const size_t row = (size_t)b * SQ + qc * 256 + wave * 32 + r;
    bf16x8 qf[4]; load_q(qf, P.QM() + row * 256 + h * 64 + 8 * hh);
    const bf16_t* kg = P.KMEM() + ((size_t)l_ * 2048 + (size_t)b * 256) * 256 + h * 64;
    const bf16_t* vg = P.VMEMT() + ((size_t)l_ * 32 + b * 4 + h) * 64 * 256;
#pragma unroll
    for (int i = 0; i < 4; ++i) { const int c = tid + 512 * i;
        { const int kr = c >> 3, ch = c & 7; *(LAS u32x4*)(lds + kr * MW_KP + ch * 16) = *(const GAS u32x4*)(kg + (size_t)kr * 256 + ch * 8); }
        { const int d = c >> 5, ch = c & 31; const u32x4 v = *(const GAS u32x4*)(vg + (size_t)d * 256 + ch * 8); LAS unsigned char* p = lds + MW_VOFF + d * MW_VP + ch * 16;
          *(LAS u32x2*)p = (u32x2){v.x, v.y}; *(LAS u32x2*)(p + 8) = (u32x2){v.z, v.w}; } }
    __syncthreads();
    f32x16 o0 = zero16(), o1 = zero16(); float m = -1e30f, l = 0.f;
    const LAS unsigned char* kl = lds + r * MW_KP + hh * 16; const LAS unsigned char* vl = lds + MW_VOFF + r * MW_VP + hh * 8;
    for (int kt = 0; kt < 8; ++kt) {
        bf16x8 kf[4];
#pragma unroll
        for (int s2 = 0; s2 < 4; ++s2) kf[s2] = *(const LAS bf16x8*)(kl + kt * 32 * MW_KP + s2 * 32);
        f32x16 z = qk_frag(kf, qf);
        softmax_step<false>(z, 0xffffu, m, l, o0, o1);
        bf16x8 vf[4];
#pragma unroll
        for (int s2 = 0; s2 < 2; ++s2) {
#pragma unroll
            for (int db = 0; db < 2; ++db) { const LAS unsigned char* vp = vl + db * 32 * MW_VP + (kt * 32 + 16 * s2) * 2;
                const s16x4 lo = *(const LAS s16x4*)vp, hi = *(const LAS s16x4*)(vp + 16); vf[2 * s2 + db] = __builtin_shufflevector(lo, hi, 0, 1, 2, 3, 4, 5, 6, 7); } }
        pv_frag(o0, o1, vf, z);
    }
    const float lt = l + shx32(l), inv = lt > 0.f ? 1.f / lt : 0.f;
    store_ot(P.OM() + row * 256 + h * 64, o0, o1, inv, hh);
    __syncthreads();
}
DI void mem_attn_unit(const Bufs& P, int l_, int b, int h, int qb, int lane) {
    const int r = lane & 31, hh = lane >> 5;
    const size_t row = (size_t)b * SQ + qb * 32 + r;
    bf16x8 qf[4]; load_q(qf, P.QM() + row * 256 + h * 64 + 8 * hh);
    f32x16 o0 = zero16(), o1 = zero16(); float m = -1e30f, l = 0.f;
    auto mask = [&](int) -> unsigned { return 0xffffu; };
    attn_tiles<false>(o0, o1, m, l, qf, P.KMEM() + ((size_t)l_ * 2048 + (size_t)b * 256) * 256 + h * 64, 256, P.VMEMT() + ((size_t)l_ * 32 + b * 4 + h) * 64 * 256, 256, 0, 7, mask, r, hh);
    const float lt = l + shx32(l), inv = lt > 0.f ? 1.f / lt : 0.f;
    store_ot(P.OM() + row * 256 + h * 64, o0, o1, inv, hh);
}
DI void st8(bf16_t* p, const f32x4& a, const f32x4& b) { u32x4 w; w.x = cvtpk(a[0], a[1]); w.y = cvtpk(a[2], a[3]); w.z = cvtpk(b[0], b[1]); w.w = cvtpk(b[2], b[3]); *(GAS u32x4*)p = w; }
DI void st8nt(bf16_t* p, const f32x4& a, const f32x4& b) { u32x4 w; w.x = cvtpk(a[0], a[1]); w.y = cvtpk(a[2], a[3]); w.z = cvtpk(b[0], b[1]); w.w = cvtpk(b[2], b[3]); __builtin_nontemporal_store(w, (GAS u32x4*)p); }
DI float sigm(float x) { return __builtin_amdgcn_rcpf(1.f + fexp2(-x * LOG2E)); }
DI float rs_of(float ssq) { return __builtin_amdgcn_rsqf(ssq * (1.f / 1024.f) + RMS_EPS); }

struct EpiIn {
    static constexpr bool PERM = true;
    const float* ss; Bufs P; LAS unsigned char* scr;
    DI void operator()(const f32x4 (&acc)[2][2][4][2], const pg8::Unit& u, int wr, int wc, int fr0, int fq0) const {
        int fr = fr0, fq = fq0; asm volatile("" : "+v"(fr), "+v"(fq));
        const int pn = u.pn, b = u.pm >> 4;
        float rsv[8];
#pragma unroll
        for (int i = 0; i < 8; ++i) rsv[i] = rs_of(ss[u.pm * 256 + (i >> 2) * 128 + wr * 64 + (i & 3) * 16 + fr]);
#pragma unroll
        for (int bj = 0; bj < 2; ++bj) {
            const int cl = bj * 128 + wc * 32 + fq * 8, g = cl >> 6, e = cl & 63;
            int mode = 5; float scale = 1.f; bf16_t* dst = nullptr; size_t pitch = 0;
            if (pn == 0) { mode = 0; scale = 0.125f; dst = P.PA() + C_QA + cl; pitch = PAP; }
            else if (pn == 1) { mode = 0; dst = P.PA() + C_KA + cl; pitch = PAP; }
            else if (pn == 2) { mode = 2; dst = P.VAT() + ((size_t)(b * 4 + g) * 64 + e) * SQ; }
            else if (pn == 3) { mode = 1; scale = C2; dst = P.PA() + C_QB + cl; pitch = PAP; }
            else if (pn == 4) { mode = 1; dst = P.PA() + C_QI + cl; pitch = PAP; }
            else if (pn == 5) { mode = 1; scale = C2; dst = P.PA() + C_QC + cl; pitch = PAP; }
            else if (pn == 6) { mode = 1;
                if (g == 0) { dst = P.PA() + C_KB + e; pitch = PAP; } else if (g == 1) { dst = P.PA() + C_KI + e; pitch = PAP; }
                else if (g == 2) { dst = P.KCMP() + e; pitch = 64; } else { dst = P.PA() + C_KSEL + e; pitch = PAP; } }
            else if (pn == 7) {
                if (g == 0) { mode = 1; dst = P.PA() + C_KWIN + e; pitch = PAP; } else if (g == 1) { mode = 0; dst = P.VCMP() + e; pitch = 64; }
                else if (g == 2) { mode = (e < 16) ? 4 : 5; } else mode = 5; }
            else if (pn == 8) { mode = 2; if (g == 0) dst = P.VBT() + ((size_t)b * 64 + e) * SQ; else if (g == 1) dst = P.VST() + ((size_t)b * 64 + e) * SQ; else if (g == 2) dst = P.VWT() + ((size_t)b * 64 + e) * SQ; else mode = 5; }
            else { mode = 3; dst = P.PG() + (size_t)(pn - 9) * 256 + cl; pitch = 3072; }
#pragma unroll
            for (int ai = 0; ai < 2; ++ai) {
                f32x4 c01s[4], c23s[4];
                if (mode == 1) {
#pragma unroll
                    for (int m = 0; m < 4; ++m) { const int t = (u.pm * 256 + ai * 128 + wr * 64 + m * 16 + fr) & (SQ - 1);
                        const f32x4* cs = (const f32x4*)(P.rope() + (size_t)t * 32 + (e >> 1)); c01s[m] = *(const GAS f32x4*)cs; c23s[m] = *(const GAS f32x4*)(cs + 1); }
                }
#pragma unroll
                for (int m = 0; m < 4; ++m) {
                    const int row = u.pm * 256 + ai * 128 + wr * 64 + m * 16 + fr;
                    const float rs = rsv[ai * 4 + m];
                    const int t = row & (SQ - 1);
                    const f32x4 v0 = acc[ai][bj][m][0] * rs, v1 = acc[ai][bj][m][1] * rs;
                    if (mode == 0) { st8(dst + (size_t)row * pitch, v0 * scale, v1 * scale); }
                    else if (mode == 1) {
                        const f32x4 c01 = c01s[m], c23 = c23s[m];
                        f32x4 r0, r1;
                        r0[0] = v0[0] * c01[0] - v0[1] * c01[1]; r0[1] = v0[1] * c01[0] + v0[0] * c01[1];
                        r0[2] = v0[2] * c01[2] - v0[3] * c01[3]; r0[3] = v0[3] * c01[2] + v0[2] * c01[3];
                        r1[0] = v1[0] * c23[0] - v1[1] * c23[1]; r1[1] = v1[1] * c23[0] + v1[0] * c23[1];
                        r1[2] = v1[2] * c23[2] - v1[3] * c23[3]; r1[3] = v1[3] * c23[2] + v1[2] * c23[3];
                        st8(dst + (size_t)row * pitch, r0 * scale, r1 * scale);
                    } else if (mode == 2) {
                        const unsigned w0 = cvtpk(v0[0], v0[1]), w1 = cvtpk(v0[2], v0[3]), w2 = cvtpk(v1[0], v1[1]), w3 = cvtpk(v1[2], v1[3]);
                        LAS unsigned short* sw = (LAS unsigned short*)(scr + (wr * 4 + wc) * 1024) + (fq * 8) * 16 + fr;
                        sw[0] = (unsigned short)w0; sw[16] = (unsigned short)(w0 >> 16); sw[32] = (unsigned short)w1; sw[48] = (unsigned short)(w1 >> 16);
                        sw[64] = (unsigned short)w2; sw[80] = (unsigned short)(w2 >> 16); sw[96] = (unsigned short)w3; sw[112] = (unsigned short)(w3 >> 16);
                        const int ln = fq * 16 + fr, dd = ln >> 1, hf = ln & 1;
                        const u32x4 tv = *(LAS u32x4*)(scr + (wr * 4 + wc) * 1024 + dd * 32 + hf * 16);
                        const int trow0 = (row - fr) & (SQ - 1);
                        *(GAS u32x4*)(dst + (ptrdiff_t)(dd - fq * 8) * SQ + trow0 + hf * 8) = tv;
                    } else if (mode == 3) {
                        f32x4 s0, s1;
#pragma unroll
                        for (int j = 0; j < 4; ++j) { s0[j] = sigm(v0[j]); s1[j] = sigm(v1[j]); }
                        st8nt(dst + (size_t)row * pitch, s0, s1);
                    } else if (mode == 4) {
                        f32x4 s0, s1;
                        if (e == 0) { s0 = v0 * 0.0625f; } else {
#pragma unroll
                            for (int j = 0; j < 4; ++j) s0[j] = sigm(v0[j]); }
#pragma unroll
                        for (int j = 0; j < 4; ++j) s1[j] = sigm(v1[j]);
                        GAS f32x4* wg = (GAS f32x4*)(P.WG() + (size_t)row * 16 + e);
                        wg[0] = s0; wg[1] = s1;
                    }
                }
                asm volatile("" ::: "memory");
            }
        }
    }
};
struct EpiMemKV {
    static constexpr bool PERM = true;
    Bufs P;
    DI void operator()(const f32x4 (&acc)[2][2][4][2], const pg8::Unit& u, int wr, int wc, int fr0, int fq0) const {
        int fr = fr0, fq = fq0; asm volatile("" : "+v"(fr), "+v"(fq));
        const int layer = u.pn >> 1, isv = u.pn & 1;
#pragma unroll
        for (int ai = 0; ai < 2; ++ai)
#pragma unroll
            for (int m = 0; m < 4; ++m) {
                const int row = u.pm * 256 + ai * 128 + wr * 64 + m * 16 + fr;
                const float rs = rs_of(P.ssm()[row]); const int b = row >> 8, mt = row & 255;
#pragma unroll
                for (int bj = 0; bj < 2; ++bj) {
                    const int cl = bj * 128 + wc * 32 + fq * 8, g = cl >> 6, e = cl & 63;
                    const f32x4 v0 = acc[ai][bj][m][0] * rs, v1 = acc[ai][bj][m][1] * rs;
                    if (!isv) st8(P.KMEM() + ((size_t)layer * 2048 + row) * 256 + cl, v0, v1);
                    else {
                        const unsigned w0 = cvtpk(v0[0], v0[1]), w1 = cvtpk(v0[2], v0[3]), w2 = cvtpk(v1[0], v1[1]), w3 = cvtpk(v1[2], v1[3]);
                        GAS bf16_t* d = (GAS bf16_t*)P.VMEMT() + (((size_t)layer * 32 + b * 4 + g) * 64 + e) * 256 + mt;
                        d[0] = (bf16_t)w0; d[256] = (bf16_t)(w0 >> 16); d[512] = (bf16_t)w1; d[768] = (bf16_t)(w1 >> 16);
                        d[1024] = (bf16_t)w2; d[1280] = (bf16_t)(w2 >> 16); d[1536] = (bf16_t)w3; d[1792] = (bf16_t)(w3 >> 16);
                    }
                    asm volatile("" ::: "memory");
                }
            }
    }
};
DI float gelu_tanh(float x) { const float u = 0.7978845608028654f * (x + 0.044715f * x * x * x); const float e = fexp2(-2.f * LOG2E * fabsf(u)); const float th = (1.f - e) * __builtin_amdgcn_rcpf(1.f + e);
    return 0.5f * x * (1.f + (u < 0.f ? -th : th)); }
struct EpiCmp1 {
    static constexpr bool PERM = true;
    bf16_t* HID; const float* bias;
    DI void operator()(const f32x4 (&acc)[2][2][4][2], const pg8::Unit& u, int wr, int wc, int fr0, int fq0) const {
        int fr = fr0, fq = fq0; asm volatile("" : "+v"(fr), "+v"(fq));
        const bool isv = u.pm >= 8;
#pragma unroll
        for (int bj = 0; bj < 2; ++bj) {
            const int cl = bj * 128 + wc * 32 + fq * 8;
            const bool keep = (bj == 1) == isv;
            const f32x4 b0 = *(const GAS f32x4*)(bias + cl), b1 = *(const GAS f32x4*)(bias + cl + 4);
#pragma unroll
            for (int ai = 0; ai < 2; ++ai)
#pragma unroll
                for (int m = 0; m < 4; ++m) {
                    const int row = u.pm * 256 + ai * 128 + wr * 64 + m * 16 + fr;
                    f32x4 h0, h1;
#pragma unroll
                    for (int j = 0; j < 4; ++j) { h0[j] = keep ? gelu_tanh(acc[ai][bj][m][0][j] + b0[j]) : 0.f; h1[j] = keep ? gelu_tanh(acc[ai][bj][m][1][j] + b1[j]) : 0.f; }
                    st8(HID + (size_t)row * 256 + (cl & 127) + (keep ? 0 : 128), h0, h1);
                }
        }
    }
};
struct EpiCmp2 {
    static constexpr bool PERM = true;
    bf16_t *KC, *VCT;
    DI void operator()(const f32x4 (&acc)[2][2][4][2], const pg8::Unit& u, int wr, int wc, int fr0, int fq0) const {
        int fr = fr0, fq = fq0; asm volatile("" : "+v"(fr), "+v"(fq));
        const bool isv = u.pm >= 8;
        if (wc >= 2) return;
#pragma unroll
        for (int ai = 0; ai < 2; ++ai)
#pragma unroll
            for (int m = 0; m < 4; ++m) {
                const int row = u.pm * 256 + ai * 128 + wr * 64 + m * 16 + fr, rl = row & 2047, b = rl >> 8, ci = rl & 255;
                const bool live = ci != 255;
                const f32x4 zf = {0.f, 0.f, 0.f, 0.f};
                (void)b;
                {
                    const int cl = wc * 32 + fq * 8;
                    const f32x4 v0 = live ? acc[ai][0][m][0] : zf, v1 = live ? acc[ai][0][m][1] : zf;
                    if (!isv) st8(KC + (size_t)rl * 64 + cl, v0, v1);
                }
            }
    }
    DI void vpart(const f32x4 (&acc)[2][2][4][2], const pg8::Unit& u, int wr, int wc, int fr0, int fq0) const {
        int fr = fr0, fq = fq0; asm volatile("" : "+v"(fr), "+v"(fq));
        if (u.pm < 8 || wc < 2) return;
#pragma unroll
        for (int ai = 0; ai < 2; ++ai)
#pragma unroll
            for (int m = 0; m < 4; ++m) {
                const int row = u.pm * 256 + ai * 128 + wr * 64 + m * 16 + fr, rl = row & 2047, b = rl >> 8, ci = rl & 255;
                const bool live = ci != 255;
                const f32x4 zf = {0.f, 0.f, 0.f, 0.f};
                const int d0 = (wc - 2) * 32 + fq * 8;
                const f32x4 v0 = live ? acc[ai][0][m][0] : zf, v1 = live ? acc[ai][0][m][1] : zf;
                const unsigned w0 = cvtpk(v0[0], v0[1]), w1 = cvtpk(v0[2], v0[3]), w2 = cvtpk(v1[0], v1[1]), w3 = cvtpk(v1[2], v1[3]);
                GAS bf16_t* d = (GAS bf16_t*)VCT + ((size_t)b * 64 + d0) * 256 + ci;
                d[0] = (bf16_t)w0; d[256] = (bf16_t)(w0 >> 16); d[512] = (bf16_t)w1; d[768] = (bf16_t)(w1 >> 16);
                d[1024] = (bf16_t)w2; d[1280] = (bf16_t)(w2 >> 16); d[1536] = (bf16_t)w3; d[1792] = (bf16_t)(w3 >> 16);
            }
    }
};
struct EpiCmp2All {
    static constexpr bool PERM = true;
    EpiCmp2 e;
    DI void operator()(const f32x4 (&acc)[2][2][4][2], const pg8::Unit& u, int wr, int wc, int fr0, int fq0) const {
        int fr = fr0, fq = fq0; asm volatile("" : "+v"(fr), "+v"(fq));
        if (u.pm < 8) e(acc, u, wr, wc, fr, fq); else e.vpart(acc, u, wr, wc, fr, fq);
    }
};
struct EpiMerge {
    static constexpr bool PERM = true;
    const bf16_t* PG; bf16_t* MG;
    DI void operator()(const f32x4 (&acc)[2][2][4][2], const pg8::Unit& u, int wr, int wc, int fr0, int fq0) const {
        int fr = fr0, fq = fq0; asm volatile("" : "+v"(fr), "+v"(fq));
        const int br = u.br;
#pragma unroll
        for (int ai = 0; ai < 2; ++ai)
#pragma unroll
            for (int bj = 0; bj < 2; ++bj) {
                const int rowb = u.pm * 256 + ai * 128 + wr * 64 + fr, col = u.pn * 256 + bj * 128 + wc * 32 + fq * 8;
                u32x4 gw[4], pw[4];
#pragma unroll
                for (int m = 0; m < 4; ++m) { gw[m] = *(const GAS u32x4*)(PG + (size_t)(rowb + m * 16) * 3072 + br * 1024 + col); pw[m] = (u32x4){0u, 0u, 0u, 0u}; }
                if (br > 0) {
#pragma unroll
                    for (int m = 0; m < 4; ++m) pw[m] = *(const GAS u32x4*)(MG + (size_t)(rowb + m * 16) * 1024 + col); }
#pragma unroll
                for (int m = 0; m < 4; ++m) {
                    f32x4 v0 = acc[ai][bj][m][0], v1 = acc[ai][bj][m][1];
                    v0[0] = v0[0] * bflo(gw[m].x) + bflo(pw[m].x); v0[1] = v0[1] * bfhi(gw[m].x) + bfhi(pw[m].x); v0[2] = v0[2] * bflo(gw[m].y) + bflo(pw[m].y); v0[3] = v0[3] * bfhi(gw[m].y) + bfhi(pw[m].y);
                    v1[0] = v1[0] * bflo(gw[m].z) + bflo(pw[m].z); v1[1] = v1[1] * bfhi(gw[m].z) + bfhi(pw[m].z); v1[2] = v1[2] * bflo(gw[m].w) + bflo(pw[m].w); v1[3] = v1[3] * bfhi(gw[m].w) + bfhi(pw[m].w);
                    st8(MG + (size_t)(rowb + m * 16) * 1024 + col, v0, v1);
                }
                asm volatile("" ::: "memory");
            }
    }
};
template <bool DRY = false> struct EpiResidT {
    static constexpr bool PERM = true;
    const float* hin; float* hout; bf16_t* HB; float* ssout;
    DI void operator()(const f32x4 (&acc)[2][2][4][2], const pg8::Unit& u, int wr, int wc, int fr0, int fq0) const {
        int fr = fr0, fq = fq0; asm volatile("" : "+v"(fr), "+v"(fq));
#pragma unroll
        for (int ai = 0; ai < 2; ++ai) {
            float sq[4] = {0.f, 0.f, 0.f, 0.f};
            const int rowb = u.pm * 256 + ai * 128 + wr * 64 + fr;
#pragma unroll
            for (int bj = 0; bj < 2; ++bj) {
                const size_t offb = (size_t)rowb * 1024 + u.pn * 256 + bj * 128 + wc * 32 + fq * 8;
                f32x4 ha[4], hb4[4];
#pragma unroll
                for (int m = 0; m < 4; ++m) { ha[m] = *(const GAS f32x4*)(hin + offb + (size_t)m * 16 * 1024); hb4[m] = *(const GAS f32x4*)(hin + offb + (size_t)m * 16 * 1024 + 4); }
#pragma unroll
                for (int m = 0; m < 4; ++m) {
                    const size_t off = offb + (size_t)m * 16 * 1024;
                    const f32x4 v0 = acc[ai][bj][m][0] + ha[m], v1 = acc[ai][bj][m][1] + hb4[m];
                    if (!DRY) { *(GAS f32x4*)(hout + off) = v0; *(GAS f32x4*)(hout + off + 4) = v1; }
                    st8(HB + off, v0, v1);
                    sq[m] += (v0[0] * v0[0] + v0[1] * v0[1]) + (v0[2] * v0[2] + v0[3] * v0[3]) + (v1[0] * v1[0] + v1[1] * v1[1]) + (v1[2] * v1[2] + v1[3] * v1[3]);
                }
                asm volatile("" ::: "memory");
            }
#pragma unroll
            for (int m = 0; m < 4; ++m) { float q = sq[m]; q += __shfl_xor(q, 16); q += __shfl_xor(q, 32); if (fq == 0) atomicAdd(ssout + rowb + m * 16, q); }
        }
    }
};
typedef EpiResidT<false> EpiResid;
struct EpiMemQ {
    static constexpr bool PERM = true;
    const float* ss; bf16_t* QM;
    DI void operator()(const f32x4 (&acc)[2][2][4][2], const pg8::Unit& u, int wr, int wc, int fr0, int fq0) const {
        int fr = fr0, fq = fq0; asm volatile("" : "+v"(fr), "+v"(fq));
#pragma unroll
        for (int ai = 0; ai < 2; ++ai)
#pragma unroll
            for (int m = 0; m < 4; ++m) {
                const int row = u.pm * 256 + ai * 128 + wr * 64 + m * 16 + fr;
                const float rs = rs_of(ss[row]) * C2;
#pragma unroll
                for (int bj = 0; bj < 2; ++bj) st8(QM + (size_t)row * 256 + bj * 128 + wc * 32 + fq * 8, acc[ai][bj][m][0] * rs, acc[ai][bj][m][1] * rs);
            }
    }
};
struct EpiFfnIn {
    static constexpr bool PERM = true;
    const float* ss; bf16_t* ACT;
    DI void operator()(const f32x4 (&acc)[2][2][4][2], const pg8::Unit& u, int wr, int wc, int fr0, int fq0) const {
        int fr = fr0, fq = fq0; asm volatile("" : "+v"(fr), "+v"(fq));
#pragma unroll
        for (int ai = 0; ai < 2; ++ai)
#pragma unroll
            for (int m = 0; m < 4; ++m) {
                const int row = u.pm * 256 + ai * 128 + wr * 64 + m * 16 + fr;
                const float rs = rs_of(ss[row]);
                f32x4 o0, o1;
#pragma unroll
                for (int j = 0; j < 4; ++j) { const float g0 = acc[ai][0][m][0][j] * rs, g1 = acc[ai][0][m][1][j] * rs;
                    o0[j] = g0 * sigm(g0) * (acc[ai][1][m][0][j] * rs); o1[j] = g1 * sigm(g1) * (acc[ai][1][m][1][j] * rs); }
                st8nt(ACT + (size_t)row * DFF + u.pn * 128 + wc * 32 + fq * 8, o0, o1);
            }
    }
};
constexpr int LDS_SCRATCH = 139264, MISC_OFF = LDS_SCRATCH, LDS_BYTES = 147456;
static_assert(8 * HWAVE <= LDS_SCRATCH && DS_LDS_END <= LDS_SCRATCH && 128 * 64 * 4 <= 4 * HWAVE && pg8::STAGE_BYTES <= LDS_SCRATCH, "LDS map");

#define XB_TMO      128
#define XB_XCNT(j)  (256  + 64 * (j))
#define XB_XSUB(j)  (1280 + 64 * (j))
#define XB_XGEN(j)  (2304 + 64 * (j))
#define XB_TOP      3328
#define XB_TOPGEN   3392
#define XCD_BAR_WORDS 3456
#define XB_SPIN_CAP (1u << 18)

__device__ __forceinline__ unsigned xb_ld(unsigned* p)              { return __hip_atomic_load(p, __ATOMIC_RELAXED, __HIP_MEMORY_SCOPE_AGENT); }
__device__ __forceinline__ unsigned xb_add(unsigned* p, unsigned v) { return __hip_atomic_fetch_add(p, v, __ATOMIC_RELAXED, __HIP_MEMORY_SCOPE_AGENT); }
__device__ __forceinline__ unsigned xb_xcc_id() { return (unsigned)__builtin_amdgcn_s_getreg((3 << 11) | 20) & 0xFu; }
#define XB_SPIN(cond, bar) do { unsigned _sp = 0; while (cond) { __builtin_amdgcn_s_sleep(1); \
    if ((++_sp & 255u) == 0u) { if (xb_ld(&(bar)[XB_TMO])) break; if (_sp > XB_SPIN_CAP) { atomicAdd(&(bar)[XB_TMO], 1u); break; } } } } while (0)

struct XcdBarrier {
    unsigned* bar; unsigned x;
    volatile LAS unsigned* st;
};

__device__ __forceinline__ XcdBarrier xcd_barrier_post(unsigned* bar, volatile LAS unsigned* st) {
    XcdBarrier b; b.bar = bar; b.x = xb_xcc_id(); b.st = st;
    if (threadIdx.x == 0) (void)xb_add(&bar[XB_XCNT(b.x)], 1u);
    return b;
}
__device__ __forceinline__ void xcd_barrier_complete(unsigned* bar, unsigned x, unsigned& nloc, unsigned& nx) {
    const unsigned G = gridDim.x * gridDim.y * gridDim.z;
    unsigned sum, cnt, mine, sp = 0u;
    for (;;) {
        sum = 0u; cnt = 0u; mine = 0u;
#pragma unroll
        for (unsigned j = 0; j < 16; ++j) { const unsigned c = xb_ld(&bar[XB_XCNT(j)]); sum += c; cnt += (c > 0u) ? 1u : 0u; mine = (j == x) ? c : mine; }
        if (sum == G) break;
        __builtin_amdgcn_s_sleep(1);
        if ((++sp & 255u) == 0u) { if (xb_ld(&bar[XB_TMO])) break; if (sp > XB_SPIN_CAP) { atomicAdd(&bar[XB_TMO], 1u); break; } }
    }
    nloc = mine > 0u ? mine : 1u; nx = cnt > 0u ? cnt : 1u;
}

__device__ __forceinline__ void xcd_barrier(const XcdBarrier& b) {
    asm volatile("s_waitcnt vmcnt(0)" ::: "memory");
    __syncthreads();
    if (threadIdx.x == 0) {
        unsigned* bar = b.bar;
        __builtin_amdgcn_s_waitcnt(0);
        unsigned nloc = b.st[0], nx = b.st[1];
        if (nloc == 0u) { xcd_barrier_complete(bar, b.x, nloc, nx); b.st[0] = nloc; b.st[1] = nx; }
        const unsigned old = xb_add(&bar[XB_XSUB(b.x)], 1u);
        const unsigned gen = old / nloc;
        if (old + 1u == (gen + 1u) * nloc) {
            __builtin_amdgcn_fence(__ATOMIC_RELEASE, "agent");
            asm volatile("s_waitcnt vmcnt(0)" ::: "memory");
            const unsigned og = xb_add(&bar[XB_TOP], 1u);
            const unsigned tg = og / nx;
            if (og + 1u == (tg + 1u) * nx) xb_add(&bar[XB_TOPGEN], 1u);
            else XB_SPIN(xb_ld(&bar[XB_TOPGEN]) == tg, bar);
            __builtin_amdgcn_fence(__ATOMIC_ACQUIRE, "agent");
            xb_add(&bar[XB_XGEN(b.x)], 1u);
            asm volatile("s_waitcnt vmcnt(0)" ::: "memory");
        } else {
            XB_SPIN(xb_ld(&bar[XB_XGEN(b.x)]) == gen, bar);
            __builtin_amdgcn_fence(__ATOMIC_ACQUIRE, "agent");
            asm volatile("s_waitcnt vmcnt(0)" ::: "memory");
        }
    }
    __syncthreads();
}
DI float wave_sum(float v) {
#pragma unroll
    for (int o = 1; o < 64; o <<= 1) v += __shfl_xor(v, o);
    return v;
}
DI int ropeperm(int e) { return (e & 1) ? (e >> 1) + 32 : (e >> 1); }
DI int win_srccol(int n) {
    const int pn = n >> 8, c = n & 255, g = c >> 6, e = c & 63, rp = ropeperm(e);
    switch (pn) {
        case 0: return c; case 1: return 256 + c; case 2: return 512 + c;
        case 3: return 768 + g * 64 + rp; case 4: return 1152 + g * 64 + rp; case 5: return 1476 + g * 64 + rp;
        case 6: return g == 0 ? 1024 + rp : g == 1 ? 1408 + rp : g == 2 ? 1732 + rp : 1860 + rp;
        case 7: return g == 0 ? 1988 + rp : g == 1 ? 1796 + e : g == 2 ? (e < 4 ? 1472 + e : e < 16 ? 2116 + (e - 4) : -1) : -1;
        case 8: return g == 0 ? 1088 + e : g == 1 ? 1924 + e : g == 2 ? 2052 + e : -1;
        default: return 2128 + (n - 2304);
    }
}
constexpr int CV_P = 136;
template <class ColFn> DI void conv_weight(bf16_t* dst, int N, int K, int ld, const float* gain, bool kperm, int kmax, const ColFn& colp, int gwave, int gwaves, int lane, LAS unsigned char* scr) {
    const int nkt = K >> 6, total = (N >> 6) * nkt;
    for (int t = gwave; t < total; t += gwaves) {
        const int n0 = (t / nkt) << 6, k0 = (t % nkt) << 6;
        const float* cp = colp(n0 + lane);
        const bool live = (cp != nullptr) && (k0 < kmax);
        const float* cq = live ? cp + (size_t)k0 * ld : nullptr;
#pragma unroll
        for (int c = 0; c < 2; ++c) {
            float x[32];
#pragma unroll
            for (int j = 0; j < 32; ++j) { const int kk = 32 * c + j, rr = kperm ? ropeperm(kk) : kk; x[j] = live ? cq[(size_t)rr * ld] : 0.f; }
            if (gain) {
#pragma unroll
                for (int j = 0; j < 32; ++j) x[j] *= gain[k0 + 32 * c + j];
            }
#pragma unroll
            for (int j = 0; j < 32; j += 2) *(LAS unsigned*)(scr + lane * CV_P + (32 * c + j) * 2) = cvtpk(x[j], x[j + 1]);
        }
        asm volatile("s_waitcnt lgkmcnt(0)" ::: "memory");
#pragma unroll
        for (int i = 0; i < 8; ++i) {
            const int n = 8 * i + (lane >> 3), ch = lane & 7;
            const u32x2 lo = *(LAS u32x2*)(scr + n * CV_P + ch * 16), hi = *(LAS u32x2*)(scr + n * CV_P + ch * 16 + 8);
            *(GAS u32x4*)(dst + (size_t)(n0 + n) * K + k0 + ch * 8) = (u32x4){lo.x, lo.y, hi.x, hi.y};
        }
        asm volatile("s_waitcnt lgkmcnt(0)" ::: "memory");
    }
}
DI void prologue(const Bufs& P, int gtid, int gthreads, int gwave, int gwaves, int lane, LAS unsigned char* scr) {
    for (int l = 0; l < 2; ++l) {
        { const float* W = P.w_in() + (size_t)l * 1024 * DIN;
          conv_weight(P.WIN() + (size_t)l * DINP * 1024, DINP, 1024, DIN, P.norm_mix() + l * 1024, false, 1024, [&](int n) -> const float* { const int sc = win_srccol(n); return sc < 0 ? nullptr : W + sc; }, gwave, gwaves, lane, scr); }
        { const float* W = P.w_ffn_in() + (size_t)l * 1024 * 5632;
          conv_weight(P.WFI() + (size_t)l * 5632 * 1024, 5632, 1024, 5632, P.norm_ffn() + l * 1024, false, 1024, [&](int n) -> const float* { const int c = n & 255, idx = (n >> 8) * 128 + (c & 127); return W + ((c & 128) ? DFF + idx : idx); }, gwave, gwaves, lane, scr); }
        { const float* W = P.w_ffn_out() + (size_t)l * DFF * 1024;
          conv_weight(P.WFO() + (size_t)l * 1024 * DFF, 1024, DFF, 1024, nullptr, false, DFF, [&](int n) -> const float* { return W + n; }, gwave, gwaves, lane, scr); }
        { const float* W = P.w_out() + (size_t)l * 1024 * 1024;
          conv_weight(P.WOUT() + (size_t)l * 1024 * 1024, 1024, 1024, 1024, nullptr, false, 1024, [&](int n) -> const float* { return W + n; }, gwave, gwaves, lane, scr); }
        for (int br = 0; br < 3; ++br) { const float* W = P.w_up() + ((size_t)l * 3 + br) * 256 * 1024;
          conv_weight(P.WUP() + ((size_t)l * 3 + br) * 1024 * 256, 1024, 256, 1024, nullptr, false, 256, [&](int n) -> const float* { return W + n; }, gwave, gwaves, lane, scr); }
        { const float* W = P.w_mem_q() + (size_t)l * 1024 * 256;
          conv_weight(P.WMQ() + (size_t)l * 256 * 1024, 256, 1024, 256, P.norm_mem_q() + l * 1024, false, 1024, [&](int n) -> const float* { return W + n; }, gwave, gwaves, lane, scr); }
        { const float* W = P.w_mem_kv() + (size_t)l * 1024 * 512;
          conv_weight(P.WMKV() + (size_t)l * 512 * 1024, 512, 1024, 512, P.norm_mem_kv() + l * 1024, false, 1024, [&](int n) -> const float* { return W + n; }, gwave, gwaves, lane, scr); }
        { const float* W = P.w_mem_o() + (size_t)l * 256 * 1024;
          conv_weight(P.WMO() + (size_t)l * 1024 * 256, 1024, 256, 1024, nullptr, false, 256, [&](int n) -> const float* { return W + n; }, gwave, gwaves, lane, scr); }
        { const float* Wk = P.cmp_w1_k() + (size_t)l * 2048 * 128; const float* Wv = P.cmp_w1_v() + (size_t)l * 2048 * 128;
          conv_weight(P.WC1() + (size_t)l * 256 * 2048, 128, 2048, 128, nullptr, true, 2048, [&](int n) -> const float* { return Wk + n; }, gwave, gwaves, lane, scr);
          conv_weight(P.WC1() + (size_t)l * 256 * 2048 + (size_t)128 * 2048, 128, 2048, 128, nullptr, false, 2048, [&](int n) -> const float* { return Wv + n; }, gwave, gwaves, lane, scr); }
        { const float* Wk = P.cmp_w2_k() + (size_t)l * 128 * 64; const float* Wv = P.cmp_w2_v() + (size_t)l * 128 * 64;
          conv_weight(P.WC2() + (size_t)l * 256 * 256, 256, 256, 64, nullptr, false, 128, [&](int n) -> const float* { return n < 64 ? Wk + ropeperm(n) : n < 128 ? Wv + (n - 64) : nullptr; }, gwave, gwaves, lane, scr); }
        for (int o = gwave; o < 256; o += gwaves) {
            const float* W = (o < 128 ? P.cmp_w1_k() : P.cmp_w1_v()) + (size_t)l * 2048 * 128; const float* pos = (o < 128 ? P.cmp_pos_k() : P.cmp_pos_v()) + (size_t)l * 2048; const int n = o & 127;
            float s = 0.f;
#pragma unroll 16
            for (int k = lane; k < 2048; k += 64) s += pos[k] * W[(size_t)k * 128 + n];
            s = wave_sum(s); if (lane == 0) P.BIAS1()[l * 256 + o] = s;
        }
    }
    for (int i = gtid; i < SQ * 32; i += gthreads) {
        const int pos = i >> 5, f = i & 31;
        const float inv = exp2f(-(float)f * (13.287712379549449f / 32.f));
        const float ang = (float)pos * inv;
        const double rev = (double)ang * 0.15915494309189535; const double fr = rev - __builtin_rint(rev);
        const float frf = (float)fr;
        P.rope()[i] = (f32x2){__builtin_amdgcn_cosf(frf), __builtin_amdgcn_sinf(frf)};
    }
    for (int row = 2 * gwave; row < MT + 2048; row += 2 * gwaves) {
        f32x4 v[2][4];
#pragma unroll
        for (int q = 0; q < 2; ++q) { const int rw = row + q; const bool ism = rw >= MT; const int rr = ism ? rw - MT : rw;
            const float* src = (ism ? P.mem() : P.x()) + (size_t)rr * 1024;
#pragma unroll
            for (int j = 0; j < 4; ++j) v[q][j] = *(const GAS f32x4*)(src + 256 * j + 4 * lane); }
#pragma unroll
        for (int q = 0; q < 2; ++q) { const int rw = row + q; const bool ism = rw >= MT; const int rr = ism ? rw - MT : rw;
            bf16_t* dst = (ism ? P.MEMB() : P.HB()) + (size_t)rr * 1024;
            float s = 0.f;
#pragma unroll
            for (int j = 0; j < 4; ++j) { const f32x4 t = v[q][j]; s += (t.x * t.x + t.y * t.y) + (t.z * t.z + t.w * t.w);
                u32x2 w; w.x = cvtpk(t.x, t.y); w.y = cvtpk(t.z, t.w); *(GAS u32x2*)(dst + 256 * j + 4 * lane) = w; }
            s = wave_sum(s); if (lane == 0) { if (ism) P.ssm()[rr] = s; else P.ss()[rr] = s; } }
    }
}

#ifndef PROBE_DUP
#define PROBE_DUP 0
#endif
#ifndef MK_ONE_LAUNCH
#define MK_ONE_LAUNCH 1
#endif
constexpr int NPH_LAYER = 11, PH_FINAL = 2 + 2 * NPH_LAYER, NPHASES = PH_FINAL + 1;
struct Args { Bufs P; int ph_lo, ph_hi; };

__global__ void __launch_bounds__(512, 2) mk_fwd(Args args) {
    extern __shared__ __attribute__((aligned(16))) unsigned char lds_raw[];
    LAS unsigned char* lds = (LAS unsigned char*)lds_raw;
    volatile LAS unsigned* MISC = (volatile LAS unsigned*)(lds + MISC_OFF);
    const Bufs& P = args.P;
    const int G = gridDim.x;
#define TID ((int)threadIdx.x)
#define LANE (TID & 63)
#define WAVE (__builtin_amdgcn_readfirstlane(TID >> 6))
    if (TID < 32) MISC[TID] = 0u;
    __syncthreads();
    XcdBarrier bar; bar.bar = (unsigned*)(P.ctl() + CW_BAR); bar.x = 0; bar.st = nullptr;
    if (MK_ONE_LAUNCH) bar = xcd_barrier_post((unsigned*)(P.ctl() + CW_BAR), MISC + 8);
    const int lo = args.ph_lo, hi = args.ph_hi;
#ifndef PHMASK
#define PHMASK 0xFFFFFFFFu
#endif
#define EN(i) (((PHMASK) >> (i)) & 1u)
#define IN(k) (lo <= (k) && (k) < hi)
#define SEAM(k) do { if (IN(k) && IN((k) + 1)) xcd_barrier(bar); } while (0)
#define QCTR(ph, slot) (Q.ctl() + CW_Q + ((ph) * 4 + (slot)) * 64)
#define QCTRB(ph, slot, b) (Q.ctl() + CW_Q2 + ((((ph) * 4 + (slot)) * 8 + (int)(b)) * 64))
#define FOR_WG_UNITS(ph, slot, nper, BODY) do { const unsigned myx_ = xb_xcc_id() & 7u; \
        for (unsigned qi_ = 0; qi_ < 8u; ++qi_) { const int bq = (int)((myx_ + qi_) & 7u); \
            for (;;) { if (TID == 0) MISC[16] = __hip_atomic_fetch_add(QCTRB(ph, slot, bq), 1u, RLX_AGENT); __syncthreads(); const unsigned u = MISC[16]; __syncthreads(); \
                if (u >= (unsigned)(nper)) break; BODY; } } } while (0)
#define FOR_UNITS(ph, slot, nper, BODY) do { const unsigned myx_ = xb_xcc_id() & 7u; \
        for (unsigned qi_ = 0; qi_ < 8u; ++qi_) { const int bq = (int)((myx_ + qi_) & 7u); gu32* ctr_ = QCTRB(ph, slot, bq); \
            for (;;) { const unsigned u = pull(ctr_, ln); if (u >= (unsigned)(nper)) break; BODY; } } } while (0)

    if (EN(0) && IN(0)) { prologue(P, (int)blockIdx.x * 512 + TID, G * 512, (int)blockIdx.x * 8 + WAVE, G * 8, LANE, lds + WAVE * 16384); if (PROBE_DUP == 8) prologue(P, (int)blockIdx.x * 512 + TID, G * 512, (int)blockIdx.x * 8 + WAVE, G * 8, LANE, lds + WAVE * 16384); }
    SEAM(0);
    if (EN(1) && IN(1)) {
        { pg8::Gemm g{P.HB(), P.WIN(), MT, DINP, 1024, 1024, 1024}; pg8::StaticOrder S; S.init(MT, DINP, G, (int)blockIdx.x); EpiIn E{P.ss(), P, lds + pg8::STAGE_BYTES};
          pg8::gemm_phase<EpiIn, pg8::StaticOrder, true>(lds, g, S, E);
          if (PROBE_DUP == 21) pg8::gemm_phase<EpiIn, pg8::StaticOrder, true>(lds, g, S, E);
          if (PROBE_DUP == 25) { EpiMemQ E2{P.ss(), (bf16_t*)P.out()}; pg8::gemm_phase<EpiMemQ, pg8::StaticOrder, true>(lds, g, S, E2); } }
        { pg8::Gemm g{P.MEMB(), P.WMKV(), 2048, 1024, 1024, 1024, 1024}; pg8::StaticOrder S; S.init(2048, 1024, G, (int)((blockIdx.x + G / 2) % G));   EpiMemKV E{P};
          pg8::gemm_phase<EpiMemKV, pg8::StaticOrder, false>(lds, g, S, E); }
    }
    SEAM(1);
#pragma unroll
    for (int l = 0; l < 2; ++l) {
        const int pb = 2 + l * NPH_LAYER;
        float* ss_mix = P.ss() + (size_t)(3 * l) * MT; float* ss_a = P.ss() + (size_t)(3 * l + 1) * MT; float* ss_b = P.ss() + (size_t)(3 * l + 2) * MT; float* ss_c = P.ss() + (size_t)(3 * l + 3) * MT;
        (void)ss_mix;
        if (EN(2) && IN(pb + 0)) {
            Bufs Q = P; asm volatile("" : "+s"(Q.ws), "+s"(Q.o_));
            { pg8::Gemm g{Q.KCMP(), Q.WC1() + (size_t)l * 256 * 2048, 4096, 256, 2048, 1024, 2048}; pg8::StaticOrder S; S.init(4096, 256, G, (int)blockIdx.x); EpiCmp1 E{Q.HID(), Q.BIAS1() + l * 256};
              pg8::gemm_phase<EpiCmp1, pg8::StaticOrder, false>(lds, g, S, E); }
            __syncthreads(); __builtin_amdgcn_fence(__ATOMIC_ACQUIRE, "agent"); asm volatile("s_waitcnt vmcnt(0)" ::: "memory"); __syncthreads();
            { pg8::Gemm g{Q.HID(), Q.WC2() + (size_t)l * 256 * 256, 4096, 256, 256, 256, 256}; pg8::StaticOrder S; S.init(4096, 256, G, (int)blockIdx.x); EpiCmp2All E{{Q.KC(), Q.VCT()}};
              pg8::gemm_phase<EpiCmp2All, pg8::StaticOrder, false>(lds, g, S, E); }
            int td = TID; asm volatile("" : "+v"(td)); const int ln = td & 63;
            if (PROBE_DUP == 40 || PROBE_DUP == 42) FOR_WG_UNITS(pb + 0, 2, 128, (dsa_select_wg<0, 1>(Q, bq, 127 - (int)u, ln, WAVE, (LAS unsigned*)lds)));
            else if (PROBE_DUP == 41) FOR_WG_UNITS(pb + 0, 2, 128, (dsa_select_wg<0, 2>(Q, bq, 127 - (int)u, ln, WAVE, (LAS unsigned*)lds)));
            else FOR_WG_UNITS(pb + 0, 2, 128, dsa_select_wg<0>(Q, bq, 127 - (int)u, ln, WAVE, (LAS unsigned*)lds));
            if (PROBE_DUP == 3 && l == 0) FOR_WG_UNITS(pb + 0, 3, 128, dsa_select_wg<0>(Q, bq, 127 - (int)u, ln, WAVE, (LAS unsigned*)lds));
            if (PROBE_DUP == 31 && l == 0) FOR_WG_UNITS(pb + 0, 3, 128, dsa_select_wg<11>(Q, bq, 127 - (int)u, ln, WAVE, (LAS unsigned*)lds));
            if (PROBE_DUP == 32 && l == 0) FOR_WG_UNITS(pb + 0, 3, 128, dsa_select_wg<12>(Q, bq, 127 - (int)u, ln, WAVE, (LAS unsigned*)lds));
            if (PROBE_DUP == 33 && l == 0) FOR_WG_UNITS(pb + 0, 3, 128, dsa_select_wg<13>(Q, bq, 127 - (int)u, ln, WAVE, (LAS unsigned*)lds));
            if (PROBE_DUP == 35 && l == 0) FOR_WG_UNITS(pb + 0, 3, 128, dsa_select_wg<14>(Q, bq, 127 - (int)u, ln, WAVE, (LAS unsigned*)lds));
            if (PROBE_DUP == 36 && l == 0) FOR_WG_UNITS(pb + 0, 3, 128, dsa_select_wg<15>(Q, bq, 127 - (int)u, ln, WAVE, (LAS unsigned*)lds));
            if (PROBE_DUP == 34 && l == 0) FOR_WG_UNITS(pb + 0, 3, 128, dsa_select_wg<10>(Q, bq, 127 - (int)u, ln, WAVE, (LAS unsigned*)lds));
            if (PROBE_DUP == 2 && l == 0) FOR_UNITS(pb + 0, 0, 512, sb_unit(Q, bq, (int)(u >> 7), (int)(u & 127u), ln));
        }
        SEAM(pb + 0);
        if (EN(3) && IN(pb + 1)) {
            Bufs Q = P; asm volatile("" : "+s"(Q.ws), "+s"(Q.o_));
            int td = TID; asm volatile("" : "+v"(td)); const int ln = td & 63;
            if (PROBE_DUP == 40 || PROBE_DUP == 41 || PROBE_DUP == 43) FOR_UNITS(pb + 1, 1, 128, nsa_cmp_unit<1>(Q, bq, 127 - (int)u, ln, (LAS float*)(lds + WAVE * HWAVE)));
            else FOR_UNITS(pb + 1, 1, 128, nsa_cmp_unit<0>(Q, bq, 127 - (int)u, ln, (LAS float*)(lds + WAVE * HWAVE)));
            if (PROBE_DUP == 1 && l == 0) FOR_UNITS(pb + 1, 3, 128, nsa_cmp_unit<0>(Q, bq, 127 - (int)u, ln, (LAS float*)(lds + WAVE * HWAVE)));
            FOR_WG_UNITS(pb + 1, 0, 64, dsa_attn_wg(Q, bq, 63 - (int)u, ln, WAVE, td, lds));
            if (PROBE_DUP == 6 && l == 0) FOR_WG_UNITS(pb + 1, 3, 64, dsa_attn_wg(Q, bq, 63 - (int)u, ln, WAVE, td, lds));
            if (PROBE_DUP == 61 && l == 0) FOR_WG_UNITS(pb + 1, 3, 64, dsa_attn_wg<1>(Q, bq, 63 - (int)u, ln, WAVE, td, lds));
            if (PROBE_DUP == 62 && l == 0) FOR_WG_UNITS(pb + 1, 3, 64, dsa_attn_wg<2>(Q, bq, 63 - (int)u, ln, WAVE, td, lds));
            if (PROBE_DUP == 63 && l == 0) FOR_WG_UNITS(pb + 1, 3, 64, dsa_attn_wg<3>(Q, bq, 63 - (int)u, ln, WAVE, td, lds));
            __syncthreads();
            FOR_UNITS(pb + 1, 2, 512, sb_unit(Q, bq, (int)(u >> 7), (int)(u & 127u), ln));
        }
        SEAM(pb + 1);
        if (EN(5) && IN(pb + 2)) {
            Bufs Q = P; asm volatile("" : "+s"(Q.ws), "+s"(Q.o_));
            int td = TID; asm volatile("" : "+v"(td)); const int ln = td & 63;
            FOR_WG_UNITS(pb + 2, 1, 64, nsa_selwin_wg(Q, bq, 63 - (int)u, ln, WAVE, td, lds, Q.O3()));
            if (PROBE_DUP == 5 && l == 0) FOR_WG_UNITS(pb + 2, 3, 64, nsa_selwin_wg(Q, bq, 63 - (int)u, ln, WAVE, td, lds, (bf16_t*)Q.out()));
        }
        SEAM(pb + 2);
        if (EN(6) && IN(pb + 3)) {
            Bufs Q = P; asm volatile("" : "+s"(Q.ws), "+s"(Q.o_));
            pg8::ChainOrder3 S; S.init(MT, 1024, G, (int)blockIdx.x);
            pg8::Gemm g{Q.O3(), Q.WUP() + (size_t)l * 3 * 1024 * 256, MT, 1024, 256, 768, 256, (size_t)256 * 2, (size_t)1024 * 256 * 2};
            EpiMerge E{Q.PG(), Q.MG()};
            pg8::gemm_phase<EpiMerge, pg8::ChainOrder3, true>(lds, g, S, E);
        }
        SEAM(pb + 3);
        if (EN(7) && IN(pb + 4)) {
            Bufs Q = P; asm volatile("" : "+s"(Q.ws), "+s"(Q.o_));
            pg8::Gemm g{Q.MG(), Q.WOUT() + (size_t)l * 1024 * 1024, MT, 1024, 1024, 1024, 1024}; pg8::StaticOrder S; S.init(MT, 1024, G, (int)blockIdx.x);
            EpiResid E{l == 0 ? Q.x() : (const float*)Q.out(), Q.out(), Q.HB(), ss_a};
            pg8::gemm_phase<EpiResid, pg8::StaticOrder, true>(lds, g, S, E);
            if (PROBE_DUP == 24 && l == 0) { EpiResid E2{Q.x(), Q.out(), Q.HB(), (float*)Q.TAU()}; pg8::gemm_phase<EpiResid, pg8::StaticOrder, true>(lds, g, S, E2); }
        }
        SEAM(pb + 4);
        if (EN(8) && IN(pb + 5)) {
            Bufs Q = P; asm volatile("" : "+s"(Q.ws), "+s"(Q.o_));
            pg8::Gemm g{Q.HB(), Q.WMQ() + (size_t)l * 256 * 1024, MT, 256, 1024, 1024, 1024}; pg8::StaticOrder S; S.init(MT, 256, G, (int)blockIdx.x); EpiMemQ E{ss_a, Q.QM()};
            pg8::gemm_phase<EpiMemQ, pg8::StaticOrder, false>(lds, g, S, E);
            if (PROBE_DUP == 28 && l == 0) pg8::gemm_phase<EpiMemQ, pg8::StaticOrder, false>(lds, g, S, E);
        }
        SEAM(pb + 5);
        if (EN(9) && IN(pb + 6)) {
            Bufs Q = P; asm volatile("" : "+s"(Q.ws), "+s"(Q.o_));
            int td = TID; asm volatile("" : "+v"(td)); const int ln = td & 63;
            FOR_WG_UNITS(pb + 6, 0, 64, mem_attn_wg(Q, l, bq, (int)(u & 3u), (int)(u >> 2), ln, WAVE, td, lds));
            if (PROBE_DUP == 7 && l == 0) FOR_WG_UNITS(pb + 6, 3, 64, mem_attn_wg(Q, l, bq, (int)(u & 3u), (int)(u >> 2), ln, WAVE, td, lds));
        }
        SEAM(pb + 6);
        if (EN(10) && IN(pb + 7)) {
            Bufs Q = P; asm volatile("" : "+s"(Q.ws), "+s"(Q.o_));
            pg8::Gemm g{Q.OM(), Q.WMO() + (size_t)l * 1024 * 256, MT, 1024, 256, 256, 256}; pg8::StaticOrder S; S.init(MT, 1024, G, (int)blockIdx.x);
            EpiResid E{Q.out(), Q.out(), Q.HB(), ss_b};
            pg8::gemm_phase<EpiResid, pg8::StaticOrder, true>(lds, g, S, E);
            if (PROBE_DUP == 27 && l == 0) { EpiResidT<true> E2{Q.out(), Q.out(), Q.PA(), (float*)Q.TAU()}; pg8::gemm_phase<EpiResidT<true>, pg8::StaticOrder, true>(lds, g, S, E2); }
        }
        SEAM(pb + 7);
        if (EN(11) && IN(pb + 8)) {
            Bufs Q = P; asm volatile("" : "+s"(Q.ws), "+s"(Q.o_));
            pg8::Gemm g{Q.HB(), Q.WFI() + (size_t)l * 5632 * 1024, MT, 5632, 1024, 1024, 1024}; pg8::StaticOrder S; S.init(MT, 5632, G, (int)blockIdx.x); EpiFfnIn E{ss_b, Q.ACT()};
            pg8::gemm_phase<EpiFfnIn, pg8::StaticOrder, true>(lds, g, S, E);
            if (PROBE_DUP == 22 && l == 0) pg8::gemm_phase<EpiFfnIn, pg8::StaticOrder, true>(lds, g, S, E);
        }
        SEAM(pb + 8);
        if (EN(12) && IN(pb + 9)) {
            Bufs Q = P; asm volatile("" : "+s"(Q.ws), "+s"(Q.o_));
            pg8::Gemm g{Q.ACT(), Q.WFO() + (size_t)l * 1024 * DFF, MT, 1024, DFF, DFF, DFF}; pg8::StaticOrder S; S.init(MT, 1024, G, (int)blockIdx.x);
            EpiResid E{Q.out(), Q.out(), Q.HB(), ss_c};
            pg8::gemm_phase<EpiResid, pg8::StaticOrder, true>(lds, g, S, E);
            if (PROBE_DUP == 26 && l == 0) { EpiResidT<true> E2{Q.out(), Q.out(), Q.PA(), (float*)Q.TAU()}; pg8::gemm_phase<EpiResidT<true>, pg8::StaticOrder, true>(lds, g, S, E2); }
        }
        SEAM(pb + 9);
        if (EN(13) && IN(pb + 10) && l == 0) {
            Bufs Q = P; asm volatile("" : "+s"(Q.ws), "+s"(Q.o_));
            pg8::Gemm g{Q.HB(), Q.WIN() + (size_t)DINP * 1024, MT, DINP, 1024, 1024, 1024}; pg8::StaticOrder S; S.init(MT, DINP, G, (int)blockIdx.x); EpiIn E{ss_c, Q, lds + pg8::STAGE_BYTES};
            pg8::gemm_phase<EpiIn, pg8::StaticOrder, true>(lds, g, S, E);
        }
        if (l == 0) SEAM(pb + 10);
    }
    if (PROBE_DUP == 30) { for (int i = 0; i < 20; ++i) xcd_barrier(bar); }
    if (EN(15) && IN(PH_FINAL)) {
        const float* ssf = P.ss() + (size_t)6 * MT;
        const int lane = LANE, gwave = (int)blockIdx.x * 8 + WAVE, gwaves = G * 8;
        const unsigned chkflag = (PROBE_DUP >= 40 && PROBE_DUP <= 43) ? __hip_atomic_load(P.ctl() + 2, RLX_AGENT) : 0u;
        for (int row = gwave; row < MT; row += gwaves) {
            const float rs = rs_of(ssf[row]); float* o = P.out() + (size_t)row * 1024;
#pragma unroll
            for (int j = 0; j < 4; ++j) { const f32x4 v = *(const GAS f32x4*)(o + 256 * j + 4 * lane), g = *(const GAS f32x4*)(P.norm_final() + 256 * j + 4 * lane); *(GAS f32x4*)(o + 256 * j + 4 * lane) = v * rs * g; }
            if (chkflag && row == 0 && lane < 2) o[lane] = (chkflag & (1u << lane)) ? __builtin_nanf("") : o[lane];
        }
    }
#undef IN
#undef SEAM
#undef QCTR
}

extern "C" void kernel_launch(void* const* d_in, const int* in_sizes, int n_in, void* d_out, int out_size, void* d_ws, size_t ws_size, hipStream_t stream) {
    static int grid = 0;
    if (grid == 0) {
        if (n_in != 21 || in_sizes[0] != MT * DM || out_size != MT * DM || ws_size < WS_END) {
            fprintf(stderr, "kernel_launch: unexpected problem: n_in %d in0 %d out %d ws %zu (need %zu); nothing launched\n", n_in, n_in > 0 ? in_sizes[0] : -1, out_size, ws_size, (size_t)WS_END); grid = -1; return; }
        int dev = 0, cus = 0, per_cu = 0;
        if (hipGetDevice(&dev) != hipSuccess || hipDeviceGetAttribute(&cus, hipDeviceAttributeMultiprocessorCount, dev) != hipSuccess) { grid = -1; return; }
        if (hipFuncSetAttribute((const void*)mk_fwd, hipFuncAttributeMaxDynamicSharedMemorySize, LDS_BYTES) != hipSuccess) { fprintf(stderr, "kernel_launch: hipFuncSetAttribute failed\n"); grid = -1; return; }
        if (hipOccupancyMaxActiveBlocksPerMultiprocessor(&per_cu, (const void*)mk_fwd, 512, LDS_BYTES) != hipSuccess || per_cu < 1)
            fprintf(stderr, "kernel_launch: note: occupancy query reports %d workgroups per CU\n", per_cu);
        (void)hipGetLastError();
        grid = cus;
    }
    if (grid < 0) return;
    if (hipMemsetAsync((char*)d_ws + WS_CTL, 0, CTL_ZERO_BYTES, stream) != hipSuccess) { fprintf(stderr, "kernel_launch: memset failed\n"); return; }
    Args a{};
    for (int i = 0; i < 21; ++i) a.P.in[i] = (const float*)d_in[i];
    a.P.o_ = (float*)d_out; a.P.ws = (unsigned char*)d_ws;
#if MK_ONE_LAUNCH
    a.ph_lo = 0; a.ph_hi = NPHASES;
    hipLaunchKernelGGL(mk_fwd, dim3(grid), dim3(512), LDS_BYTES, stream, a);
#else
    for (int ph = 0; ph < NPHASES; ++ph) { a.ph_lo = ph; a.ph_hi = ph + 1; hipLaunchKernelGGL(mk_fwd, dim3(grid), dim3(512), LDS_BYTES, stream, a); }
#endif
    const hipError_t le = hipPeekAtLastError();
    if (le != hipSuccess) fprintf(stderr, "kernel_launch: launch failed: %s\n", hipGetErrorName(le));
}
```

```cpp
#include <hip/hip_runtime.h>
#include <cstdio>
#include <cstdint>
#include <type_traits>

#define DI __device__ __forceinline__
#define GAS __attribute__((address_space(1)))
#define LAS __attribute__((address_space(3)))
typedef unsigned short bf16_t;
typedef short bf16x8 __attribute__((ext_vector_type(8)));
typedef short s16x4 __attribute__((ext_vector_type(4)));
typedef float f32x4 __attribute__((ext_vector_type(4)));
typedef float f32x2 __attribute__((ext_vector_type(2)));
typedef float f32x16 __attribute__((ext_vector_type(16)));
typedef unsigned u32x4 __attribute__((ext_vector_type(4)));
typedef unsigned u32x2 __attribute__((ext_vector_type(2)));
typedef GAS unsigned gu32;
typedef __bf16 bf16x2_t __attribute__((ext_vector_type(2)));
#define RLX_AGENT __ATOMIC_RELAXED, __HIP_MEMORY_SCOPE_AGENT

DI unsigned cvtpk(float lo, float hi) { f32x2 v = {lo, hi}; bf16x2_t b = __builtin_convertvector(v, bf16x2_t); return __builtin_bit_cast(unsigned, b); }
DI float bf2f(bf16_t h) { return __builtin_bit_cast(float, (unsigned)h << 16); }
DI float bflo(unsigned w) { return __builtin_bit_cast(float, w << 16); }
DI float bfhi(unsigned w) { return __builtin_bit_cast(float, w & 0xffff0000u); }

namespace pg8 {
constexpr int BM = 256, BK = 64, HALF = 128, HTB = HALF * BK * 2  , STAGE_BYTES = 8 * HTB, NXCD = 8, WGM = 8;

__host__ __device__ __forceinline__ int lds_byte(int r, int c) { const int st = (r >> 4) * 2 + (c >> 5), rr = r & 15, cc = c & 31, ob = rr * 64 + cc * 2; return st * 1024 + (ob ^ (((ob >> 9) & 1) << 5)); }
__host__ __device__ __forceinline__ void stage_rc(int b, int& R, int& C) { const int st = b / 1024, sb = b % 1024, swz = sb ^ (((sb >> 9) & 1) << 5); R = (st >> 1) * 16 + swz / 64; C = (st & 1) * 32 + (swz % 64) / 2; }
__host__ __device__ __forceinline__ int perm32(int rho) { const int n = rho >> 4, i = rho & 15; return 8 * (i >> 2) + 4 * n + (i & 3); }

struct Unit { int pm, pn, br; };
struct Gemm { const bf16_t* A; const bf16_t* Bt; int M, N, K, lda, ldb; size_t brA = 0, brB = 0; };

struct StaticOrder {
    int nM, nN, nwg, G, c;
    __host__ __device__ __forceinline__ void init(int M, int N, int G_, int c_) { nM = M / BM; nN = N / BM; nwg = nM * nN; G = G_; c = c_; }
    __host__ __device__ __forceinline__ bool next(int i, Unit& u) const {
        const long L = (long)i * G + c; if (L >= nwg) return false;
        int wgid = (int)L; { const int q = nwg / NXCD, r = nwg % NXCD, xcd = wgid % NXCD, off = wgid / NXCD; wgid = (xcd < r ? xcd * (q + 1) : r * (q + 1) + (xcd - r) * q) + off; }
        const int nig = WGM * nN, gid = wgid / nig, fm = gid * WGM, gsz = (nM - fm) < WGM ? (nM - fm) : WGM;
        u.pm = fm + ((wgid % nig) % gsz); u.pn = (wgid % nig) / gsz; u.br = 0; return true;
    }
    __device__ __forceinline__ void a_ready(const Unit&) const {}
    __device__ __forceinline__ void done(const Unit&) const {}
};

struct ChainOrder3 : StaticOrder {
    __host__ __device__ __forceinline__ bool next(int i, Unit& u) const { const int t = i / 3; if (!StaticOrder::next(t, u)) return false; u.br = i - 3 * t; return true; }
};

template <class Epi, class Sched, bool ALIGN_EPI = false, bool CHAIN = false>
__device__ __forceinline__ void gemm_phase(LAS unsigned char* lds, const Gemm g, const Sched& S, const Epi& E) {
    int tid = threadIdx.x; asm volatile("" : "+v"(tid));
    const int wid = __builtin_amdgcn_readfirstlane(tid >> 6), lane = tid & 63, wr = wid >> 2, wc = wid & 3, fr = lane & 15, fq = lane >> 4;
    const int K = g.K, nt = K / BK;
    unsigned voffA[2], voffB[2];
#pragma unroll
    for (int i = 0; i < 2; ++i) { int R, C; stage_rc(tid * 16 + i * 8192, R, C); const int Rb = Epi::PERM ? ((R & ~31) + perm32(R & 31)) : R;
        voffA[i] = (unsigned)(R * g.lda + C) * 2u; voffB[i] = (unsigned)(Rb * g.ldb + C) * 2u; }
    const size_t kstep = (size_t)(BK * 2);
    const size_t hstepA = (size_t)HALF * g.lda * 2, hstepB = (size_t)HALF * g.ldb * 2;
    const size_t tstepA = 2 * hstepA, tstepB = 2 * hstepB;
    const unsigned ldsw = (unsigned)wid * 1024u;
    const int aoff = lds_byte(wr * 64 + fr, fq * 8), boff = lds_byte(wc * 32 + fr, fq * 8);
#define PG8_SA(b, h) (((b) * 2 + (h)) * HTB)
#define PG8_SB(b, h) ((4 + (b) * 2 + (h)) * HTB)
#define PG8_STAGE(bufoff, gbase, voff) do { _Pragma("unroll") for (int _i = 0; _i < 2; ++_i) \
        __builtin_amdgcn_global_load_lds((const unsigned*)((const char*)(gbase) + (voff)[_i]), (LAS unsigned*)(lds + (bufoff) + ldsw + _i * 8192), 16, 0, 0); } while (0)
#define PG8_LDA(dst, b, h) do { _Pragma("unroll") for (int m = 0; m < 4; ++m) _Pragma("unroll") for (int k = 0; k < 2; ++k) dst[m][k] = *(const LAS bf16x8*)(lds + PG8_SA(b, h) + aoff + m * 2048 + k * 1024); } while (0)
#define PG8_LDB(dst, b, h) do { _Pragma("unroll") for (int n = 0; n < 2; ++n) _Pragma("unroll") for (int k = 0; k < 2; ++k) dst[n][k] = *(const LAS bf16x8*)(lds + PG8_SB(b, h) + boff + n * 2048 + k * 1024); } while (0)
#define PG8_MMA(ai, bj, At, Bt) do { __builtin_amdgcn_s_setprio(1); _Pragma("unroll") for (int m = 0; m < 4; ++m) _Pragma("unroll") for (int n = 0; n < 2; ++n) _Pragma("unroll") for (int k = 0; k < 2; ++k) \
        acc[ai][bj][m][n] = __builtin_amdgcn_mfma_f32_16x16x32_bf16(Bt[n][k], At[m][k], acc[ai][bj][m][n], 0, 0, 0); __builtin_amdgcn_s_setprio(0); } while (0)
#define PG8_WAIT_V(n) asm volatile("s_waitcnt vmcnt(" #n ")" ::: "memory")
#define PG8_WAIT_L(n) asm volatile("s_waitcnt lgkmcnt(" #n ")" ::: "memory")
#define PG8_BAR __builtin_amdgcn_s_barrier()
#define PG8_SCHED __builtin_amdgcn_sched_barrier(0)
    Unit cur, nxt; int ui = 0;
    if (!S.next(0, cur)) return;
    f32x4 acc[2][2][4][2];
#pragma unroll
    for (int a = 0; a < 2; ++a)
#pragma unroll
        for (int b = 0; b < 2; ++b)
#pragma unroll
            for (int m = 0; m < 4; ++m)
#pragma unroll
                for (int n = 0; n < 2; ++n) acc[a][b][m][n] = (f32x4){0.f, 0.f, 0.f, 0.f};
    bf16x8 At[4][2], B0[2][2], B1[2][2];
    const char* cA = (const char*)g.A + (size_t)cur.pm * tstepA + (size_t)cur.br * g.brA; const char* cB = (const char*)g.Bt + (size_t)cur.pn * tstepB + (size_t)cur.br * g.brB;
    S.a_ready(cur);
    PG8_STAGE(PG8_SB(0, 0), cB, voffB); PG8_STAGE(PG8_SB(0, 1), cB + hstepB, voffB); PG8_STAGE(PG8_SA(0, 0), cA, voffA); PG8_STAGE(PG8_SA(0, 1), cA + hstepA, voffA);
    if (wr == 1) PG8_BAR;
    PG8_WAIT_V(2); PG8_BAR;
    PG8_STAGE(PG8_SB(1, 0), cB + kstep, voffB); PG8_STAGE(PG8_SA(1, 0), cA + kstep, voffA); PG8_STAGE(PG8_SB(1, 1), cB + hstepB + kstep, voffB);
    PG8_WAIT_V(6); PG8_BAR;
    for (;;) {
        const bool has_next = S.next(ui + 1, nxt);
        const char* nA = has_next ? (const char*)g.A + (size_t)nxt.pm * tstepA + (size_t)nxt.br * g.brA : cA; const char* nB = has_next ? (const char*)g.Bt + (size_t)nxt.pn * tstepB + (size_t)nxt.br * g.brB : cB;
#pragma clang loop unroll(disable)
        for (int t = 0; t < nt; t += 2) {
            const bool last = (t == nt - 2);
            const char* a1 = cA + (size_t)(t + 1) * kstep;
            const char* a2 = last ? nA : cA + (size_t)(t + 2) * kstep; const char* b2 = last ? nB : cB + (size_t)(t + 2) * kstep;
            const char* a3 = a2 + kstep; const char* b3 = b2 + kstep;
            if (last && has_next) S.a_ready(nxt);
            PG8_LDB(B0, 0, 0); PG8_LDB(B1, 0, 1); PG8_SCHED; PG8_LDA(At, 0, 0); PG8_STAGE(PG8_SA(1, 1), a1 + hstepA, voffA);
            PG8_WAIT_V(8); PG8_WAIT_L(0); PG8_BAR; PG8_MMA(0, 0, At, B0); PG8_MMA(0, 1, At, B1); PG8_BAR; PG8_SCHED;
            PG8_LDA(At, 0, 1); PG8_STAGE(PG8_SB(0, 0), b2, voffB); PG8_STAGE(PG8_SB(0, 1), b2 + hstepB, voffB); PG8_STAGE(PG8_SA(0, 0), a2, voffA);
            PG8_WAIT_V(8); PG8_WAIT_L(0); PG8_BAR; PG8_MMA(1, 0, At, B0); PG8_MMA(1, 1, At, B1); PG8_BAR; PG8_SCHED;
            PG8_LDB(B0, 1, 0); PG8_LDB(B1, 1, 1); PG8_SCHED; PG8_LDA(At, 1, 0); PG8_STAGE(PG8_SA(0, 1), a2 + hstepA, voffA);
            PG8_WAIT_V(8); PG8_WAIT_L(0); PG8_BAR; PG8_MMA(0, 0, At, B0); PG8_MMA(0, 1, At, B1); PG8_BAR; PG8_SCHED;
            PG8_LDA(At, 1, 1); PG8_STAGE(PG8_SB(1, 0), b3, voffB); PG8_STAGE(PG8_SB(1, 1), b3 + hstepB, voffB); PG8_STAGE(PG8_SA(1, 0), a3, voffA);
            PG8_WAIT_V(8); PG8_WAIT_L(0); PG8_BAR; PG8_MMA(1, 0, At, B0); PG8_MMA(1, 1, At, B1); PG8_BAR; PG8_SCHED;
        }
        if constexpr (ALIGN_EPI) { if (wr == 0) PG8_BAR; }
        if constexpr (CHAIN) E.step(acc, cur, wr, wc, fr, fq); else E(acc, cur, wr, wc, fr, fq);
        S.done(cur);
        if (!has_next) break;
        if (!CHAIN || cur.br == 2) {
#pragma unroll
        for (int a = 0; a < 2; ++a)
#pragma unroll
            for (int b = 0; b < 2; ++b)
#pragma unroll
                for (int m = 0; m < 4; ++m)
#pragma unroll
                    for (int n = 0; n < 2; ++n) acc[a][b][m][n] = (f32x4){0.f, 0.f, 0.f, 0.f};
        }
        cur = nxt; cA = nA; cB = nB; ++ui;
        if constexpr (ALIGN_EPI) { if (wr == 1) PG8_BAR; }
    }
    PG8_WAIT_V(0);
    if constexpr (!ALIGN_EPI) { if (wr == 0) PG8_BAR; }
    PG8_BAR;
#undef PG8_SA
#undef PG8_SB
#undef PG8_STAGE
#undef PG8_LDA
#undef PG8_LDB
#undef PG8_MMA
#undef PG8_WAIT_V
#undef PG8_WAIT_L
#undef PG8_BAR
#undef PG8_SCHED
}
}
constexpr int NB = 8, SQ = 4096, DM = 1024, MT = NB * SQ;
constexpr int DIN = 5200, DINP = 5376, DFF = 2816, NMEM = 256;
constexpr int PAP = 1600;
constexpr int C_QA = 0, C_KA = 256, C_QB = 512, C_QI = 768, C_QC = 1024, C_KB = 1280, C_KI = 1344, C_KSEL = 1472, C_KWIN = 1536;
constexpr float LOG2E = 1.4426950408889634f;
constexpr float C2 = 0.125f * LOG2E;
constexpr float RMS_EPS = 1e-6f;

#define MFMA32(a, b, c) __builtin_amdgcn_mfma_f32_32x32x16_bf16((a), (b), (c), 0, 0, 0)
DI int crow(int i, int hh) { return (i & 3) + 8 * (i >> 2) + 4 * hh; }
DI bf16x8 ldg16(const bf16_t* p) { return *(const GAS bf16x8*)p; }
DI bf16x8 ld_vt(const bf16_t* p) { const s16x4 lo = *(const GAS s16x4*)p, hi = *(const GAS s16x4*)(p + 8); return __builtin_shufflevector(lo, hi, 0, 1, 2, 3, 4, 5, 6, 7); }
DI bf16x8 pack8(const f32x16& x, int s) { u32x4 p; p.x = cvtpk(x[8 * s], x[8 * s + 1]); p.y = cvtpk(x[8 * s + 2], x[8 * s + 3]); p.z = cvtpk(x[8 * s + 4], x[8 * s + 5]); p.w = cvtpk(x[8 * s + 6], x[8 * s + 7]); return __builtin_bit_cast(bf16x8, p); }
DI unsigned shx32u(unsigned v) { auto rr = __builtin_amdgcn_permlane32_swap(v, v, false, false); return (threadIdx.x & 32u) ? rr[0] : rr[1]; }
DI float shx32(float v) { return __uint_as_float(shx32u(__float_as_uint(v))); }
DI f32x16 zero16() { f32x16 z; _Pragma("unroll") for (int i = 0; i < 16; ++i) z[i] = 0.f; return z; }
DI unsigned pull(gu32* ctr, int lane) { unsigned v = 0; if (lane == 0) v = __hip_atomic_fetch_add(ctr, 1u, RLX_AGENT); return (unsigned)__builtin_amdgcn_readfirstlane((int)v); }
DI unsigned le_mask(int d, int hh) {
    const int dd = d - 4 * hh, rem = dd & 7;
    int n = 4 * (dd >> 3) + (rem < 3 ? rem + 1 : 4);
    n = dd < 0 ? 0 : (n > 16 ? 16 : n);
    return (1u << n) - 1u;
}
DI unsigned bitif(bool c, int i) { unsigned b = c ? 1u : 0u; asm("" : "+v"(b)); return b << i; }
DI float fexp2(float x) { return __builtin_amdgcn_exp2f(x); }
DI float flog2(float x) { return __builtin_amdgcn_logf(x); }

DI f32x16 qk_tile(const bf16_t* kp, const bf16x8 (&qf)[4]) {
    bf16x8 kf[4];
#pragma unroll
    for (int s = 0; s < 4; ++s) kf[s] = ldg16(kp + 16 * s);
    f32x16 z = zero16();
#pragma unroll
    for (int s = 0; s < 4; ++s) z = MFMA32(kf[s], qf[s], z);
    return z;
}
DI void pv_tile(f32x16& o0, f32x16& o1, const bf16_t* vp, size_t vts, const f32x16& p) {
#pragma unroll
    for (int s = 0; s < 2; ++s) {
        const bf16x8 pf = pack8(p, s);
        const bf16x8 v0 = ld_vt(vp + 16 * s), v1 = ld_vt(vp + 32 * vts + 16 * s);
        o0 = MFMA32(v0, pf, o0); o1 = MFMA32(v1, pf, o1);
    }
}
DI void store_ot(bf16_t* orow, const f32x16& o0, const f32x16& o1, float sc, int hh) {
#pragma unroll
    for (int g = 0; g < 4; ++g) {
        u32x2 w0, w1;
        w0.x = cvtpk(o0[4 * g] * sc, o0[4 * g + 1] * sc); w0.y = cvtpk(o0[4 * g + 2] * sc, o0[4 * g + 3] * sc);
        w1.x = cvtpk(o1[4 * g] * sc, o1[4 * g + 1] * sc); w1.y = cvtpk(o1[4 * g + 2] * sc, o1[4 * g + 3] * sc);
        *(GAS u32x2*)(orow + 8 * g + 4 * hh) = w0; *(GAS u32x2*)(orow + 32 + 8 * g + 4 * hh) = w1;
    }
}

struct KV { bf16x8 k[4]; bf16x8 v[4]; };
DI void load_k4(bf16x8 (&k)[4], const bf16_t* kp) {
#pragma unroll
    for (int s = 0; s < 4; ++s) k[s] = ldg16(kp + 16 * s);
}
DI void load_kv(KV& t, const bf16_t* kp, const bf16_t* vp, size_t vts) {
    load_k4(t.k, kp);
#pragma unroll
    for (int s = 0; s < 2; ++s) { t.v[2 * s] = ld_vt(vp + 16 * s); t.v[2 * s + 1] = ld_vt(vp + 32 * vts + 16 * s); }
}
DI f32x16 qk_frag(const bf16x8 (&kf)[4], const bf16x8 (&qf)[4]) {
    f32x16 z = zero16();
#pragma unroll
    for (int s = 0; s < 4; ++s) z = MFMA32(kf[s], qf[s], z);
    return z;
}
DI void pv_frag(f32x16& o0, f32x16& o1, const bf16x8 (&v)[4], const f32x16& p) {
#pragma unroll
    for (int s = 0; s < 2; ++s) { const bf16x8 pf = pack8(p, s); o0 = MFMA32(v[2 * s], pf, o0); o1 = MFMA32(v[2 * s + 1], pf, o1); }
}
constexpr float SM_THR = 10.f;
template <bool MASKED = true> DI void softmax_step(f32x16& z, unsigned vm, float& m, float& l, f32x16& o0, f32x16& o1) {
    const float ninf = -__builtin_inff();
    if (MASKED) {
#pragma unroll
    for (int i = 0; i < 16; ++i) z[i] = ((vm >> i) & 1u) ? z[i] : ninf; }
    float t0 = __builtin_fmaxf(__builtin_fmaxf(z[0], z[1]), z[2]), t1 = __builtin_fmaxf(__builtin_fmaxf(z[3], z[4]), z[5]), t2 = __builtin_fmaxf(__builtin_fmaxf(z[6], z[7]), z[8]),
          t3 = __builtin_fmaxf(__builtin_fmaxf(z[9], z[10]), z[11]), t4 = __builtin_fmaxf(__builtin_fmaxf(z[12], z[13]), z[14]);
    float tm = __builtin_fmaxf(__builtin_fmaxf(__builtin_fmaxf(t0, t1), __builtin_fmaxf(t2, t3)), __builtin_fmaxf(t4, z[15]));
    tm = __builtin_fmaxf(tm, shx32(tm));
    const float mc = __builtin_fmaxf(m, tm);
    if (__any(mc > m + SM_THR)) {
        const float alpha = fexp2(m - mc);
        l *= alpha;
#pragma unroll
        for (int i = 0; i < 16; ++i) { o0[i] *= alpha; o1[i] *= alpha; }
        m = mc;
    }
    float ls = 0.f;
#pragma unroll
    for (int i = 0; i < 16; ++i) { z[i] = fexp2(z[i] - m); ls += z[i]; }
    l += ls;
}
DI float sm_meff(float m) { return m > -1e29f ? m : 0.f; }
DI f32x16 qk_frag_init(const bf16x8 (&kf)[4], const bf16x8 (&qf)[4], const f32x16& init) {
    f32x16 z = init;
#pragma unroll
    for (int s = 0; s < 4; ++s) z = MFMA32(kf[s], qf[s], z);
    return z;
}
DI float max_x32(float v) { auto rr = __builtin_amdgcn_permlane32_swap(__float_as_uint(v), __float_as_uint(v), false, false); return fmaxf(__uint_as_float(rr[0]), __uint_as_float(rr[1])); }
DI float add_x32(float v) { auto rr = __builtin_amdgcn_permlane32_swap(__float_as_uint(v), __float_as_uint(v), false, false); return __uint_as_float(rr[0]) + __uint_as_float(rr[1]); }
DI void softmax_core(f32x16& z, float& m, float& l, f32x16& o0, f32x16& o1) {
    float t0 = __builtin_fmaxf(__builtin_fmaxf(z[0], z[1]), z[2]), t1 = __builtin_fmaxf(__builtin_fmaxf(z[3], z[4]), z[5]), t2 = __builtin_fmaxf(__builtin_fmaxf(z[6], z[7]), z[8]),
          t3 = __builtin_fmaxf(__builtin_fmaxf(z[9], z[10]), z[11]), t4 = __builtin_fmaxf(__builtin_fmaxf(z[12], z[13]), z[14]);
    float tm = __builtin_fmaxf(__builtin_fmaxf(__builtin_fmaxf(t0, t1), __builtin_fmaxf(t2, t3)), __builtin_fmaxf(t4, z[15]));
    tm = max_x32(tm);
    const bool started = m > -1e29f, haskey = tm > -3e38f;
    if (__any(started ? (tm > SM_THR) : haskey)) {
        const float delta = started ? __builtin_fmaxf(tm, 0.f) : (haskey ? tm : 0.f);
        const float alpha = started ? fexp2(-delta) : 1.f;
        l *= alpha;
#pragma unroll
        for (int i = 0; i < 16; ++i) { o0[i] *= alpha; o1[i] *= alpha; z[i] -= delta; }
        m = started ? m + delta : (haskey ? tm : m);
    }
    f32x2 ls2 = {0.f, 0.f};
#pragma unroll
    for (int i = 0; i < 16; i += 2) { z[i] = fexp2(z[i]); z[i + 1] = fexp2(z[i + 1]); ls2 += (f32x2){z[i], z[i + 1]}; }
    l += ls2.x + ls2.y;
}
template <bool SKIP, class MaskFn>
DI void attn_tiles(f32x16& o0, f32x16& o1, float& m, float& l, const bf16x8 (&qf)[4], const bf16_t* kbase, size_t kpitch, const bf16_t* vtbase, size_t vts,
                   int kt_lo, int kt_hi, const MaskFn& mask, int r, int hh) {
    const bf16_t* kl = kbase + (size_t)r * kpitch + 8 * hh; const bf16_t* vl = vtbase + (size_t)r * vts + 4 * hh;
    int kt = kt_lo; unsigned vm = 0u;
    if (SKIP) { for (; kt <= kt_hi; ++kt) { vm = mask(kt); if (__any(vm != 0u)) break; } } else { if (kt <= kt_hi) vm = mask(kt); }
    if (kt > kt_hi) return;
    KV cur; load_kv(cur, kl + (size_t)(kt * 32) * kpitch, vl + kt * 32, vts);
    for (;;) {
        int kn = kt + 1; unsigned vmn = 0u;
        if (SKIP) { for (; kn <= kt_hi; ++kn) { vmn = mask(kn); if (__any(vmn != 0u)) break; } } else { if (kn <= kt_hi) vmn = mask(kn); }
        const bool more = kn <= kt_hi;
        KV nxt = cur; if (more) load_kv(nxt, kl + (size_t)(kn * 32) * kpitch, vl + kn * 32, vts);
        f32x16 z = qk_frag(cur.k, qf);
        softmax_step(z, vm, m, l, o0, o1);
        pv_frag(o0, o1, cur.v, z);
        if (!more) break;
        cur = nxt; vm = vmn; kt = kn;
    }
}
DI void load_q(bf16x8 (&qf)[4], const bf16_t* qp) {
#pragma unroll
    for (int s = 0; s < 4; ++s) qf[s] = ldg16(qp + 16 * s);
}

constexpr size_t MiB = 1u << 20;
constexpr size_t WS_CTL = 0, CTL_ZERO_BYTES = 2 * MiB;
constexpr size_t WS_ROPE = 2 * MiB, WS_WG = 3 * MiB, WS_TAU = 5 * MiB, WS_RR = WS_TAU + 128 * 1024, WS_BM = WS_TAU + 256 * 1024, WS_BIAS1 = WS_TAU + 512 * 1024;
constexpr size_t WS_KC = 6 * MiB, WS_VCT = WS_KC + 256 * 1024, WS_HID = WS_KC + 512 * 1024;
constexpr size_t WS_MEMB = 9 * MiB, WS_KMEM = 13 * MiB, WS_VMEMT = 15 * MiB;
constexpr size_t WS_KCMP = 17 * MiB, WS_VCMP = 21 * MiB;
constexpr size_t WS_VAT = 26 * MiB, WS_VBT = 42 * MiB, WS_VST = 46 * MiB, WS_VWT = 50 * MiB;
constexpr size_t WS_WIN = 54 * MiB, WS_WFI = 75 * MiB, WS_WFO = 97 * MiB, WS_WOUT = 108 * MiB, WS_WUP = 112 * MiB, WS_WMQ = 115 * MiB, WS_WMKV = 116 * MiB, WS_WMO = 118 * MiB,
                 WS_WC1 = 119 * MiB, WS_WC2 = 121 * MiB;
constexpr size_t WS_HB = 122 * MiB;
constexpr size_t WS_PA = 186 * MiB;
constexpr size_t WS_PG = 286 * MiB;
constexpr size_t WS_SSX = 478 * MiB;
constexpr size_t WS_END = 480 * MiB;
typedef unsigned long long ssq_t; constexpr float SSQ_SCALE = 16777216.f;
static_assert(WS_VCMP == WS_KCMP + (size_t)MT * 64 * 2, "compact cmp buffers must be adjacent");
static_assert(WS_PA + (size_t)MT * PAP * 2 <= WS_PG && WS_PG + (size_t)MT * 3072 * 2 <= WS_END && WS_HB + 64 * MiB <= WS_PA, "ws map");
static_assert(WS_WIN + (size_t)2 * DINP * 1024 * 2 <= WS_WFI && WS_WFI + (size_t)2 * 5632 * 1024 * 2 <= WS_WFO && WS_WFO + (size_t)2 * 1024 * DFF * 2 <= WS_WOUT, "weights map");
constexpr int CW_TMO = 0, CW_BAR = 4096, CW_Q = 8192, CW_SS = 32768, CW_SSM = CW_SS + 7 * MT, CW_Q2 = CW_SSM + 2048;
static_assert((size_t)(CW_Q2 + 32 * 4 * 8 * 64) * 4 <= CTL_ZERO_BYTES, "ctl region");
struct Bufs {
    const float* in[21]; float* o_; unsigned char* ws;
#define BIN(name, idx) DI const float* name() const { return in[idx]; }
    BIN(x, 0) BIN(mem, 1) BIN(norm_mix, 2) BIN(w_in, 3) BIN(cmp_pos_k, 4) BIN(cmp_w1_k, 5) BIN(cmp_w2_k, 6) BIN(cmp_pos_v, 7) BIN(cmp_w1_v, 8) BIN(cmp_w2_v, 9) BIN(w_up, 10) BIN(w_out, 11)
    BIN(norm_mem_q, 12) BIN(norm_mem_kv, 13) BIN(w_mem_q, 14) BIN(w_mem_kv, 15) BIN(w_mem_o, 16) BIN(norm_ffn, 17) BIN(w_ffn_in, 18) BIN(w_ffn_out, 19) BIN(norm_final, 20)
#undef BIN
#define BWS(type, name, off) DI type* name() const { return (type*)(ws + (off)); }
    DI float* out() const { return o_; }
    DI gu32* ctl() const { return (gu32*)(ws + WS_CTL); }
    BWS(ssq_t, ss, WS_SSX) BWS(float, ssm, WS_CTL + (size_t)CW_SSM * 4)
    BWS(f32x2, rope, WS_ROPE) BWS(float, WG, WS_WG) BWS(unsigned, TAU, WS_TAU) BWS(unsigned, RR, WS_RR) BWS(unsigned long long, BM, WS_BM) BWS(float, BIAS1, WS_BIAS1)
    BWS(bf16_t, KC, WS_KC) BWS(bf16_t, VCT, WS_VCT) BWS(bf16_t, HID, WS_HID) BWS(bf16_t, MEMB, WS_MEMB) BWS(bf16_t, KMEM, WS_KMEM) BWS(bf16_t, VMEMT, WS_VMEMT)
    BWS(bf16_t, KCMP, WS_KCMP) BWS(bf16_t, VCMP, WS_VCMP) BWS(bf16_t, VAT, WS_VAT) BWS(bf16_t, VBT, WS_VBT) BWS(bf16_t, VST, WS_VST) BWS(bf16_t, VWT, WS_VWT)
    BWS(bf16_t, WIN, WS_WIN) BWS(bf16_t, WFI, WS_WFI) BWS(bf16_t, WFO, WS_WFO) BWS(bf16_t, WOUT, WS_WOUT) BWS(bf16_t, WUP, WS_WUP) BWS(bf16_t, WMQ, WS_WMQ)
    BWS(bf16_t, WMKV, WS_WMKV) BWS(bf16_t, WMO, WS_WMO) BWS(bf16_t, WC1, WS_WC1) BWS(bf16_t, WC2, WS_WC2)
    BWS(bf16_t, HB, WS_HB)
    DI bf16_t* O3() const { return (bf16_t*)o_; } DI unsigned short* MB() const { return (unsigned short*)((unsigned char*)o_ + 48 * MiB); }
    BWS(bf16_t, PA, WS_PA) BWS(bf16_t, MG, WS_PA) BWS(bf16_t, QM, WS_PA + 64 * MiB) BWS(bf16_t, OM, WS_PA + 80 * MiB)
    BWS(unsigned char, PG, WS_PG) BWS(bf16_t, ACT, WS_PG)
#undef BWS
};

DI void sb_unit(const Bufs& P, int b, int h, int qb, int lane) {
    const int r = lane & 31, hh = lane >> 5, q0 = qb * 32, tq = q0 + r;
    const size_t row = (size_t)b * SQ + tq;
    bf16x8 qf[4]; load_q(qf, P.PA() + row * PAP + C_QA + h * 64 + 8 * hh);
    f32x16 o0 = zero16(), o1 = zero16();
    float R = 0.f;
    const bf16_t* kb = P.PA() + ((size_t)b * SQ + r) * PAP + C_KA + h * 64 + 8 * hh;
    const bf16_t* vb = P.VAT() + ((size_t)(b * 4 + h) * 64 + r) * SQ + 4 * hh;
    KV cur; load_kv(cur, kb + (size_t)(qb * 32) * PAP, vb + qb * 32, SQ);
    for (int kt = qb; kt >= 0; --kt) {
        const int k0 = kt * 32;
        KV nxt = cur; if (kt > 0) load_kv(nxt, kb + (size_t)(k0 - 32) * PAP, vb + k0 - 32, SQ);
        f32x16 z = qk_frag(cur.k, qf);
        float Lg[16];
#pragma unroll
        for (int i = 0; i < 16; ++i) {
            const bool valid = (k0 + crow(i, hh)) < tq;
            const float zz = z[i], sp = fmaxf(zz, 0.f) + 0.6931471805599453f * flog2(1.f + fexp2(-fabsf(zz) * LOG2E));
            Lg[i] = valid ? -sp : 0.f;
        }
        float T[4];
#pragma unroll
        for (int g = 0; g < 4; ++g) { Lg[4 * g + 2] += Lg[4 * g + 3]; Lg[4 * g + 1] += Lg[4 * g + 2]; Lg[4 * g] += Lg[4 * g + 1]; T[g] = Lg[4 * g]; }
        float PT[4];
#pragma unroll
        for (int g = 0; g < 4; ++g) PT[g] = shx32(T[g]);
        float above = R;
#pragma unroll
        for (int g = 3; g >= 0; --g) {
            const float ab = above + (hh == 0 ? PT[g] : 0.f);
#pragma unroll
            for (int e = 0; e < 4; ++e) {
                const int i = 4 * g + e; const bool valid = (k0 + crow(i, hh)) < tq;
                z[i] = valid ? fexp2((z[i] + Lg[i] + ab) * LOG2E) : 0.f;
            }
            above += T[g] + PT[g];
        }
        R = above;
        pv_frag(o0, o1, cur.v, z);
        if (__all(R < -60.f)) break;
        cur = nxt;
    }
    store_ot(P.O3() + row * 768 + h * 64, o0, o1, 1.f, hh);
}

DI unsigned mono_key(float s) { const unsigned u = __builtin_bit_cast(unsigned, s + 0.0f); return u ^ ((unsigned)((int)u >> 31) | 0x80000000u); }
DI float mono_inv(unsigned k) { const unsigned u = (k & 0x80000000u) ? (k ^ 0x80000000u) : ~k; return __builtin_bit_cast(float, u); }
DI float mono_inv_hi(unsigned k) { if (k == 0x7fffffffu) return __builtin_bit_cast(float, 0x80000001u); const float f = mono_inv(k); return (f != f) ? ((k & 0x80000000u) ? __builtin_inff() : -__builtin_inff()) : f; }
DI float relu_f(float x) { const int b = __float_as_int(x); return __int_as_float(b > 0 ? b : 0); }
DI void idx_tile(float (&sc)[16], const bf16x8 (&kf)[4], const bf16x8 (&qi)[4][4], const float (&w)[4]) {
    f32x16 z0 = zero16(), z1 = zero16(), z2 = zero16(), z3 = zero16();
#pragma unroll
    for (int s = 0; s < 4; ++s) { z0 = MFMA32(kf[s], qi[0][s], z0); z1 = MFMA32(kf[s], qi[1][s], z1); z2 = MFMA32(kf[s], qi[2][s], z2); z3 = MFMA32(kf[s], qi[3][s], z3); }
#pragma unroll
    for (int i = 0; i < 16; ++i) { float t = w[0] * relu_f(z0[i]); t = __builtin_fmaf(w[1], relu_f(z1[i]), t); t = __builtin_fmaf(w[2], relu_f(z2[i]), t); sc[i] = __builtin_fmaf(w[3], relu_f(z3[i]), t); }
}

constexpr int KT_SLICE = 32 * 144;
DI void ktile_issue(u32x4 (&rg)[4], const bf16_t* kcol  , int k0, int lane) {
    const bf16_t* p = kcol + (size_t)(k0 + (lane >> 3)) * PAP + (lane & 7) * 8;
#pragma unroll
    for (int i = 0; i < 4; ++i) rg[i] = *(const GAS u32x4*)(p + (size_t)(8 * i) * PAP);
}
DI void ktile_commit(LAS unsigned char* slice, const u32x4 (&rg)[4], int lane) {
    LAS unsigned char* p = slice + (lane >> 3) * 144 + (lane & 7) * 16;
#pragma unroll
    for (int i = 0; i < 4; ++i) *(LAS u32x4*)(p + i * 8 * 144) = rg[i];
}
DI void ktile_frags(bf16x8 (&kf)[4], const LAS unsigned char* slice, int lane) {
    const LAS unsigned char* p = slice + (lane & 31) * 144 + (lane >> 5) * 16;
#pragma unroll
    for (int s2 = 0; s2 < 4; ++s2) kf[s2] = *(const LAS bf16x8*)(p + s2 * 32);
}
constexpr int HROW = 132;
constexpr int HWAVE = 32 * HROW * 4;
constexpr int DS_CAP = 64;
constexpr int DS_OFF_KSL = 4 * HWAVE, DS_OFF_FLAG = DS_OFF_KSL + 8 * KT_SLICE, DS_OFF_CNT = DS_OFF_FLAG + 512, DS_OFF_CAND = DS_OFF_CNT + 128, DS_LDS_END = DS_OFF_CAND + 32 * DS_CAP * 8;
template <int EXPT = 0, class F> DI void ds_tile_pass(const bf16_t* kcol, LAS unsigned char* kslice, int qb, int wave, int lane, const bf16x8 (&qi)[4][4], const float (&w)[4], const F& f) {
    if (wave > qb) return;
    u32x4 rg[4]; ktile_issue(rg, kcol, wave * 32, lane); ktile_commit(kslice, rg, lane);
    for (int kt = wave; kt <= qb; kt += 8) {
        const int k0 = kt * 32;
        bf16x8 kf[4]; ktile_frags(kf, kslice, lane);
        if (EXPT != 13 && kt + 8 <= qb) ktile_issue(rg, kcol, k0 + 256, lane);
        float sc[16]; if (EXPT == 12) { _Pragma("unroll") for (int i = 0; i < 16; ++i) sc[i] = __builtin_bit_cast(float, (int)kf[i & 3][i >> 2] << 16); } else idx_tile(sc, kf, qi, w);
        f(kt, k0, sc);
        if (EXPT != 13 && kt + 8 <= qb) ktile_commit(kslice, rg, lane);
    }
}
template <int EXP = 0, int CHK = 0> DI void dsa_select_wg(const Bufs& P, int b, int qb, int lane, int wave, LAS unsigned* hist4) {
    const int r = lane & 31, hh = lane >> 5, q0 = qb * 32, tq = q0 + r;
    const size_t row = (size_t)b * SQ + tq;
    const bool takeall = (tq + 1) <= 256;
    bf16x8 qi[4][4];
#pragma unroll
    for (int hd = 0; hd < 4; ++hd) load_q(qi[hd], P.PA() + row * PAP + C_QI + hd * 64 + 8 * hh);
    float w[4]; { const f32x4 wv = *(const GAS f32x4*)(P.WG() + row * 16); w[0] = wv.x; w[1] = wv.y; w[2] = wv.z; w[3] = wv.w; }
    LAS unsigned char* const base = (LAS unsigned char*)hist4;
    { LAS unsigned* z = hist4 + wave * 2112 + lane;
#pragma unroll
      for (int j = 0; j < 33; ++j) z[64 * j] = 0u; }
    LAS unsigned* const tieflag = (LAS unsigned*)(base + DS_OFF_FLAG);
    LAS unsigned* const chk = tieflag + 4;
    LAS unsigned* const ccnt_l = (LAS unsigned*)(base + DS_OFF_CNT);
    LAS unsigned* const cand = (LAS unsigned*)(base + DS_OFF_CAND);
    if (wave == 0) { if (lane == 0) *tieflag = 0u; if (lane < 32) { ccnt_l[lane] = 0u; if (CHK) { chk[3 * lane] = 0xffffffffu; chk[3 * lane + 1] = 0u; chk[3 * lane + 2] = 0u; } } }
    __syncthreads();
    unsigned prefix = 0u, krem = (CHK == 2) ? 255u : 256u, bc = 0u; int npass = 0; bool early = false;
    const bf16_t* kcol = P.PA() + (size_t)b * SQ * PAP + C_KI;
    LAS unsigned char* kslice = base + DS_OFF_KSL + wave * KT_SLICE;
    LAS unsigned* const mk = hist4;
    unsigned short* const mbp = (EXP >= 10 ? (unsigned short*)(P.ws + 480 * MiB) : P.MB()) + ((size_t)(b * 128 + qb) * 128) * 64 + lane;
    const unsigned sq = (unsigned)r >> 3;
    auto hist_pass = [&](int pass) -> bool {
        const int sh_d = 24 - 8 * pass, sh_p = (32 - 8 * pass) & 31;
        const unsigned klo = pass == 0 ? 0u : (prefix << sh_p), khi = pass == 0 ? 0xffffffffu : (klo | ((1u << sh_p) - 1u));
        float flo = mono_inv(klo); const float fhi = mono_inv_hi(khi);
        if (flo != flo) flo = -__builtin_inff();
        LAS unsigned* hrow = hist4 + pass * (32 * HROW) + r * HROW;
        auto hbody = [&](auto allv_c, int k0, const float (&sc)[16]) {
            constexpr bool ALLV = decltype(allv_c)::value;
            if (pass == 0) {
#pragma unroll
                for (int i = 0; i < 16; ++i) {
                    const unsigned d = mono_key(sc[i]) >> 24;
                    const unsigned val = (ALLV || (k0 + crow(i, hh)) <= tq) ? (1u << (16 * (d & 1u))) : 0u;
                    if (EXP == 14) { if (lane & 1) __hip_atomic_fetch_add(hrow + ((d >> 1) ^ sq), val, __ATOMIC_RELAXED, __HIP_MEMORY_SCOPE_WORKGROUP); }
                    else if (EXP == 15) { if (i & 1) __hip_atomic_fetch_add(hrow + ((d >> 1) ^ sq), val, __ATOMIC_RELAXED, __HIP_MEMORY_SCOPE_WORKGROUP); else asm volatile("" :: "v"(val), "v"(d)); }
                    else if (EXP != 1 && EXP != 11) __hip_atomic_fetch_add(hrow + ((d >> 1) ^ sq), val, __ATOMIC_RELAXED, __HIP_MEMORY_SCOPE_WORKGROUP); else asm volatile("" :: "v"(val), "v"(d));
                }
            } else {
#pragma unroll
                for (int i = 0; i < 16; ++i) {
                    const bool ok = (ALLV || (k0 + crow(i, hh)) <= tq) && sc[i] >= flo && sc[i] <= fhi;
                    if (ok) { const unsigned d = (mono_key(sc[i]) >> sh_d) & 255u;
                        __hip_atomic_fetch_add(hrow + ((d >> 1) ^ sq), 1u << (16 * (d & 1u)), __ATOMIC_RELAXED, __HIP_MEMORY_SCOPE_WORKGROUP); }
                }
            }
        };
        ds_tile_pass<EXP>(kcol, kslice, qb, wave, lane, qi, w, [&](int kt, int k0, const float (&sc)[16]) {
            if (kt < qb) hbody(std::true_type{}, k0, sc); else hbody(std::false_type{}, k0, sc);
        });
        __syncthreads();
        LAS unsigned* hhalf = hrow + 64 * hh;
        unsigned gs[16], tot = 0u;
#pragma unroll
        for (int j = 0; j < 16; ++j) { const u32x4 x = *(LAS u32x4*)(hhalf + 4 * j);
            gs[j] = ((x.x & 0xffffu) + (x.x >> 16)) + ((x.y & 0xffffu) + (x.y >> 16)) + ((x.z & 0xffffu) + (x.z >> 16)) + ((x.w & 0xffffu) + (x.w >> 16)); tot += gs[j]; }
        const unsigned oth = shx32u(tot), U = hh ? tot : oth;
        const bool mine = hh ? (krem <= U) : (krem > U);
        const unsigned target = hh ? krem : krem - U;
        unsigned cum = 0u; int fj = -1;
#pragma unroll
        for (int j = 15; j >= 0; --j) { const bool hit = (fj < 0) && (cum + gs[j] >= target); fj = hit ? j : fj; cum += (fj < 0) ? gs[j] : 0u; }
        u32x4 xg = *(LAS u32x4*)(hhalf + 4 * (fj < 0 ? 0 : fj));
        if (sq & 1u) xg = (u32x4){xg.y, xg.x, xg.w, xg.z};
        if (sq & 2u) xg = (u32x4){xg.z, xg.w, xg.x, xg.y};
        unsigned above = 0u, binc = 0u; int found = -1;
#pragma unroll
        for (int wi = 3; wi >= 0; --wi) { const unsigned x = xg[wi], hi = x >> 16, lo = x & 0xffffu;
            { const bool hit = (found < 0) && (cum + hi >= target); if (hit) { found = 2 * wi + 1; above = cum; binc = hi; } cum += (found < 0) ? hi : 0u; }
            { const bool hit = (found < 0) && (cum + lo >= target); if (hit) { found = 2 * wi; above = cum; binc = lo; } cum += (found < 0) ? lo : 0u; } }
        const bool okf = (fj >= 0) && (found >= 0);
        unsigned dm = (okf ? (unsigned)(8 * fj + found) : 0u) + 128u * hh, am = (okf ? above : 0u) + (hh ? 0u : U);
        const unsigned d_o = shx32u(dm), a_o = shx32u(am), b_o = shx32u(binc);
        const unsigned dig = mine ? dm : d_o, abv = mine ? am : a_o;
        bc = mine ? binc : b_o;
        krem -= abv; prefix = (prefix << 8) | dig; npass = pass + 1;
        return pass < 3 && __all(bc == krem || takeall);
    };
    early = hist_pass(0);
    if (!early && EXP != 3) early = hist_pass(1);
    const bool collect = !early && (EXP == 0 || EXP >= 10) && __all(bc <= (unsigned)DS_CAP || takeall);
    unsigned tau = 0u, rr = 0u;
    if (collect) {
        const unsigned klo = prefix << 16, khi = klo | 0xffffu;
        float flo = mono_inv(klo); const float fhi = mono_inv_hi(khi);
        if (flo != flo) flo = -__builtin_inff();
        __syncthreads();
        auto cbody = [&](auto allv_c, int kt, int k0, const float (&sc)[16]) {
            constexpr bool ALLV = decltype(allv_c)::value;
            unsigned gt = 0u;
#pragma unroll
            for (int i = 0; i < 16; ++i) {
                const bool valid = ALLV || (k0 + crow(i, hh)) <= tq;
                gt |= bitif(valid && (takeall || sc[i] > fhi), i);
                if (valid && !takeall && sc[i] >= flo && sc[i] <= fhi) {
                    const unsigned slot = __hip_atomic_fetch_add(ccnt_l + r, 1u, __ATOMIC_RELAXED, __HIP_MEMORY_SCOPE_WORKGROUP);
                    if (slot < (unsigned)DS_CAP) { cand[(r * DS_CAP + slot) * 2] = mono_key(sc[i]); cand[(r * DS_CAP + slot) * 2 + 1] = (unsigned)(kt * 1024 + lane * 16 + i); }
                }
            }
            mk[kt * 64 + lane] = gt;
        };
        ds_tile_pass<EXP>(kcol, kslice, qb, wave, lane, qi, w, [&](int kt, int k0, const float (&sc)[16]) {
            if (kt < qb) cbody(std::true_type{}, kt, k0, sc); else cbody(std::false_type{}, kt, k0, sc);
        });
        __syncthreads();
        {
            const int qq = wave * 4 + (lane >> 4), j16 = lane & 15;
            const unsigned need = (unsigned)__shfl((int)krem, qq & 31), tk = (unsigned)__shfl((int)(takeall ? 1u : 0u), qq & 31);
            const unsigned cnt = tk ? 0u : (ccnt_l[qq] < (unsigned)DS_CAP ? ccnt_l[qq] : (unsigned)DS_CAP);
            const LAS unsigned* cl = cand + qq * DS_CAP * 2;
            unsigned cmaxn = cnt;
#pragma unroll
            for (int o = 16; o < 64; o <<= 1) { const unsigned t2 = (unsigned)__shfl_xor((int)cmaxn, o); cmaxn = t2 > cmaxn ? t2 : cmaxn; }
            unsigned mykey[4], mypos[4], rank[4];
#pragma unroll
            for (int c = 0; c < 4; ++c) { const unsigned sidx = j16 + 16 * c; const bool have = sidx < cnt; mykey[c] = have ? cl[2 * sidx] : 0u; mypos[c] = have ? cl[2 * sidx + 1] : 0u; rank[c] = 0u; }
            for (unsigned j2 = 0; j2 < cmaxn; ++j2) {
                const bool in = j2 < cnt;
                const unsigned k2 = in ? cl[2 * j2] : 0u, p2 = in ? cl[2 * j2 + 1] : 0u;
                const unsigned i2 = (p2 >> 10) * 32u + (unsigned)crow((int)(p2 & 15u), (int)((p2 >> 9) & 1u));
#pragma unroll
                for (int c = 0; c < 4; ++c) { const unsigned ic = (mypos[c] >> 10) * 32u + (unsigned)crow((int)(mypos[c] & 15u), (int)((mypos[c] >> 9) & 1u));
                    rank[c] += (in && (k2 > mykey[c] || (k2 == mykey[c] && i2 < ic))) ? 1u : 0u; }
            }
#pragma unroll
            for (int c = 0; c < 4; ++c) { const unsigned sidx = j16 + 16 * c;
                if (sidx < cnt && rank[c] < need) __hip_atomic_fetch_or(mk + (mypos[c] >> 4), 1u << (mypos[c] & 15u), __ATOMIC_RELAXED, __HIP_MEMORY_SCOPE_WORKGROUP); }
        }
        __syncthreads();
        if (wave <= qb) for (int kt = wave; kt <= qb; kt += 8) mbp[(size_t)kt * 64] = (unsigned short)mk[kt * 64 + lane];
    } else {
        if (!early && EXP != 3) { early = hist_pass(2); if (!early) (void)hist_pass(3); }
        if (takeall) { tau = 0u; rr = 0xffffffffu; }
        else if (early) { tau = (prefix << (32 - 8 * npass)) - 1u; rr = 0u; }
        else { tau = prefix; rr = krem; }
        if (EXP != 0) { asm volatile("" :: "v"(tau), "v"(rr)); __syncthreads(); return; }
        const float tauf = mono_inv_hi(tau);
        __syncthreads();
        unsigned anyeq = 0u;
        ds_tile_pass<EXP>(kcol, kslice, qb, wave, lane, qi, w, [&](int kt, int k0, const float (&sc)[16]) {
            unsigned gt = 0u, eq = 0u;
#pragma unroll
            for (int i = 0; i < 16; ++i) { const bool valid = (k0 + crow(i, hh)) <= tq; gt |= bitif(valid && sc[i] > tauf, i); eq |= bitif(valid && sc[i] == tauf, i); }
            mbp[(size_t)kt * 64] = (unsigned short)gt;
            mk[kt * 64 + lane] = gt | (eq << 16);
            anyeq |= eq;
        });
        if (__any(anyeq != 0u && rr != 0u)) { if (lane == 0) __hip_atomic_fetch_or(tieflag, 1u, __ATOMIC_RELAXED, __HIP_MEMORY_SCOPE_WORKGROUP); }
        __syncthreads();
        if (*tieflag != 0u && wave == 0) {
            unsigned run = 0u;
            for (int kt = 0; kt <= qb; ++kt) {
                const unsigned wd = mk[kt * 64 + lane], gt = wd & 0xffffu, eq = wd >> 16;
                if (__any(eq != 0u)) {
                    unsigned cg[4], pk = 0u;
#pragma unroll
                    for (int g = 0; g < 4; ++g) { cg[g] = __builtin_popcount((eq >> (4 * g)) & 15u); pk |= cg[g] << (8 * g); }
                    const unsigned opk = shx32u(pk);
                    unsigned bs = run, bits = gt;
#pragma unroll
                    for (int g = 0; g < 4; ++g) {
                        const unsigned og = (opk >> (8 * g)) & 255u;
                        unsigned ord = bs + (hh ? og : 0u);
#pragma unroll
                        for (int e = 0; e < 4; ++e) { const int i = 4 * g + e; const unsigned ei = (eq >> i) & 1u; bits |= bitif(ei && ord < rr, i); ord += ei; }
                        bs += cg[g] + og;
                    }
                    run = bs;
                    mbp[(size_t)kt * 64] = (unsigned short)bits;
                    mk[kt * 64 + lane] = bits;
                } else mk[kt * 64 + lane] = gt;
            }
        }
    }
    __syncthreads();
    if (CHK) {
        unsigned cmin = 0xffffffffu, cmax = 0u, ccnt = 0u;
        asm volatile("s_waitcnt vmcnt(0)" ::: "memory");
        ds_tile_pass<EXP>(kcol, kslice, qb, wave, lane, qi, w, [&](int kt, int k0, const float (&sc)[16]) {
            const unsigned bits = (unsigned)__builtin_nontemporal_load(mbp + (size_t)kt * 64);
#pragma unroll
            for (int i = 0; i < 16; ++i) { const bool valid = (k0 + crow(i, hh)) <= tq; const unsigned uk = mono_key(sc[i]);
                if ((bits >> i) & 1u) cmin = uk < cmin ? uk : cmin; else if (valid) cmax = uk > cmax ? uk : cmax; }
            ccnt += __builtin_popcount(bits);
        });
        __hip_atomic_fetch_min(chk + 3 * r, cmin, __ATOMIC_RELAXED, __HIP_MEMORY_SCOPE_WORKGROUP); __hip_atomic_fetch_max(chk + 3 * r + 1, cmax, __ATOMIC_RELAXED, __HIP_MEMORY_SCOPE_WORKGROUP);
        __hip_atomic_fetch_add(chk + 3 * r + 2, ccnt, __ATOMIC_RELAXED, __HIP_MEMORY_SCOPE_WORKGROUP);
        __syncthreads();
        if (wave == 1 && hh == 0) { const unsigned want = (unsigned)((tq + 1) < 256 ? (tq + 1) : 256);
            const bool bad = (chk[3 * r + 2] != want) || (chk[3 * r] < chk[3 * r + 1]);
            if (bad) __hip_atomic_fetch_or((gu32*)P.ctl() + 2, 1u, RLX_AGENT); }
        __syncthreads();
    }
}
DI void dsa_mask_unit(const Bufs& P, int b, int qb, int lane, LAS unsigned char* kslice) {
    const int r = lane & 31, hh = lane >> 5, q0 = qb * 32, tq = q0 + r;
    const size_t row = (size_t)b * SQ + tq;
    bf16x8 qi[4][4];
#pragma unroll
    for (int hd = 0; hd < 4; ++hd) load_q(qi[hd], P.PA() + row * PAP + C_QI + hd * 64 + 8 * hh);
    float w[4]; { const f32x4 wv = *(const GAS f32x4*)(P.WG() + row * 16); w[0] = wv.x; w[1] = wv.y; w[2] = wv.z; w[3] = wv.w; }
    const unsigned tau = P.TAU()[row], rr = P.RR()[row];
    float tauf = mono_inv(tau); if (tauf != tauf) tauf = -__builtin_inff();
    unsigned run = 0u;
    const bf16_t* kcol = P.PA() + (size_t)b * SQ * PAP + C_KI;
    unsigned short* mb = P.MB() + ((size_t)(b * 128 + qb) * 128) * 64 + lane;
    u32x4 rg[4]; ktile_issue(rg, kcol, 0, lane); ktile_commit(kslice, rg, lane);
    for (int kt = 0; kt <= qb; ++kt) {
        const int k0 = kt * 32;
        bf16x8 kf[4]; ktile_frags(kf, kslice, lane);
        if (kt < qb) ktile_issue(rg, kcol, k0 + 32, lane);
        float sc[16]; idx_tile(sc, kf, qi, w);
        if (kt < qb) ktile_commit(kslice, rg, lane);
        unsigned gt = 0u, eq = 0u;
#pragma unroll
        for (int i = 0; i < 16; ++i) {
            const bool valid = (k0 + crow(i, hh)) <= tq;
            gt |= bitif(valid && sc[i] > tauf, i); eq |= bitif(valid && sc[i] == tauf, i);
        }
        unsigned bits = gt;
        if (__any(eq != 0u)) {
        unsigned cg[4], pk = 0u;
#pragma unroll
        for (int g = 0; g < 4; ++g) { cg[g] = __builtin_popcount((eq >> (4 * g)) & 15u); pk |= cg[g] << (8 * g); }
        const unsigned opk = shx32u(pk);
        unsigned base = run;
#pragma unroll
        for (int g = 0; g < 4; ++g) {
            const unsigned og = (opk >> (8 * g)) & 255u;
            unsigned ord = base + (hh ? og : 0u);
#pragma unroll
            for (int e = 0; e < 4; ++e) { const int i = 4 * g + e; const unsigned ei = (eq >> i) & 1u; bits |= bitif(ei && ord < rr, i); ord += ei; }
            base += cg[g] + og;
        }
        run = base;
        }
        mb[(size_t)kt * 64] = (unsigned short)bits;
    }
}
DI void dsa_attn_unit(const Bufs& P, int b, int h, int qb, int lane) {
    const int r = lane & 31, hh = lane >> 5, q0 = qb * 32;
    const size_t row = (size_t)b * SQ + q0 + r;
    bf16x8 qf[4]; load_q(qf, P.PA() + row * PAP + C_QB + h * 64 + 8 * hh);
    f32x16 o0 = zero16(), o1 = zero16(); float m = -1e30f, l = 0.f;
    const unsigned short* mb = P.MB() + ((size_t)(b * 128 + qb) * 128) * 64 + lane;
    auto mask = [&](int kt) -> unsigned { return (unsigned)mb[(size_t)kt * 64]; };
    attn_tiles<false>(o0, o1, m, l, qf, P.PA() + (size_t)b * SQ * PAP + C_KB, PAP, P.VBT() + (size_t)b * 64 * SQ, SQ, 0, qb, mask, r, hh);
    const float lt = l + shx32(l), inv = lt > 0.f ? 1.f / lt : 0.f;
    store_ot(P.O3() + row * 768 + 256 + h * 64, o0, o1, inv, hh);
}


template <int MODE>
DI void dsa_attn_probe(const Bufs& P, int b, int h, int qb, int lane) {
    const int r = lane & 31, hh = lane >> 5, q0 = qb * 32;
    const size_t row = (size_t)b * SQ + q0 + r;
    bf16x8 qf[4]; load_q(qf, P.PA() + row * PAP + C_QB + h * 64 + 8 * hh);
    f32x16 o0 = zero16(), o1 = zero16(); float m = -1e30f, l = 0.f;
    const unsigned short* mb = P.MB() + ((size_t)(b * 128 + qb) * 128) * 64 + lane;
    const bf16_t* kl = P.PA() + (size_t)b * SQ * PAP + C_KB + (size_t)r * PAP + 8 * hh; const bf16_t* vl = P.VBT() + (size_t)b * 64 * SQ + (size_t)r * SQ + 4 * hh;
    if (MODE == 1) {
        bf16x8 acc = qf[0];
        for (int kt = 0; kt <= qb; ++kt) { KV t; load_kv(t, kl + (size_t)(kt * 32) * PAP, vl + kt * 32, SQ); const unsigned vm = mb[(size_t)kt * 64];
#pragma unroll
            for (int j = 0; j < 4; ++j) acc = acc ^ t.k[j] ^ t.v[j]; acc[0] ^= (short)vm; }
        o0[0] = (float)acc[0] + (float)acc[1] + (float)acc[2] + (float)acc[3] + (float)acc[4] + (float)acc[5] + (float)acc[6] + (float)acc[7];
    } else {
        auto mask = [&](int kt) -> unsigned { return (unsigned)mb[0]; };
        attn_tiles<false>(o0, o1, m, l, qf, P.PA() + (size_t)b * SQ * PAP + C_KB, 0, P.VBT() + (size_t)b * 64 * SQ, SQ, 0, qb, mask, r, hh);
    }
    const float lt = l + shx32(l), inv = lt > 0.f ? 1.f / lt : 0.f;
    store_ot((bf16_t*)P.out() + row * 768 + 256 + h * 64, o0, o1, inv, hh);
}
template <int CHK = 0> DI void nsa_cmp_unit(const Bufs& P, int b, int qb, int lane, LAS float* impl) {
    const int r = lane & 31, hh = lane >> 5, q0 = qb * 32, tq = q0 + r;
    const size_t row = (size_t)b * SQ + tq;
    const bf16_t* kcb = P.KC() + (size_t)b * 256 * 64 + 8 * hh;
    const bf16_t* vcb = P.VCT() + ((size_t)b * 64 + r) * 256 + 4 * hh;
    const int cmax = (tq >= 31) ? ((tq - 31) >> 4) : -1;
    const int ctile_hi = qb >> 4;
    LAS float* imp = impl + lane;
#pragma unroll
    for (int a = 0; a < 32; ++a) imp[64 * a] = 0.f;
    for (int h = 0; h < 4; ++h) {
        bf16x8 qf[4]; load_q(qf, P.PA() + row * PAP + C_QC + h * 64 + 8 * hh);
        float m = -1e30f, l = 0.f;
        for (int kt = 0; kt <= ctile_hi; ++kt) {
            const int k0 = kt * 32;
            const f32x16 z = qk_tile(kcb + (size_t)(k0 + r) * 64, qf);
            float tm = -1e30f;
#pragma unroll
            for (int i = 0; i < 16; ++i) tm = ((k0 + crow(i, hh)) <= cmax) ? fmaxf(tm, z[i]) : tm;
            tm = fmaxf(tm, shx32(tm));
            const float mn = fmaxf(m, tm); float ls = 0.f;
#pragma unroll
            for (int i = 0; i < 16; ++i) ls += ((k0 + crow(i, hh)) <= cmax) ? fexp2(z[i] - mn) : 0.f;
            l = l * fexp2(m - mn) + ls; m = mn;
        }
        const float lt = l + shx32(l), inv = lt > 0.f ? 1.f / lt : 0.f;
        f32x16 o0 = zero16(), o1 = zero16();
        float carry = 0.f;
        for (int kt = 0; kt <= ctile_hi; ++kt) {
            const int k0 = kt * 32;
            f32x16 z = qk_tile(kcb + (size_t)(k0 + r) * 64, qf);
#pragma unroll
            for (int i = 0; i < 16; ++i) z[i] = ((k0 + crow(i, hh)) <= cmax) ? fexp2(z[i] - m) * inv : 0.f;
            float px[4];
#pragma unroll
            for (int g = 0; g < 4; ++g) px[g] = shx32(z[4 * g + 3]);
#pragma unroll
            for (int g = 0; g < 4; ++g) {
                const float G = (z[4 * g] + z[4 * g + 1]) + (z[4 * g + 2] + z[4 * g + 3]);
                const float prev = hh ? px[g] : (g == 0 ? carry : px[g - 1]);
                imp[64 * (4 * kt + g)] += G + prev;
            }
            carry = px[3];
            pv_tile(o0, o1, vcb + k0, 256, z);
        }
        const float gate = P.WG()[row * 16 + 4 + h * 3 + 0];
        store_ot(P.O3() + row * 768 + 512 + h * 64, o0, o1, gate, hh);
    }
    const int cur = tq >> 6;
    unsigned own = 0u;
    unsigned cand = 0u;
#pragma unroll
    for (int a = 0; a < 32; ++a) { const int j = 2 * a + hh; const bool adm = j <= cur, forced = (j == 0) || (j == cur) || (j == cur - 1);
        own |= bitif(adm && (forced || cur < 16), a); cand |= bitif(adm && !forced, a); }
    if (__any(cur >= 16)) {
        float iv[32];
#pragma unroll
        for (int a = 0; a < 32; ++a) iv[a] = imp[64 * a];
        for (int it = 0; it < 13; ++it) {
            float bv = -1e30f; int ba = 64;
#pragma unroll
            for (int a = 0; a < 32; ++a) { const bool c = (cand >> a) & 1u; if (c && iv[a] > bv) { bv = iv[a]; ba = a; } }
            const float pv_ = shx32(bv); const int pa = __shfl_xor(ba, 32);
            const int jo = 2 * ba + hh, jp = 2 * pa + (1 - hh);
            const bool win = (ba < 64) && ((pa >= 64) || (bv > pv_) || (bv == pv_ && jo < jp));
            const unsigned wb = (win ? 1u : 0u) << (ba & 31);
            if (cur >= 16) own |= wb;
            cand &= ~wb;
        }
    }
    if (CHK) {
        float smin = 1e30f, umax = -1e30f; int sj = -1, uj = 999;
#pragma unroll
        for (int a = 0; a < 32; ++a) { const int j = 2 * a + hh; const bool adm = j <= cur, forced = (j == 0) || (j == cur) || (j == cur - 1); const float v = imp[64 * a];
            if (adm && !forced) { if ((own >> a) & 1u) { if (v < smin || (v == smin && j > sj)) { smin = v; sj = j; } } else { if (v > umax || (v == umax && j < uj)) { umax = v; uj = j; } } } }
        const float psmin = shx32(smin), pumax = shx32(umax); const int psj = __shfl_xor(sj, 32), puj = __shfl_xor(uj, 32);
        if (psmin < smin || (psmin == smin && psj > sj)) { smin = psmin; sj = psj; }
        if (pumax > umax || (pumax == umax && puj < uj)) { umax = pumax; uj = puj; }
        const unsigned both = __builtin_popcount(own) + __builtin_popcount(shx32u(own));
        const unsigned want = (unsigned)(cur + 1 < 16 ? cur + 1 : 16);
        bool bad = both != want;
        if (sj >= 0 && uj < 999 && (umax > smin || (umax == smin && uj < sj))) bad = true;
        { const int j0 = 0, j1 = cur, j2 = cur - 1; const unsigned oo = shx32u(own);
          auto has = [&](int j) -> bool { if (j < 0) return true; const unsigned msk = ((j & 1) == hh) ? own : oo; return (msk >> (j >> 1)) & 1u; };
          if (!has(j0) || !has(j1) || !has(j2)) bad = true; }
        if (bad) __hip_atomic_fetch_or((gu32*)P.ctl() + 2, 2u, RLX_AGENT);
    }
    const unsigned oth = shx32u(own);
    if (hh == 0) {
        unsigned long long bm = 0ull;
#pragma unroll
        for (int a = 0; a < 32; ++a) { bm |= (unsigned long long)((own >> a) & 1u) << (2 * a); bm |= (unsigned long long)((oth >> a) & 1u) << (2 * a + 1); }
        P.BM()[row] = bm;
    }
}
DI void nsa_selwin_unit(const Bufs& P, int b, int h, int qb, int lane, bf16_t* obase) {
    const int r = lane & 31, hh = lane >> 5, q0 = qb * 32, tq = q0 + r;
    const size_t row = (size_t)b * SQ + tq;
    bf16x8 qf[4]; load_q(qf, P.PA() + row * PAP + C_QC + h * 64 + 8 * hh);
    const unsigned long long bm = P.BM()[row];
    f32x16 a0 = zero16(), a1 = zero16();
    {
        f32x16 o0 = zero16(), o1 = zero16(); float m = -1e30f, l = 0.f;
        auto mask = [&](int kt) -> unsigned {
            if (!((bm >> (kt >> 1)) & 1ull)) return 0u;
            unsigned v = 0u;
#pragma unroll
            for (int i = 0; i < 16; ++i) v |= bitif((kt * 32 + crow(i, hh)) <= tq, i);
            return v; };
        attn_tiles<true>(o0, o1, m, l, qf, P.PA() + (size_t)b * SQ * PAP + C_KSEL, PAP, P.VST() + (size_t)b * 64 * SQ, SQ, 0, qb, mask, r, hh);
        const float lt = l + shx32(l), g = (lt > 0.f ? 1.f / lt : 0.f) * P.WG()[row * 16 + 4 + h * 3 + 1];
#pragma unroll
        for (int i = 0; i < 16; ++i) { a0[i] = o0[i] * g; a1[i] = o1[i] * g; }
    }
    {
        f32x16 o0 = zero16(), o1 = zero16(); float m = -1e30f, l = 0.f;
        auto mask = [&](int kt) -> unsigned {
            unsigned v = 0u;
#pragma unroll
            for (int i = 0; i < 16; ++i) { const int key = kt * 32 + crow(i, hh); v |= bitif(key <= tq && key > tq - 512, i); }
            return v; };
        const int lo = (q0 - 511) > 0 ? ((q0 - 511) >> 5) : 0;
        attn_tiles<false>(o0, o1, m, l, qf, P.PA() + (size_t)b * SQ * PAP + C_KWIN, PAP, P.VWT() + (size_t)b * 64 * SQ, SQ, lo, qb, mask, r, hh);
        const float lt = l + shx32(l), g = (lt > 0.f ? 1.f / lt : 0.f) * P.WG()[row * 16 + 4 + h * 3 + 2];
#pragma unroll
        for (int i = 0; i < 16; ++i) { a0[i] += o0[i] * g; a1[i] += o1[i] * g; }
    }
    bf16_t* orow = obase + row * 768 + 512 + h * 64;
#pragma unroll
    for (int g = 0; g < 4; ++g) {
        const u32x2 c0 = *(const GAS u32x2*)(orow + 8 * g + 4 * hh), c1 = *(const GAS u32x2*)(orow + 32 + 8 * g + 4 * hh);
        a0[4 * g] += bflo(c0.x); a0[4 * g + 1] += bfhi(c0.x); a0[4 * g + 2] += bflo(c0.y); a0[4 * g + 3] += bfhi(c0.y);
        a1[4 * g] += bflo(c1.x); a1[4 * g + 1] += bfhi(c1.x); a1[4 * g + 2] += bflo(c1.y); a1[4 * g + 3] += bfhi(c1.y);
    }
    store_ot(orow, a0, a1, 1.f, hh);
}

constexpr int AW_KP = 144, AW_VP = 136, AW_KB = 64 * AW_KP, AW_BUF = AW_KB + 64 * AW_VP;
template <int KIND  , int EXP = 0>
DI void attn_wg(f32x16& o0, f32x16& o1, float& m, float& l, const bf16x8 (&qf)[4], const bf16_t* kglob  , const bf16_t* vtglob  ,
                int st_lo, int st_hi, int tq, int kt32_base_unused, const unsigned short* mb  , unsigned long long bm, int lane, int tid, LAS unsigned char* lds) {
    (void)kt32_base_unused;
    const int r = lane & 31, hh = lane >> 5;
    const int srow = tid >> 3, sch = tid & 7;
    const bf16_t* kg = kglob + (size_t)srow * PAP + sch * 8; const bf16_t* vg = vtglob + (size_t)srow * SQ + sch * 8;
    LAS unsigned char* const kw = lds + srow * AW_KP + sch * 16; LAS unsigned char* const vw = lds + AW_KB + srow * AW_VP + sch * 16;
    const int kro = r * AW_KP + hh * 16, vro = AW_KB + r * AW_VP + hh * 8;
    if (st_lo > st_hi) return;
    u32x4 kr = *(const GAS u32x4*)(kg + (size_t)(st_lo * 64) * PAP), vr = *(const GAS u32x4*)(vg + st_lo * 64);
    unsigned mw0 = 0u, mw1 = 0u;
    if (KIND == 0) { mw0 = mb[(size_t)(2 * st_lo) * 64]; mw1 = mb[(size_t)(2 * st_lo + 1) * 64]; }
    *(LAS u32x4*)kw = kr; *(LAS u32x2*)vw = (u32x2){vr.x, vr.y}; *(LAS u32x2*)(vw + 8) = (u32x2){vr.z, vr.w};
    __syncthreads();
    for (int st = st_lo; st <= st_hi; ++st) {
        LAS unsigned char* const buf = lds + ((st - st_lo) & 1) * AW_BUF;
        const bool more = st < st_hi;
        unsigned nw0 = 0u, nw1 = 0u;
        if (more) { if (EXP != 3) { kr = *(const GAS u32x4*)(kg + (size_t)((st + 1) * 64) * PAP); vr = *(const GAS u32x4*)(vg + (st + 1) * 64); }
            if (KIND == 0) { nw0 = mb[(size_t)(2 * st + 2) * 64]; nw1 = mb[(size_t)(2 * st + 3) * 64]; } }
        const float meff0 = sm_meff(m);
        auto prep = [&](int j, f32x16& z) -> bool {
            const int k0 = st * 64 + j * 32, q0w = tq - r;
            unsigned vm = 0xffffu; int mode;
            bool lanesel = true;
            if (KIND == 0) { vm = (2 * st + j <= (tq >> 5)) ? (j ? mw1 : mw0) : 0u; mode = 0; }
            else if (KIND == 1) {
                lanesel = ((bm >> st) & 1ull) != 0ull;
                if (k0 + 31 <= q0w) { mode = 2; vm = lanesel ? 0xffffu : 0u; }
                else { mode = 0; vm = lanesel ? le_mask(tq - k0, hh) : 0u; }
            } else {
                if (k0 + 31 <= q0w && k0 > q0w + 31 - 512) mode = 1;
                else { mode = 0; vm = le_mask(tq - k0, hh) & ~le_mask(tq - 512 - k0, hh); }
            }
            if (!__any(vm != 0u)) return false;
            bf16x8 kf[4];
#pragma unroll
            for (int s2 = 0; s2 < 4; ++s2) kf[s2] = *(const LAS bf16x8*)(buf + kro + j * 32 * AW_KP + s2 * 32);
            const float nme = -meff0, ninf = -__builtin_inff();
            if (mode != 0) {
                const float v = (mode == 1 || lanesel) ? nme : ninf;
                z = qk_frag(kf, qf);
#pragma unroll
                for (int i = 0; i < 16; i += 2) { f32x2 t = {z[i], z[i + 1]}; t += (f32x2){v, v}; z[i] = t.x; z[i + 1] = t.y; }
            } else {
                f32x16 init;
                const unsigned nb = __builtin_bit_cast(unsigned, nme), ib = __builtin_bit_cast(unsigned, ninf);
                unsigned t0, t1, t2, t3, t4, t5, t6, t7, t8, t9, t10, t11, t12, t13, t14, t15;
                asm("v_bfe_i32 %0, %16, 0, 1\n\tv_bfe_i32 %1, %16, 1, 1\n\tv_bfe_i32 %2, %16, 2, 1\n\tv_bfe_i32 %3, %16, 3, 1\n\t"
                    "v_bfe_i32 %4, %16, 4, 1\n\tv_bfe_i32 %5, %16, 5, 1\n\tv_bfe_i32 %6, %16, 6, 1\n\tv_bfe_i32 %7, %16, 7, 1\n\t"
                    "v_bfe_i32 %8, %16, 8, 1\n\tv_bfe_i32 %9, %16, 9, 1\n\tv_bfe_i32 %10, %16, 10, 1\n\tv_bfe_i32 %11, %16, 11, 1\n\t"
                    "v_bfe_i32 %12, %16, 12, 1\n\tv_bfe_i32 %13, %16, 13, 1\n\tv_bfe_i32 %14, %16, 14, 1\n\tv_bfe_i32 %15, %16, 15, 1\n\t"
                    "v_bfi_b32 %0, %0, %17, %18\n\tv_bfi_b32 %1, %1, %17, %18\n\tv_bfi_b32 %2, %2, %17, %18\n\tv_bfi_b32 %3, %3, %17, %18\n\t"
                    "v_bfi_b32 %4, %4, %17, %18\n\tv_bfi_b32 %5, %5, %17, %18\n\tv_bfi_b32 %6, %6, %17, %18\n\tv_bfi_b32 %7, %7, %17, %18\n\t"
                    "v_bfi_b32 %8, %8, %17, %18\n\tv_bfi_b32 %9, %9, %17, %18\n\tv_bfi_b32 %10, %10, %17, %18\n\tv_bfi_b32 %11, %11, %17, %18\n\t"
                    "v_bfi_b32 %12, %12, %17, %18\n\tv_bfi_b32 %13, %13, %17, %18\n\tv_bfi_b32 %14, %14, %17, %18\n\tv_bfi_b32 %15, %15, %17, %18\n\ts_nop 1"
                    : "=&v"(t0), "=&v"(t1), "=&v"(t2), "=&v"(t3), "=&v"(t4), "=&v"(t5), "=&v"(t6), "=&v"(t7), "=&v"(t8), "=&v"(t9), "=&v"(t10), "=&v"(t11), "=&v"(t12), "=&v"(t13), "=&v"(t14), "=&v"(t15)
                    : "v"(vm), "v"(nb), "v"(ib));
                init[0] = __builtin_bit_cast(float, t0); init[1] = __builtin_bit_cast(float, t1); init[2] = __builtin_bit_cast(float, t2); init[3] = __builtin_bit_cast(float, t3);
                init[4] = __builtin_bit_cast(float, t4); init[5] = __builtin_bit_cast(float, t5); init[6] = __builtin_bit_cast(float, t6); init[7] = __builtin_bit_cast(float, t7);
                init[8] = __builtin_bit_cast(float, t8); init[9] = __builtin_bit_cast(float, t9); init[10] = __builtin_bit_cast(float, t10); init[11] = __builtin_bit_cast(float, t11);
                init[12] = __builtin_bit_cast(float, t12); init[13] = __builtin_bit_cast(float, t13); init[14] = __builtin_bit_cast(float, t14); init[15] = __builtin_bit_cast(float, t15);
                if (EXP == 2) { _Pragma("unroll") for (int i = 0; i < 16; ++i) z[i] = __builtin_bit_cast(float, (int)kf[i & 3][i >> 2] << 16) + init[i]; } else z = qk_frag_init(kf, qf, init);
            }
            return true;
        };
        auto finish = [&](int j, f32x16& z) {
            if (EXP == 1) { asm volatile("" :: "v"(z)); } else softmax_core(z, m, l, o0, o1);
            bf16x8 vf[4];
#pragma unroll
            for (int s2 = 0; s2 < 2; ++s2) {
#pragma unroll
                for (int db = 0; db < 2; ++db) {
                    const LAS unsigned char* vp = buf + vro + db * 32 * AW_VP + (j * 32 + 16 * s2) * 2;
                    const s16x4 lo = *(const LAS s16x4*)vp, hi = *(const LAS s16x4*)(vp + 16);
                    vf[2 * s2 + db] = __builtin_shufflevector(lo, hi, 0, 1, 2, 3, 4, 5, 6, 7);
                }
            }
            if (EXP == 2) { _Pragma("unroll") for (int i = 0; i < 16; ++i) { o0[i] += z[i] + __builtin_bit_cast(float, (int)vf[i & 3][i >> 2] << 16); } } else pv_frag(o0, o1, vf, z);
        };
        f32x16 zA, zB;
        const bool actA = prep(0, zA), actB = prep(1, zB);
        if (actA) finish(0, zA);
        if (actB) {
            const float d = sm_meff(m) - meff0;
            if (__any(d != 0.f)) {
#pragma unroll
                for (int i = 0; i < 16; ++i) zB[i] -= d; }
            finish(1, zB);
        }
        if (more) {
            const int off = ((st - st_lo + 1) & 1) * AW_BUF;
            *(LAS u32x4*)(kw + off) = kr; *(LAS u32x2*)(vw + off) = (u32x2){vr.x, vr.y}; *(LAS u32x2*)(vw + off + 8) = (u32x2){vr.z, vr.w};
            mw0 = nw0; mw1 = nw1;
        }
        __syncthreads();
    }
}
template <int EXP = 0> DI void dsa_attn_wg(const Bufs& P, int b, int qb64, int lane, int wave, int tid, LAS unsigned char* lds) {
    const int r = lane & 31, hh = lane >> 5, sub = wave >> 2, h = wave & 3, qb = 2 * qb64 + sub, tq = qb * 32 + r;
    const size_t row = (size_t)b * SQ + tq;
    bf16x8 qf[4]; load_q(qf, P.PA() + row * PAP + C_QB + h * 64 + 8 * hh);
    f32x16 o0 = zero16(), o1 = zero16(); float m = -1e30f, l = 0.f;
    const unsigned short* mb = P.MB() + ((size_t)(b * 128 + qb) * 128) * 64 + lane;
    attn_wg<0, EXP>(o0, o1, m, l, qf, P.PA() + (size_t)b * SQ * PAP + C_KB, P.VBT() + (size_t)b * 64 * SQ, 0, qb64, tq, 0, mb, 0ull, lane, tid, lds);
    const float lt = l + shx32(l), inv = lt > 0.f ? 1.f / lt : 0.f;
    store_ot((EXP ? (bf16_t*)P.out() : P.O3()) + row * 768 + 256 + h * 64, o0, o1, inv, hh);
}
DI void nsa_selwin_wg(const Bufs& P, int b, int qb64, int lane, int wave, int tid, LAS unsigned char* lds, bf16_t* obase) {
    const int r = lane & 31, hh = lane >> 5, sub = wave >> 2, h = wave & 3, qb = 2 * qb64 + sub, tq = qb * 32 + r;
    const size_t row = (size_t)b * SQ + tq;
    bf16x8 qf[4]; load_q(qf, P.PA() + row * PAP + C_QC + h * 64 + 8 * hh);
    const unsigned long long bm = P.BM()[row];
    f32x16 a0 = zero16(), a1 = zero16();
    {
        f32x16 o0 = zero16(), o1 = zero16(); float m = -1e30f, l = 0.f;
        attn_wg<1>(o0, o1, m, l, qf, P.PA() + (size_t)b * SQ * PAP + C_KSEL, P.VST() + (size_t)b * 64 * SQ, 0, qb64, tq, 0, nullptr, bm, lane, tid, lds);
        const float lt = l + shx32(l), g = (lt > 0.f ? 1.f / lt : 0.f) * P.WG()[row * 16 + 4 + h * 3 + 1];
#pragma unroll
        for (int i = 0; i < 16; ++i) { a0[i] = o0[i] * g; a1[i] = o1[i] * g; }
    }
    {
        f32x16 o0 = zero16(), o1 = zero16(); float m = -1e30f, l = 0.f;
        const int lo = (qb64 * 64 - 511) > 0 ? ((qb64 * 64 - 511) >> 6) : 0;
        attn_wg<2>(o0, o1, m, l, qf, P.PA() + (size_t)b * SQ * PAP + C_KWIN, P.VWT() + (size_t)b * 64 * SQ, lo, qb64, tq, 0, nullptr, 0ull, lane, tid, lds);
        const float lt = l + shx32(l), g = (lt > 0.f ? 1.f / lt : 0.f) * P.WG()[row * 16 + 4 + h * 3 + 2];
#pragma unroll
        for (int i = 0; i < 16; ++i) { a0[i] += o0[i] * g; a1[i] += o1[i] * g; }
    }
    bf16_t* orow = obase + row * 768 + 512 + h * 64;
#pragma unroll
    for (int g = 0; g < 4; ++g) {
        const u32x2 c0 = *(const GAS u32x2*)(orow + 8 * g + 4 * hh), c1 = *(const GAS u32x2*)(orow + 32 + 8 * g + 4 * hh);
        a0[4 * g] += bflo(c0.x); a0[4 * g + 1] += bfhi(c0.x); a0[4 * g + 2] += bflo(c0.y); a0[4 * g + 3] += bfhi(c0.y);
        a1[4 * g] += bflo(c1.x); a1[4 * g + 1] += bfhi(c1.x); a1[4 * g + 2] += bflo(c1.y); a1[4 * g + 3] += bfhi(c1.y);
    }
    store_ot(orow, a0, a1, 1.f, hh);
}
constexpr int MW_KP = 144, MW_VP = 520, MW_VOFF = 256 * MW_KP;
DI void mem_attn_wg(const Bufs& P, int l_, int b, int h, int qc, int lane, int wave, int tid, LAS unsigned char* lds) {
    const int r = lane & 31, hh = lane >> 5;
    const size_t row = (size_t)b * SQ + qc * 256 + wave * 32 + r;
    bf16x8 qf[4]; load_q(qf, P.QM() + row * 256 + h * 64 + 8 * hh);
    const bf16_t* kg = P.KMEM() + ((size_t)l_ * 2048 + (size_t)b * 256) * 256 + h * 64;
    const bf16_t* vg = P.VMEMT() + ((size_t)l_ * 32 + b * 4 + h) * 64 * 256;
#pragma unroll
    for (int i = 0; i < 4; ++i) { const int c = tid + 512 * i;
        { const int kr = c >> 3, ch = c & 7; *(LAS u32x4*)(lds + kr * MW_KP + ch * 16) = *(const GAS u32x4*)(kg + (size_t)kr * 256 + ch * 8); }
        { const int d = c >> 5, ch = c & 31; const u32x4 v = *(const GAS u32x4*)(vg + (size_t)d * 256 + ch * 8); LAS unsigned char* p = lds + MW_VOFF + d * MW_VP + ch * 16;
          *(LAS u32x2*)p = (u32x2){v.x, v.y}; *(LAS u32x2*)(p + 8) = (u32x2){v.z, v.w}; } }
    __syncthreads();
    f32x16 o0 = zero16(), o1 = zero16(); float m = -1e30f, l = 0.f;
    const LAS unsigned char* kl = lds + r * MW_KP + hh * 16; const LAS unsigned char* vl = lds + MW_VOFF + r * MW_VP + hh * 8;
    for (int kt = 0; kt < 8; ++kt) {
        bf16x8 kf[4];
#pragma unroll
        for (int s2 = 0; s2 < 4; ++s2) kf[s2] = *(const LAS bf16x8*)(kl + kt * 32 * MW_KP + s2 * 32);
        f32x16 z = qk_frag(kf, qf);
        softmax_step<false>(z, 0xffffu, m, l, o0, o1);
        bf16x8 vf[4];
#pragma unroll
        for (int s2 = 0; s2 < 2; ++s2) {
#pragma unroll
            for (int db = 0; db < 2; ++db) { const LAS unsigned char* vp = vl + db * 32 * MW_VP + (kt * 32 + 16 * s2) * 2;
                const s16x4 lo = *(const LAS s16x4*)vp, hi = *(const LAS s16x4*)(vp + 16); vf[2 * s2 + db] = __builtin_shufflevector(lo, hi, 0, 1, 2, 3, 4, 5, 6, 7); } }
        pv_frag(o0, o1, vf, z);
    }
    const float lt = l + shx32(l), inv = lt > 0.f ? 1.f / lt : 0.f;
    store_ot(P.OM() + row * 256 + h * 64, o0, o1, inv, hh);
    __syncthreads();
}
DI void mem_attn_unit(const Bufs& P, int l_, int b, int h, int qb, int lane) {
    const int r = lane & 31, hh = lane >> 5;
    const size_t row = (size_t)b * SQ + qb * 32 + r;
    bf16x8 qf[4]; load_q(qf, P.QM() + row * 256 + h * 64 + 8 * hh);
    f32x16 o0 = zero16(), o1 = zero16(); float m = -1e30f, l = 0.f;
    auto mask = [&](int) -> unsigned { return 0xffffu; };
    attn_tiles<false>(o0, o1, m, l, qf, P.KMEM() + ((size_t)l_ * 2048 + (size_t)b * 256) * 256 + h * 64, 256, P.VMEMT() + ((size_t)l_ * 32 + b * 4 + h) * 64 * 256, 256, 0, 7, mask, r, hh);
    const float lt = l + shx32(l), inv = lt > 0.f ? 1.f / lt : 0.f;
    store_ot(P.OM() + row * 256 + h * 64, o0, o1, inv, hh);
}
DI void st8(bf16_t* p, const f32x4& a, const f32x4& b) { u32x4 w; w.x = cvtpk(a[0], a[1]); w.y = cvtpk(a[2], a[3]); w.z = cvtpk(b[0], b[1]); w.w = cvtpk(b[2], b[3]); *(GAS u32x4*)p = w; }
DI void st8nt(bf16_t* p, const f32x4& a, const f32x4& b) { u32x4 w; w.x = cvtpk(a[0], a[1]); w.y = cvtpk(a[2], a[3]); w.z = cvtpk(b[0], b[1]); w.w = cvtpk(b[2], b[3]); __builtin_nontemporal_store(w, (GAS u32x4*)p); }
DI float sigm(float x) { return __builtin_amdgcn_rcpf(1.f + fexp2(-x * LOG2E)); }
DI float rs_of(float ssq) { return __builtin_amdgcn_rsqf(ssq * (1.f / 1024.f) + RMS_EPS); }
DI float rs_of(ssq_t v) { return rs_of((float)v * (1.f / SSQ_SCALE)); }
DI void ss_add(ssq_t* p, float q) { __hip_atomic_fetch_add(p, (ssq_t)(q * SSQ_SCALE), __ATOMIC_RELAXED, __HIP_MEMORY_SCOPE_AGENT); }

struct EpiIn {
    static constexpr bool PERM = true;
    const ssq_t* ss; Bufs P; LAS unsigned char* scr;
    DI void operator()(const f32x4 (&acc)[2][2][4][2], const pg8::Unit& u, int wr, int wc, int fr0, int fq0) const {
        int fr = fr0, fq = fq0; asm volatile("" : "+v"(fr), "+v"(fq));
        const int pn = u.pn, b = u.pm >> 4;
        float rsv[8];
#pragma unroll
        for (int i = 0; i < 8; ++i) rsv[i] = rs_of(ss[u.pm * 256 + (i >> 2) * 128 + wr * 64 + (i & 3) * 16 + fr]);
#pragma unroll
        for (int bj = 0; bj < 2; ++bj) {
            const int cl = bj * 128 + wc * 32 + fq * 8, g = cl >> 6, e = cl & 63;
            int mode = 5; float scale = 1.f; bf16_t* dst = nullptr; size_t pitch = 0;
            if (pn == 0) { mode = 0; scale = 0.125f; dst = P.PA() + C_QA + cl; pitch = PAP; }
            else if (pn == 1) { mode = 0; dst = P.PA() + C_KA + cl; pitch = PAP; }
            else if (pn == 2) { mode = 2; dst = P.VAT() + ((size_t)(b * 4 + g) * 64 + e) * SQ; }
            else if (pn == 3) { mode = 1; scale = C2; dst = P.PA() + C_QB + cl; pitch = PAP; }
            else if (pn == 4) { mode = 1; dst = P.PA() + C_QI + cl; pitch = PAP; }
            else if (pn == 5) { mode = 1; scale = C2; dst = P.PA() + C_QC + cl; pitch = PAP; }
            else if (pn == 6) { mode = 1;
                if (g == 0) { dst = P.PA() + C_KB + e; pitch = PAP; } else if (g == 1) { dst = P.PA() + C_KI + e; pitch = PAP; }
                else if (g == 2) { dst = P.KCMP() + e; pitch = 64; } else { dst = P.PA() + C_KSEL + e; pitch = PAP; } }
            else if (pn == 7) {
                if (g == 0) { mode = 1; dst = P.PA() + C_KWIN + e; pitch = PAP; } else if (g == 1) { mode = 0; dst = P.VCMP() + e; pitch = 64; }
                else if (g == 2) { mode = (e < 16) ? 4 : 5; } else mode = 5; }
            else if (pn == 8) { mode = 2; if (g == 0) dst = P.VBT() + ((size_t)b * 64 + e) * SQ; else if (g == 1) dst = P.VST() + ((size_t)b * 64 + e) * SQ; else if (g == 2) dst = P.VWT() + ((size_t)b * 64 + e) * SQ; else mode = 5; }
            else { mode = 3; }
#pragma unroll
            for (int ai = 0; ai < 2; ++ai) {
                f32x4 c01s[4], c23s[4];
                if (mode == 1) {
#pragma unroll
                    for (int m = 0; m < 4; ++m) { const int t = (u.pm * 256 + ai * 128 + wr * 64 + m * 16 + fr) & (SQ - 1);
                        const f32x4* cs = (const f32x4*)(P.rope() + (size_t)t * 32 + (e >> 1)); c01s[m] = *(const GAS f32x4*)cs; c23s[m] = *(const GAS f32x4*)(cs + 1); }
                }
#pragma unroll
                for (int m = 0; m < 4; ++m) {
                    const int row = u.pm * 256 + ai * 128 + wr * 64 + m * 16 + fr;
                    const float rs = rsv[ai * 4 + m];
                    const int t = row & (SQ - 1);
                    const f32x4 v0 = acc[ai][bj][m][0] * rs, v1 = acc[ai][bj][m][1] * rs;
                    if (mode == 0) { st8(dst + (size_t)row * pitch, v0 * scale, v1 * scale); }
                    else if (mode == 1) {
                        const f32x4 c01 = c01s[m], c23 = c23s[m];
                        f32x4 r0, r1;
                        r0[0] = v0[0] * c01[0] - v0[1] * c01[1]; r0[1] = v0[1] * c01[0] + v0[0] * c01[1];
                        r0[2] = v0[2] * c01[2] - v0[3] * c01[3]; r0[3] = v0[3] * c01[2] + v0[2] * c01[3];
                        r1[0] = v1[0] * c23[0] - v1[1] * c23[1]; r1[1] = v1[1] * c23[0] + v1[0] * c23[1];
                        r1[2] = v1[2] * c23[2] - v1[3] * c23[3]; r1[3] = v1[3] * c23[2] + v1[2] * c23[3];
                        st8(dst + (size_t)row * pitch, r0 * scale, r1 * scale);
                    } else if (mode == 2) {
                        const unsigned w0 = cvtpk(v0[0], v0[1]), w1 = cvtpk(v0[2], v0[3]), w2 = cvtpk(v1[0], v1[1]), w3 = cvtpk(v1[2], v1[3]);
                        LAS unsigned short* sw = (LAS unsigned short*)(scr + (wr * 4 + wc) * 1024) + (fq * 8) * 16 + fr;
                        sw[0] = (unsigned short)w0; sw[16] = (unsigned short)(w0 >> 16); sw[32] = (unsigned short)w1; sw[48] = (unsigned short)(w1 >> 16);
                        sw[64] = (unsigned short)w2; sw[80] = (unsigned short)(w2 >> 16); sw[96] = (unsigned short)w3; sw[112] = (unsigned short)(w3 >> 16);
                        const int ln = fq * 16 + fr, dd = ln >> 1, hf = ln & 1;
                        const u32x4 tv = *(LAS u32x4*)(scr + (wr * 4 + wc) * 1024 + dd * 32 + hf * 16);
                        const int trow0 = (row - fr) & (SQ - 1);
                        *(GAS u32x4*)(dst + (ptrdiff_t)(dd - fq * 8) * SQ + trow0 + hf * 8) = tv;
                    } else if (mode == 3) {
                        unsigned q0 = 0u, q1 = 0u;
#pragma unroll
                        for (int j = 0; j < 4; ++j) { q0 |= (unsigned)(sigm(v0[j]) * 255.f + 0.5f) << (8 * j); q1 |= (unsigned)(sigm(v1[j]) * 255.f + 0.5f) << (8 * j); }
                        __builtin_nontemporal_store((u32x2){q0, q1}, (GAS u32x2*)(P.PG() + (size_t)row * 3072 + (size_t)(pn - 9) * 256 + cl));
                    } else if (mode == 4) {
                        f32x4 s0, s1;
                        if (e == 0) { s0 = v0 * 0.0625f; } else {
#pragma unroll
                            for (int j = 0; j < 4; ++j) s0[j] = sigm(v0[j]); }
#pragma unroll
                        for (int j = 0; j < 4; ++j) s1[j] = sigm(v1[j]);
                        GAS f32x4* wg = (GAS f32x4*)(P.WG() + (size_t)row * 16 + e);
                        wg[0] = s0; wg[1] = s1;
                    }
                }
                asm volatile("" ::: "memory");
            }
        }
    }
};
struct EpiMemKV {
    static constexpr bool PERM = true;
    Bufs P;
    DI void operator()(const f32x4 (&acc)[2][2][4][2], const pg8::Unit& u, int wr, int wc, int fr0, int fq0) const {
        int fr = fr0, fq = fq0; asm volatile("" : "+v"(fr), "+v"(fq));
        const int layer = u.pn >> 1, isv = u.pn & 1;
        float sv[8];
#pragma unroll
        for (int i = 0; i < 8; ++i) sv[i] = P.ssm()[u.pm * 256 + (i >> 2) * 128 + wr * 64 + (i & 3) * 16 + fr];
#pragma unroll
        for (int ai = 0; ai < 2; ++ai)
#pragma unroll
            for (int m = 0; m < 4; ++m) {
                const int row = u.pm * 256 + ai * 128 + wr * 64 + m * 16 + fr;
                const float rs = rs_of(sv[ai * 4 + m]); const int b = row >> 8, mt = row & 255;
#pragma unroll
                for (int bj = 0; bj < 2; ++bj) {
                    const int cl = bj * 128 + wc * 32 + fq * 8, g = cl >> 6, e = cl & 63;
                    const f32x4 v0 = acc[ai][bj][m][0] * rs, v1 = acc[ai][bj][m][1] * rs;
                    if (!isv) st8(P.KMEM() + ((size_t)layer * 2048 + row) * 256 + cl, v0, v1);
                    else {
                        const unsigned w0 = cvtpk(v0[0], v0[1]), w1 = cvtpk(v0[2], v0[3]), w2 = cvtpk(v1[0], v1[1]), w3 = cvtpk(v1[2], v1[3]);
                        GAS bf16_t* d = (GAS bf16_t*)P.VMEMT() + (((size_t)layer * 32 + b * 4 + g) * 64 + e) * 256 + mt;
                        d[0] = (bf16_t)w0; d[256] = (bf16_t)(w0 >> 16); d[512] = (bf16_t)w1; d[768] = (bf16_t)(w1 >> 16);
                        d[1024] = (bf16_t)w2; d[1280] = (bf16_t)(w2 >> 16); d[1536] = (bf16_t)w3; d[1792] = (bf16_t)(w3 >> 16);
                    }
                    asm volatile("" ::: "memory");
                }
            }
    }
};
DI float gelu_tanh(float x) { const float u = 0.7978845608028654f * (x + 0.044715f * x * x * x); const float e = fexp2(-2.f * LOG2E * fabsf(u)); const float th = (1.f - e) * __builtin_amdgcn_rcpf(1.f + e);
    return 0.5f * x * (1.f + (u < 0.f ? -th : th)); }
struct EpiCmp1 {
    static constexpr bool PERM = true;
    bf16_t* HID; const float* bias;
    DI void operator()(const f32x4 (&acc)[2][2][4][2], const pg8::Unit& u, int wr, int wc, int fr0, int fq0) const {
        int fr = fr0, fq = fq0; asm volatile("" : "+v"(fr), "+v"(fq));
        const bool isv = u.pm >= 8;
#pragma unroll
        for (int bj = 0; bj < 2; ++bj) {
            const int cl = bj * 128 + wc * 32 + fq * 8;
            const bool keep = (bj == 1) == isv;
            const f32x4 b0 = *(const GAS f32x4*)(bias + cl), b1 = *(const GAS f32x4*)(bias + cl + 4);
#pragma unroll
            for (int ai = 0; ai < 2; ++ai)
#pragma unroll
                for (int m = 0; m < 4; ++m) {
                    const int row = u.pm * 256 + ai * 128 + wr * 64 + m * 16 + fr;
                    f32x4 h0, h1;
#pragma unroll
                    for (int j = 0; j < 4; ++j) { h0[j] = keep ? gelu_tanh(acc[ai][bj][m][0][j] + b0[j]) : 0.f; h1[j] = keep ? gelu_tanh(acc[ai][bj][m][1][j] + b1[j]) : 0.f; }
                    st8(HID + (size_t)row * 256 + (cl & 127) + (keep ? 0 : 128), h0, h1);
                }
        }
    }
};
struct EpiCmp2 {
    static constexpr bool PERM = true;
    bf16_t *KC, *VCT;
    DI void operator()(const f32x4 (&acc)[2][2][4][2], const pg8::Unit& u, int wr, int wc, int fr0, int fq0) const {
        int fr = fr0, fq = fq0; asm volatile("" : "+v"(fr), "+v"(fq));
        const bool isv = u.pm >= 8;
        if (wc >= 2) return;
#pragma unroll
        for (int ai = 0; ai < 2; ++ai)
#pragma unroll
            for (int m = 0; m < 4; ++m) {
                const int row = u.pm * 256 + ai * 128 + wr * 64 + m * 16 + fr, rl = row & 2047, b = rl >> 8, ci = rl & 255;
                const bool live = ci != 255;
                const f32x4 zf = {0.f, 0.f, 0.f, 0.f};
                (void)b;
                {
                    const int cl = wc * 32 + fq * 8;
                    const f32x4 v0 = live ? acc[ai][0][m][0] : zf, v1 = live ? acc[ai][0][m][1] : zf;
                    if (!isv) st8(KC + (size_t)rl * 64 + cl, v0, v1);
                }
            }
    }
    DI void vpart(const f32x4 (&acc)[2][2][4][2], const pg8::Unit& u, int wr, int wc, int fr0, int fq0) const {
        int fr = fr0, fq = fq0; asm volatile("" : "+v"(fr), "+v"(fq));
        if (u.pm < 8 || wc < 2) return;
#pragma unroll
        for (int ai = 0; ai < 2; ++ai)
#pragma unroll
            for (int m = 0; m < 4; ++m) {
                const int row = u.pm * 256 + ai * 128 + wr * 64 + m * 16 + fr, rl = row & 2047, b = rl >> 8, ci = rl & 255;
                const bool live = ci != 255;
                const f32x4 zf = {0.f, 0.f, 0.f, 0.f};
                const int d0 = (wc - 2) * 32 + fq * 8;
                const f32x4 v0 = live ? acc[ai][0][m][0] : zf, v1 = live ? acc[ai][0][m][1] : zf;
                const unsigned w0 = cvtpk(v0[0], v0[1]), w1 = cvtpk(v0[2], v0[3]), w2 = cvtpk(v1[0], v1[1]), w3 = cvtpk(v1[2], v1[3]);
                GAS bf16_t* d = (GAS bf16_t*)VCT + ((size_t)b * 64 + d0) * 256 + ci;
                d[0] = (bf16_t)w0; d[256] = (bf16_t)(w0 >> 16); d[512] = (bf16_t)w1; d[768] = (bf16_t)(w1 >> 16);
                d[1024] = (bf16_t)w2; d[1280] = (bf16_t)(w2 >> 16); d[1536] = (bf16_t)w3; d[1792] = (bf16_t)(w3 >> 16);
            }
    }
};
struct EpiCmp2All {
    static constexpr bool PERM = true;
    EpiCmp2 e;
    DI void operator()(const f32x4 (&acc)[2][2][4][2], const pg8::Unit& u, int wr, int wc, int fr0, int fq0) const {
        int fr = fr0, fq = fq0; asm volatile("" : "+v"(fr), "+v"(fq));
        if (u.pm < 8) e(acc, u, wr, wc, fr, fq); else e.vpart(acc, u, wr, wc, fr, fq);
    }
};
struct EpiMerge {
    static constexpr bool PERM = true;
    const unsigned char* PG; bf16_t* MG;
    static DI float gq(unsigned w, int j) { return fmaxf((float)((w >> (8 * j)) & 255u) * (1.f / 255.f), 1e-20f); }
    DI void step(f32x4 (&acc)[2][2][4][2], const pg8::Unit& u, int wr, int wc, int fr0, int fq0) const {
        int fr = fr0, fq = fq0; asm volatile("" : "+v"(fr), "+v"(fq));
        const int br = u.br;
#pragma unroll
        for (int ai = 0; ai < 2; ++ai) {
            u32x2 gaa[2][4], gba[2][4];
#pragma unroll
            for (int bj = 0; bj < 2; ++bj) {
                const int rowb = u.pm * 256 + ai * 128 + wr * 64 + fr, col = u.pn * 256 + bj * 128 + wc * 32 + fq * 8;
#pragma unroll
                for (int m = 0; m < 4; ++m) { gaa[bj][m] = *(const GAS u32x2*)(PG + (size_t)(rowb + m * 16) * 3072 + br * 1024 + col);
                    gba[bj][m] = *(const GAS u32x2*)(PG + (size_t)(rowb + m * 16) * 3072 + (br < 2 ? br + 1 : br) * 1024 + col); }
            }
#pragma unroll
            for (int bj = 0; bj < 2; ++bj) {
                const int rowb = u.pm * 256 + ai * 128 + wr * 64 + fr, col = u.pn * 256 + bj * 128 + wc * 32 + fq * 8;
                const u32x2 (&ga)[4] = gaa[bj]; const u32x2 (&gb)[4] = gba[bj];
#pragma unroll
                for (int m = 0; m < 4; ++m) {
                    f32x4 f0, f1;
#pragma unroll
                    for (int j = 0; j < 4; ++j) { f0[j] = gq(ga[m].x, j); f1[j] = gq(ga[m].y, j); }
                    if (br < 2) {
#pragma unroll
                        for (int j = 0; j < 4; ++j) { f0[j] *= __builtin_amdgcn_rcpf(gq(gb[m].x, j)); f1[j] *= __builtin_amdgcn_rcpf(gq(gb[m].y, j)); }
                    }
                    acc[ai][bj][m][0] *= f0; acc[ai][bj][m][1] *= f1;
                    if (br == 2) st8(MG + (size_t)(rowb + m * 16) * 1024 + col, acc[ai][bj][m][0], acc[ai][bj][m][1]);
                }
                asm volatile("" ::: "memory");
            }
        }
    }
};
template <bool DRY = false> struct EpiResidT {
    static constexpr bool PERM = true;
    bf16_t* HB; ssq_t* ssout;
    DI void operator()(const f32x4 (&acc)[2][2][4][2], const pg8::Unit& u, int wr, int wc, int fr0, int fq0) const {
        int fr = fr0, fq = fq0; asm volatile("" : "+v"(fr), "+v"(fq));
        u32x4 hva[2][2][4];
#pragma unroll
        for (int ai = 0; ai < 2; ++ai)
#pragma unroll
            for (int bj = 0; bj < 2; ++bj) {
                const size_t offb = (size_t)(u.pm * 256 + ai * 128 + wr * 64 + fr) * 1024 + u.pn * 256 + bj * 128 + wc * 32 + fq * 8;
#pragma unroll
                for (int m = 0; m < 4; ++m) hva[ai][bj][m] = *(const GAS u32x4*)(HB + offb + (size_t)m * 16 * 1024);
            }
#pragma unroll
        for (int ai = 0; ai < 2; ++ai) {
            float sq[4] = {0.f, 0.f, 0.f, 0.f};
            const int rowb = u.pm * 256 + ai * 128 + wr * 64 + fr;
#pragma unroll
            for (int bj = 0; bj < 2; ++bj) {
                const size_t offb = (size_t)rowb * 1024 + u.pn * 256 + bj * 128 + wc * 32 + fq * 8;
#pragma unroll
                for (int m = 0; m < 4; ++m) {
                    const size_t off = offb + (size_t)m * 16 * 1024;
                    const u32x4 h = hva[ai][bj][m];
                    const f32x4 ha = {__uint_as_float(h.x << 16), __uint_as_float(h.x & 0xffff0000u), __uint_as_float(h.y << 16), __uint_as_float(h.y & 0xffff0000u)};
                    const f32x4 hb4 = {__uint_as_float(h.z << 16), __uint_as_float(h.z & 0xffff0000u), __uint_as_float(h.w << 16), __uint_as_float(h.w & 0xffff0000u)};
                    const f32x4 v0 = acc[ai][bj][m][0] + ha, v1 = acc[ai][bj][m][1] + hb4;
                    if (!DRY) st8(HB + off, v0, v1);
                    sq[m] += (v0[0] * v0[0] + v0[1] * v0[1]) + (v0[2] * v0[2] + v0[3] * v0[3]) + (v1[0] * v1[0] + v1[1] * v1[1]) + (v1[2] * v1[2] + v1[3] * v1[3]);
                }
                asm volatile("" ::: "memory");
            }
#pragma unroll
            for (int m = 0; m < 4; ++m) { float q = sq[m]; q += __shfl_xor(q, 16); q += __shfl_xor(q, 32); if (fq == 0) ss_add(ssout + rowb + m * 16, q); }
        }
    }
};
typedef EpiResidT<false> EpiResid;
struct EpiMemQ {
    static constexpr bool PERM = true;
    const ssq_t* ss; bf16_t* QM;
    DI void operator()(const f32x4 (&acc)[2][2][4][2], const pg8::Unit& u, int wr, int wc, int fr0, int fq0) const {
        int fr = fr0, fq = fq0; asm volatile("" : "+v"(fr), "+v"(fq));
        ssq_t sv[8];
#pragma unroll
        for (int i = 0; i < 8; ++i) sv[i] = ss[u.pm * 256 + (i >> 2) * 128 + wr * 64 + (i & 3) * 16 + fr];
#pragma unroll
        for (int ai = 0; ai < 2; ++ai)
#pragma unroll
            for (int m = 0; m < 4; ++m) {
                const int row = u.pm * 256 + ai * 128 + wr * 64 + m * 16 + fr;
                const float rs = rs_of(sv[ai * 4 + m]) * C2;
#pragma unroll
                for (int bj = 0; bj < 2; ++bj) st8(QM + (size_t)row * 256 + bj * 128 + wc * 32 + fq * 8, acc[ai][bj][m][0] * rs, acc[ai][bj][m][1] * rs);
            }
    }
};
struct EpiNull {
    static constexpr bool PERM = true;
    DI void operator()(const f32x4 (&acc)[2][2][4][2], const pg8::Unit& u, int wr, int wc, int fr0, int fq0) const {
#pragma unroll
        for (int ai = 0; ai < 2; ++ai)
#pragma unroll
            for (int bj = 0; bj < 2; ++bj)
#pragma unroll
                for (int m = 0; m < 4; ++m) { asm volatile("" :: "v"(acc[ai][bj][m][0]), "v"(acc[ai][bj][m][1])); }
    }
};
template <int EXP = 0> struct EpiFfnInT {
    static constexpr bool PERM = true;
    const ssq_t* ss; bf16_t* ACT;
    DI void operator()(const f32x4 (&acc)[2][2][4][2], const pg8::Unit& u, int wr, int wc, int fr0, int fq0) const {
        int fr = fr0, fq = fq0; asm volatile("" : "+v"(fr), "+v"(fq));
        ssq_t sv[8];
#pragma unroll
        for (int i = 0; i < 8; ++i) sv[i] = ss[u.pm * 256 + (i >> 2) * 128 + wr * 64 + (i & 3) * 16 + fr];
#pragma unroll
        for (int ai = 0; ai < 2; ++ai)
#pragma unroll
            for (int m = 0; m < 4; ++m) {
                const int row = u.pm * 256 + ai * 128 + wr * 64 + m * 16 + fr;
                const float rs = (EXP == 1) ? 1.f : rs_of(sv[ai * 4 + m]);
                f32x4 o0, o1;
#pragma unroll
                for (int j = 0; j < 4; ++j) { const float g0 = acc[ai][0][m][0][j] * rs, g1 = acc[ai][0][m][1][j] * rs;
                    o0[j] = g0 * sigm(g0) * (acc[ai][1][m][0][j] * rs); o1[j] = g1 * sigm(g1) * (acc[ai][1][m][1][j] * rs); }
                if (EXP == 2) asm volatile("" :: "v"(o0), "v"(o1)); else st8(ACT + (size_t)row * DFF + u.pn * 128 + wc * 32 + fq * 8, o0, o1);
            }
    }
};
typedef EpiFfnInT<0> EpiFfnIn;
constexpr int LDS_SCRATCH = 139264, MISC_OFF = LDS_SCRATCH, LDS_BYTES = 147456;
static_assert(8 * HWAVE <= LDS_SCRATCH && DS_LDS_END <= LDS_SCRATCH && 128 * 64 * 4 <= 4 * HWAVE && pg8::STAGE_BYTES <= LDS_SCRATCH, "LDS map");

#define XB_TMO      128
#define XB_XCNT(j)  (256  + 64 * (j))
#define XB_XSUB(j)  (1280 + 64 * (j))
#define XB_XGEN(j)  (2304 + 64 * (j))
#define XB_TOP      3328
#define XB_TOPGEN   3392
#define XCD_BAR_WORDS 3456
#define XB_SPIN_CAP (1u << 18)

__device__ __forceinline__ unsigned xb_ld(unsigned* p)              { return __hip_atomic_load(p, __ATOMIC_RELAXED, __HIP_MEMORY_SCOPE_AGENT); }
__device__ __forceinline__ unsigned xb_add(unsigned* p, unsigned v) { return __hip_atomic_fetch_add(p, v, __ATOMIC_RELAXED, __HIP_MEMORY_SCOPE_AGENT); }
__device__ __forceinline__ unsigned xb_xcc_id() { return (unsigned)__builtin_amdgcn_s_getreg((3 << 11) | 20) & 0xFu; }
#define XB_SPIN(cond, bar) do { unsigned _sp = 0; while (cond) { __builtin_amdgcn_s_sleep(1); \
    if ((++_sp & 255u) == 0u) { if (xb_ld(&(bar)[XB_TMO])) break; if (_sp > XB_SPIN_CAP) { atomicAdd(&(bar)[XB_TMO], 1u); break; } } } } while (0)

struct XcdBarrier {
    unsigned* bar; unsigned x;
    volatile LAS unsigned* st;
};

__device__ __forceinline__ XcdBarrier xcd_barrier_post(unsigned* bar, volatile LAS unsigned* st) {
    XcdBarrier b; b.bar = bar; b.x = xb_xcc_id(); b.st = st;
    if (threadIdx.x == 0) (void)xb_add(&bar[XB_XCNT(b.x)], 1u);
    return b;
}
__device__ __forceinline__ void xcd_barrier_complete(unsigned* bar, unsigned x, unsigned& nloc, unsigned& nx) {
    const unsigned G = gridDim.x * gridDim.y * gridDim.z;
    unsigned sum, cnt, mine, sp = 0u;
    for (;;) {
        sum = 0u; cnt = 0u; mine = 0u;
#pragma unroll
        for (unsigned j = 0; j < 16; ++j) { const unsigned c = xb_ld(&bar[XB_XCNT(j)]); sum += c; cnt += (c > 0u) ? 1u : 0u; mine = (j == x) ? c : mine; }
        if (sum == G) break;
        __builtin_amdgcn_s_sleep(1);
        if ((++sp & 255u) == 0u) { if (xb_ld(&bar[XB_TMO])) break; if (sp > XB_SPIN_CAP) { atomicAdd(&bar[XB_TMO], 1u); break; } }
    }
    nloc = mine > 0u ? mine : 1u; nx = cnt > 0u ? cnt : 1u;
}

__device__ __forceinline__ void xcd_barrier(const XcdBarrier& b) {
    asm volatile("s_waitcnt vmcnt(0)" ::: "memory");
    __syncthreads();
    if (threadIdx.x == 0) {
        unsigned* bar = b.bar;
        __builtin_amdgcn_s_waitcnt(0);
        unsigned nloc = b.st[0], nx = b.st[1];
        if (nloc == 0u) { xcd_barrier_complete(bar, b.x, nloc, nx); b.st[0] = nloc; b.st[1] = nx; }
        const unsigned old = xb_add(&bar[XB_XSUB(b.x)], 1u);
        const unsigned gen = old / nloc;
        if (old + 1u == (gen + 1u) * nloc) {
            __builtin_amdgcn_fence(__ATOMIC_RELEASE, "agent");
            asm volatile("s_waitcnt vmcnt(0)" ::: "memory");
            const unsigned og = xb_add(&bar[XB_TOP], 1u);
            const unsigned tg = og / nx;
            if (og + 1u == (tg + 1u) * nx) xb_add(&bar[XB_TOPGEN], 1u);
            else XB_SPIN(xb_ld(&bar[XB_TOPGEN]) == tg, bar);
            __builtin_amdgcn_fence(__ATOMIC_ACQUIRE, "agent");
            xb_add(&bar[XB_XGEN(b.x)], 1u);
            asm volatile("s_waitcnt vmcnt(0)" ::: "memory");
        } else {
            XB_SPIN(xb_ld(&bar[XB_XGEN(b.x)]) == gen, bar);
            __builtin_amdgcn_fence(__ATOMIC_ACQUIRE, "agent");
            asm volatile("s_waitcnt vmcnt(0)" ::: "memory");
        }
    }
    __syncthreads();
}
DI float wave_sum(float v) {
#pragma unroll
    for (int o = 1; o < 64; o <<= 1) v += __shfl_xor(v, o);
    return v;
}
DI int ropeperm(int e) { return (e & 1) ? (e >> 1) + 32 : (e >> 1); }
DI int win_srccol(int n) {
    const int pn = n >> 8, c = n & 255, g = c >> 6, e = c & 63, rp = ropeperm(e);
    switch (pn) {
        case 0: return c; case 1: return 256 + c; case 2: return 512 + c;
        case 3: return 768 + g * 64 + rp; case 4: return 1152 + g * 64 + rp; case 5: return 1476 + g * 64 + rp;
        case 6: return g == 0 ? 1024 + rp : g == 1 ? 1408 + rp : g == 2 ? 1732 + rp : 1860 + rp;
        case 7: return g == 0 ? 1988 + rp : g == 1 ? 1796 + e : g == 2 ? (e < 4 ? 1472 + e : e < 16 ? 2116 + (e - 4) : -1) : -1;
        case 8: return g == 0 ? 1088 + e : g == 1 ? 1924 + e : g == 2 ? 2052 + e : -1;
        default: return 2128 + (n - 2304);
    }
}
constexpr int CV_P = 136;
template <class ColFn> DI void conv_weight(bf16_t* dst, int N, int K, int ld, const float* gain, bool kperm, int kmax, const ColFn& colp, int gwave, int gwaves, int lane, LAS unsigned char* scr, int& off) {
    const int nkt = K >> 6, total = (N >> 6) * nkt;
    const int t0 = (gwave - off + gwaves) % gwaves; off = (off + total) % gwaves;
    for (int t = t0; t < total; t += gwaves) {
        const int n0 = (t / nkt) << 6, k0 = (t % nkt) << 6;
        const float* cp = colp(n0 + lane);
        const bool live = (cp != nullptr) && (k0 < kmax);
        const float* cq = live ? cp + (size_t)k0 * ld : nullptr;
#pragma unroll
        for (int c = 0; c < 2; ++c) {
            float x[32];
#pragma unroll
            for (int j = 0; j < 32; ++j) { const int kk = 32 * c + j, rr = kperm ? ropeperm(kk) : kk; x[j] = live ? cq[(size_t)rr * ld] : 0.f; }
            if (gain) {
#pragma unroll
                for (int j = 0; j < 32; ++j) x[j] *= gain[k0 + 32 * c + j];
            }
#pragma unroll
            for (int j = 0; j < 32; j += 2) *(LAS unsigned*)(scr + lane * CV_P + (32 * c + j) * 2) = cvtpk(x[j], x[j + 1]);
        }
        asm volatile("s_waitcnt lgkmcnt(0)" ::: "memory");
#pragma unroll
        for (int i = 0; i < 8; ++i) {
            const int n = 8 * i + (lane >> 3), ch = lane & 7;
            const u32x2 lo = *(LAS u32x2*)(scr + n * CV_P + ch * 16), hi = *(LAS u32x2*)(scr + n * CV_P + ch * 16 + 8);
            *(GAS u32x4*)(dst + (size_t)(n0 + n) * K + k0 + ch * 8) = (u32x4){lo.x, lo.y, hi.x, hi.y};
        }
        asm volatile("s_waitcnt lgkmcnt(0)" ::: "memory");
    }
}
DI void prologue(const Bufs& P, int gtid, int gthreads, int gwave, int gwaves, int lane, LAS unsigned char* scr) {
    int off = 0;
    for (int l = 0; l < 2; ++l) {
        { const float* W = P.w_in() + (size_t)l * 1024 * DIN;
          conv_weight(P.WIN() + (size_t)l * DINP * 1024, DINP, 1024, DIN, P.norm_mix() + l * 1024, false, 1024, [&](int n) -> const float* { const int sc = win_srccol(n); return sc < 0 ? nullptr : W + sc; }, gwave, gwaves, lane, scr, off); }
        { const float* W = P.w_ffn_in() + (size_t)l * 1024 * 5632;
          conv_weight(P.WFI() + (size_t)l * 5632 * 1024, 5632, 1024, 5632, P.norm_ffn() + l * 1024, false, 1024, [&](int n) -> const float* { const int c = n & 255, idx = (n >> 8) * 128 + (c & 127); return W + ((c & 128) ? DFF + idx : idx); }, gwave, gwaves, lane, scr, off); }
        { const float* W = P.w_ffn_out() + (size_t)l * DFF * 1024;
          conv_weight(P.WFO() + (size_t)l * 1024 * DFF, 1024, DFF, 1024, nullptr, false, DFF, [&](int n) -> const float* { return W + n; }, gwave, gwaves, lane, scr, off); }
        { const float* W = P.w_out() + (size_t)l * 1024 * 1024;
          conv_weight(P.WOUT() + (size_t)l * 1024 * 1024, 1024, 1024, 1024, nullptr, false, 1024, [&](int n) -> const float* { return W + n; }, gwave, gwaves, lane, scr, off); }
        for (int br = 0; br < 3; ++br) { const float* W = P.w_up() + ((size_t)l * 3 + br) * 256 * 1024;
          conv_weight(P.WUP() + ((size_t)l * 3 + br) * 1024 * 256, 1024, 256, 1024, nullptr, false, 256, [&](int n) -> const float* { return W + n; }, gwave, gwaves, lane, scr, off); }
        { const float* W = P.w_mem_q() + (size_t)l * 1024 * 256;
          conv_weight(P.WMQ() + (size_t)l * 256 * 1024, 256, 1024, 256, P.norm_mem_q() + l * 1024, false, 1024, [&](int n) -> const float* { return W + n; }, gwave, gwaves, lane, scr, off); }
        { const float* W = P.w_mem_kv() + (size_t)l * 1024 * 512;
          conv_weight(P.WMKV() + (size_t)l * 512 * 1024, 512, 1024, 512, P.norm_mem_kv() + l * 1024, false, 1024, [&](int n) -> const float* { return W + n; }, gwave, gwaves, lane, scr, off); }
        { const float* W = P.w_mem_o() + (size_t)l * 256 * 1024;
          conv_weight(P.WMO() + (size_t)l * 1024 * 256, 1024, 256, 1024, nullptr, false, 256, [&](int n) -> const float* { return W + n; }, gwave, gwaves, lane, scr, off); }
        { const float* Wk = P.cmp_w1_k() + (size_t)l * 2048 * 128; const float* Wv = P.cmp_w1_v() + (size_t)l * 2048 * 128;
          conv_weight(P.WC1() + (size_t)l * 256 * 2048, 128, 2048, 128, nullptr, true, 2048, [&](int n) -> const float* { return Wk + n; }, gwave, gwaves, lane, scr, off);
          conv_weight(P.WC1() + (size_t)l * 256 * 2048 + (size_t)128 * 2048, 128, 2048, 128, nullptr, false, 2048, [&](int n) -> const float* { return Wv + n; }, gwave, gwaves, lane, scr, off); }
        { const float* Wk = P.cmp_w2_k() + (size_t)l * 128 * 64; const float* Wv = P.cmp_w2_v() + (size_t)l * 128 * 64;
          conv_weight(P.WC2() + (size_t)l * 256 * 256, 256, 256, 64, nullptr, false, 128, [&](int n) -> const float* { return n < 64 ? Wk + ropeperm(n) : n < 128 ? Wv + (n - 64) : nullptr; }, gwave, gwaves, lane, scr, off); }
        const int o0 = (gwave - off + gwaves) % gwaves; off = (off + 256) % gwaves;
        for (int o = o0; o < 256; o += gwaves) {
            const float* W = (o < 128 ? P.cmp_w1_k() : P.cmp_w1_v()) + (size_t)l * 2048 * 128; const float* pos = (o < 128 ? P.cmp_pos_k() : P.cmp_pos_v()) + (size_t)l * 2048; const int n = o & 127;
            float s = 0.f;
#pragma unroll 16
            for (int k = lane; k < 2048; k += 64) s += pos[k] * W[(size_t)k * 128 + n];
            s = wave_sum(s); if (lane == 0) P.BIAS1()[l * 256 + o] = s;
        }
    }
    for (int i = gtid; i < SQ * 32; i += gthreads) {
        const int pos = i >> 5, f = i & 31;
        const float inv = exp2f(-(float)f * (13.287712379549449f / 32.f));
        const float ang = (float)pos * inv;
        const double rev = (double)ang * 0.15915494309189535; const double fr = rev - __builtin_rint(rev);
        const float frf = (float)fr;
        P.rope()[i] = (f32x2){__builtin_amdgcn_cosf(frf), __builtin_amdgcn_sinf(frf)};
    }
    for (int row = 2 * gwave; row < MT + 2048; row += 2 * gwaves) {
        f32x4 v[2][4];
#pragma unroll
        for (int q = 0; q < 2; ++q) { const int rw = row + q; const bool ism = rw >= MT; const int rr = ism ? rw - MT : rw;
            const float* src = (ism ? P.mem() : P.x()) + (size_t)rr * 1024;
#pragma unroll
            for (int j = 0; j < 4; ++j) v[q][j] = *(const GAS f32x4*)(src + 256 * j + 4 * lane); }
#pragma unroll
        for (int q = 0; q < 2; ++q) { const int rw = row + q; const bool ism = rw >= MT; const int rr = ism ? rw - MT : rw;
            bf16_t* dst = (ism ? P.MEMB() : P.HB()) + (size_t)rr * 1024;
            float s = 0.f;
#pragma unroll
            for (int j = 0; j < 4; ++j) { const f32x4 t = v[q][j]; s += (t.x * t.x + t.y * t.y) + (t.z * t.z + t.w * t.w);
                u32x2 w; w.x = cvtpk(t.x, t.y); w.y = cvtpk(t.z, t.w); *(GAS u32x2*)(dst + 256 * j + 4 * lane) = w; }
            s = wave_sum(s); if (lane == 0) { if (ism) P.ssm()[rr] = s; else P.ss()[rr] = (ssq_t)(s * SSQ_SCALE); } }
    }
}

#ifndef PROBE_DUP
#define PROBE_DUP 0
#endif
#ifndef MK_ONE_LAUNCH
#define MK_ONE_LAUNCH 1
#endif
constexpr int NPH_LAYER = 11, PH_FINAL = 2 + 2 * NPH_LAYER, NPHASES = PH_FINAL + 1;
struct Args { Bufs P; int ph_lo, ph_hi; };

__global__ void __launch_bounds__(512, 2) mk_fwd(Args args) {
    extern __shared__ __attribute__((aligned(16))) unsigned char lds_raw[];
    LAS unsigned char* lds = (LAS unsigned char*)lds_raw;
    volatile LAS unsigned* MISC = (volatile LAS unsigned*)(lds + MISC_OFF);
    const Bufs& P = args.P;
    const int G = gridDim.x;
#define TID ((int)threadIdx.x)
#define LANE (TID & 63)
#define WAVE (__builtin_amdgcn_readfirstlane(TID >> 6))
    if (TID < 32) MISC[TID] = 0u;
    __syncthreads();
    XcdBarrier bar; bar.bar = (unsigned*)(P.ctl() + CW_BAR); bar.x = 0; bar.st = nullptr;
    if (MK_ONE_LAUNCH) bar = xcd_barrier_post((unsigned*)(P.ctl() + CW_BAR), MISC + 8);
    const int lo = args.ph_lo, hi = args.ph_hi;
#ifndef PHMASK
#define PHMASK 0xFFFFFFFFu
#endif
#define EN(i) (((PHMASK) >> (i)) & 1u)
#define IN(k) (lo <= (k) && (k) < hi)
#define SEAM(k) do { if (IN(k) && IN((k) + 1)) xcd_barrier(bar); } while (0)
#define QCTR(ph, slot) (Q.ctl() + CW_Q + ((ph) * 4 + (slot)) * 64)
#define QCTRB(ph, slot, b) (Q.ctl() + CW_Q2 + ((((ph) * 4 + (slot)) * 8 + (int)(b)) * 64))
#define FOR_WG_UNITS(ph, slot, nper, BODY) do { const unsigned myx_ = xb_xcc_id() & 7u; bool peek_ = false; \
        for (unsigned qi_ = 0; qi_ < 8u; ++qi_) { const int bq = (int)((myx_ + qi_) & 7u); gu32* ctr_ = QCTRB(ph, slot, bq); \
            if (qi_ > 0u) { \
                if (peek_) { __syncthreads(); if (TID < 8) MISC[24 + TID] = __hip_atomic_load(QCTRB(ph, slot, (int)((myx_ + (unsigned)TID) & 7u)), RLX_AGENT); __syncthreads(); peek_ = false; } \
                if (MISC[24 + qi_] >= (unsigned)(nper)) continue; } \
            for (;;) { if (TID == 0) MISC[16] = __hip_atomic_fetch_add(ctr_, 1u, RLX_AGENT); __syncthreads(); const unsigned u = MISC[16]; __syncthreads(); \
                if (u >= (unsigned)(nper)) break; \
                BODY; } \
            peek_ = true; } } while (0)
#define FOR_UNITS(ph, slot, nper, BODY) do { const unsigned myx_ = xb_xcc_id() & 7u; unsigned exh_ = 0u; \
        for (unsigned qi_ = 0; qi_ < 8u; ++qi_) { const int bq = (int)((myx_ + qi_) & 7u); gu32* ctr_ = QCTRB(ph, slot, bq); \
            if ((exh_ >> qi_) & 1u) continue; \
            for (;;) { const unsigned u = pull(ctr_, ln); if (u >= (unsigned)(nper)) break; BODY; } \
            { const unsigned c_ = __hip_atomic_load(QCTRB(ph, slot, (int)((myx_ + (unsigned)(ln & 7)) & 7u)), RLX_AGENT); exh_ = (unsigned)__ballot(c_ >= (unsigned)(nper)) & 0xffu; } } } while (0)

    if (PROBE_DUP == 50 && IN(0)) { u32x4* z = (u32x4*)P.out(); const u32x4 zz = {0u, 0u, 0u, 0u}; for (size_t i = (size_t)blockIdx.x * 512 + TID; i < (size_t)4 * 1024 * 1024; i += (size_t)G * 512) z[i] = zz; }
    if (EN(0) && IN(0)) { ssq_t* z = P.ss() + MT; for (int i = (int)blockIdx.x * 512 + TID; i < 6 * MT; i += G * 512) z[i] = 0ull; }
    if (EN(0) && IN(0)) { prologue(P, (int)blockIdx.x * 512 + TID, G * 512, (int)blockIdx.x * 8 + WAVE, G * 8, LANE, lds + WAVE * 16384); if (PROBE_DUP == 8) prologue(P, (int)blockIdx.x * 512 + TID, G * 512, (int)blockIdx.x * 8 + WAVE, G * 8, LANE, lds + WAVE * 16384); }
    SEAM(0);
    if (EN(1) && IN(1)) {
        { pg8::Gemm g{P.HB(), P.WIN(), MT, DINP, 1024, 1024, 1024}; pg8::StaticOrder S; S.init(MT, DINP, G, (int)blockIdx.x); EpiIn E{P.ss(), P, lds + pg8::STAGE_BYTES};
          pg8::gemm_phase<EpiIn, pg8::StaticOrder, true>(lds, g, S, E);
          if (PROBE_DUP == 21) pg8::gemm_phase<EpiIn, pg8::StaticOrder, true>(lds, g, S, E);
          if (PROBE_DUP == 25) { EpiMemQ E2{P.ss(), (bf16_t*)P.out()}; pg8::gemm_phase<EpiMemQ, pg8::StaticOrder, true>(lds, g, S, E2); } }
        { pg8::Gemm g{P.MEMB(), P.WMKV(), 2048, 1024, 1024, 1024, 1024}; pg8::StaticOrder S; S.init(2048, 1024, G, (int)((blockIdx.x + G / 2) % G));   EpiMemKV E{P};
          pg8::gemm_phase<EpiMemKV, pg8::StaticOrder, false>(lds, g, S, E); }
    }
    SEAM(1);
#pragma unroll
    for (int l = 0; l < 2; ++l) {
        const int pb = 2 + l * NPH_LAYER;
        ssq_t* ss_mix = P.ss() + (size_t)(3 * l) * MT; ssq_t* ss_a = P.ss() + (size_t)(3 * l + 1) * MT; ssq_t* ss_b = P.ss() + (size_t)(3 * l + 2) * MT; ssq_t* ss_c = P.ss() + (size_t)(3 * l + 3) * MT;
        (void)ss_mix;
        if (EN(2) && IN(pb + 0)) {
            Bufs Q = P; asm volatile("" : "+s"(Q.ws), "+s"(Q.o_));
            { pg8::Gemm g{Q.KCMP(), Q.WC1() + (size_t)l * 256 * 2048, 4096, 256, 2048, 1024, 2048}; pg8::StaticOrder S; S.init(4096, 256, G, (int)blockIdx.x); EpiCmp1 E{Q.HID(), Q.BIAS1() + l * 256};
              pg8::gemm_phase<EpiCmp1, pg8::StaticOrder, false>(lds, g, S, E); }
            __syncthreads(); __builtin_amdgcn_fence(__ATOMIC_ACQUIRE, "agent"); asm volatile("s_waitcnt vmcnt(0)" ::: "memory"); __syncthreads();
            { pg8::Gemm g{Q.HID(), Q.WC2() + (size_t)l * 256 * 256, 4096, 256, 256, 256, 256}; pg8::StaticOrder S; S.init(4096, 256, G, (int)blockIdx.x); EpiCmp2All E{{Q.KC(), Q.VCT()}};
              pg8::gemm_phase<EpiCmp2All, pg8::StaticOrder, false>(lds, g, S, E); }
            int td = TID; asm volatile("" : "+v"(td)); const int ln = td & 63;
            if (PROBE_DUP == 40 || PROBE_DUP == 42) FOR_WG_UNITS(pb + 0, 2, 128, (dsa_select_wg<0, 1>(Q, bq, 127 - (int)u, ln, WAVE, (LAS unsigned*)lds)));
            else if (PROBE_DUP == 41) FOR_WG_UNITS(pb + 0, 2, 128, (dsa_select_wg<0, 2>(Q, bq, 127 - (int)u, ln, WAVE, (LAS unsigned*)lds)));
            else FOR_WG_UNITS(pb + 0, 2, 128, dsa_select_wg<0>(Q, bq, 127 - (int)u, ln, WAVE, (LAS unsigned*)lds));
            if (PROBE_DUP == 3 && l == 0) FOR_WG_UNITS(pb + 0, 3, 128, dsa_select_wg<0>(Q, bq, 127 - (int)u, ln, WAVE, (LAS unsigned*)lds));
            if (PROBE_DUP == 31 && l == 0) FOR_WG_UNITS(pb + 0, 3, 128, dsa_select_wg<11>(Q, bq, 127 - (int)u, ln, WAVE, (LAS unsigned*)lds));
            if (PROBE_DUP == 32 && l == 0) FOR_WG_UNITS(pb + 0, 3, 128, dsa_select_wg<12>(Q, bq, 127 - (int)u, ln, WAVE, (LAS unsigned*)lds));
            if (PROBE_DUP == 33 && l == 0) FOR_WG_UNITS(pb + 0, 3, 128, dsa_select_wg<13>(Q, bq, 127 - (int)u, ln, WAVE, (LAS unsigned*)lds));
            if (PROBE_DUP == 35 && l == 0) FOR_WG_UNITS(pb + 0, 3, 128, dsa_select_wg<14>(Q, bq, 127 - (int)u, ln, WAVE, (LAS unsigned*)lds));
            if (PROBE_DUP == 36 && l == 0) FOR_WG_UNITS(pb + 0, 3, 128, dsa_select_wg<15>(Q, bq, 127 - (int)u, ln, WAVE, (LAS unsigned*)lds));
            if (PROBE_DUP == 34 && l == 0) FOR_WG_UNITS(pb + 0, 3, 128, dsa_select_wg<10>(Q, bq, 127 - (int)u, ln, WAVE, (LAS unsigned*)lds));
            if (PROBE_DUP == 2 && l == 0) FOR_UNITS(pb + 0, 0, 512, sb_unit(Q, bq, (int)(u >> 7), (int)(u & 127u), ln));
        }
        SEAM(pb + 0);
        if (EN(3) && IN(pb + 1)) {
            Bufs Q = P; asm volatile("" : "+s"(Q.ws), "+s"(Q.o_));
            int td = TID; asm volatile("" : "+v"(td)); const int ln = td & 63;
            if (PROBE_DUP == 40 || PROBE_DUP == 41 || PROBE_DUP == 43) FOR_UNITS(pb + 1, 1, 128, nsa_cmp_unit<1>(Q, bq, 127 - (int)u, ln, (LAS float*)(lds + WAVE * HWAVE)));
            else FOR_UNITS(pb + 1, 1, 128, nsa_cmp_unit<0>(Q, bq, 127 - (int)u, ln, (LAS float*)(lds + WAVE * HWAVE)));
            if (PROBE_DUP == 1 && l == 0) FOR_UNITS(pb + 1, 3, 128, nsa_cmp_unit<0>(Q, bq, 127 - (int)u, ln, (LAS float*)(lds + WAVE * HWAVE)));
            FOR_WG_UNITS(pb + 1, 0, 64, dsa_attn_wg(Q, bq, 63 - (int)u, ln, WAVE, td, lds));
            if (PROBE_DUP == 6 && l == 0) FOR_WG_UNITS(pb + 1, 3, 64, dsa_attn_wg(Q, bq, 63 - (int)u, ln, WAVE, td, lds));
            if (PROBE_DUP == 61 && l == 0) FOR_WG_UNITS(pb + 1, 3, 64, dsa_attn_wg<1>(Q, bq, 63 - (int)u, ln, WAVE, td, lds));
            if (PROBE_DUP == 62 && l == 0) FOR_WG_UNITS(pb + 1, 3, 64, dsa_attn_wg<2>(Q, bq, 63 - (int)u, ln, WAVE, td, lds));
            if (PROBE_DUP == 63 && l == 0) FOR_WG_UNITS(pb + 1, 3, 64, dsa_attn_wg<3>(Q, bq, 63 - (int)u, ln, WAVE, td, lds));
            __syncthreads();
            FOR_UNITS(pb + 1, 2, 512, sb_unit(Q, bq, (int)(u >> 7), (int)(u & 127u), ln));
        }
        SEAM(pb + 1);
        if (EN(5) && IN(pb + 2)) {
            Bufs Q = P; asm volatile("" : "+s"(Q.ws), "+s"(Q.o_));
            int td = TID; asm volatile("" : "+v"(td)); const int ln = td & 63;
            FOR_WG_UNITS(pb + 2, 1, 64, nsa_selwin_wg(Q, bq, 63 - (int)u, ln, WAVE, td, lds, Q.O3()));
            if (PROBE_DUP == 5 && l == 0) FOR_WG_UNITS(pb + 2, 3, 64, nsa_selwin_wg(Q, bq, 63 - (int)u, ln, WAVE, td, lds, (bf16_t*)Q.out()));
        }
        SEAM(pb + 2);
        if (EN(6) && IN(pb + 3)) {
            Bufs Q = P; asm volatile("" : "+s"(Q.ws), "+s"(Q.o_));
            pg8::ChainOrder3 S; S.init(MT, 1024, G, (int)blockIdx.x);
            pg8::Gemm g{Q.O3(), Q.WUP() + (size_t)l * 3 * 1024 * 256, MT, 1024, 256, 768, 256, (size_t)256 * 2, (size_t)1024 * 256 * 2};
            EpiMerge E{Q.PG(), Q.MG()};
            pg8::gemm_phase<EpiMerge, pg8::ChainOrder3, true, true>(lds, g, S, E);
        }
        SEAM(pb + 3);
        if (EN(7) && IN(pb + 4)) {
            Bufs Q = P; asm volatile("" : "+s"(Q.ws), "+s"(Q.o_));
            pg8::Gemm g{Q.MG(), Q.WOUT() + (size_t)l * 1024 * 1024, MT, 1024, 1024, 1024, 1024}; pg8::StaticOrder S; S.init(MT, 1024, G, (int)blockIdx.x);
            EpiResid E{Q.HB(), ss_a};
            pg8::gemm_phase<EpiResid, pg8::StaticOrder, true>(lds, g, S, E);
            if (PROBE_DUP == 24 && l == 0) { EpiResidT<true> E2{Q.HB(), (ssq_t*)Q.TAU()}; pg8::gemm_phase<EpiResidT<true>, pg8::StaticOrder, true>(lds, g, S, E2); }
        }
        SEAM(pb + 4);
        if (EN(8) && IN(pb + 5)) {
            Bufs Q = P; asm volatile("" : "+s"(Q.ws), "+s"(Q.o_));
            pg8::Gemm g{Q.HB(), Q.WMQ() + (size_t)l * 256 * 1024, MT, 256, 1024, 1024, 1024}; pg8::StaticOrder S; S.init(MT, 256, G, (int)blockIdx.x); EpiMemQ E{ss_a, Q.QM()};
            pg8::gemm_phase<EpiMemQ, pg8::StaticOrder, false>(lds, g, S, E);
            if (PROBE_DUP == 28 && l == 0) pg8::gemm_phase<EpiMemQ, pg8::StaticOrder, false>(lds, g, S, E);
        }
        SEAM(pb + 5);
        if (EN(9) && IN(pb + 6)) {
            Bufs Q = P; asm volatile("" : "+s"(Q.ws), "+s"(Q.o_));
            int td = TID; asm volatile("" : "+v"(td)); const int ln = td & 63;
            FOR_WG_UNITS(pb + 6, 0, 64, mem_attn_wg(Q, l, bq, (int)(u & 3u), (int)(u >> 2), ln, WAVE, td, lds));
            if (PROBE_DUP == 7 && l == 0) FOR_WG_UNITS(pb + 6, 3, 64, mem_attn_wg(Q, l, bq, (int)(u & 3u), (int)(u >> 2), ln, WAVE, td, lds));
        }
        SEAM(pb + 6);
        if (EN(10) && IN(pb + 7)) {
            Bufs Q = P; asm volatile("" : "+s"(Q.ws), "+s"(Q.o_));
            pg8::Gemm g{Q.OM(), Q.WMO() + (size_t)l * 1024 * 256, MT, 1024, 256, 256, 256}; pg8::StaticOrder S; S.init(MT, 1024, G, (int)blockIdx.x);
            EpiResid E{Q.HB(), ss_b};
            pg8::gemm_phase<EpiResid, pg8::StaticOrder, true>(lds, g, S, E);
            if (PROBE_DUP == 27 && l == 0) { EpiResidT<true> E2{Q.HB(), (ssq_t*)Q.TAU()}; pg8::gemm_phase<EpiResidT<true>, pg8::StaticOrder, true>(lds, g, S, E2); }
        }
        SEAM(pb + 7);
        if (EN(11) && IN(pb + 8)) {
            Bufs Q = P; asm volatile("" : "+s"(Q.ws), "+s"(Q.o_));
            pg8::Gemm g{Q.HB(), Q.WFI() + (size_t)l * 5632 * 1024, MT, 5632, 1024, 1024, 1024}; pg8::StaticOrder S; S.init(MT, 5632, G, (int)blockIdx.x); EpiFfnIn E{ss_b, Q.ACT()};
            pg8::gemm_phase<EpiFfnIn, pg8::StaticOrder, true>(lds, g, S, E);
            if (PROBE_DUP == 22 && l == 0) pg8::gemm_phase<EpiFfnIn, pg8::StaticOrder, true>(lds, g, S, E);
            if (PROBE_DUP == 123 && l == 0) { EpiFfnInT<1> E1{ss_b, Q.ACT()}; pg8::gemm_phase<EpiFfnInT<1>, pg8::StaticOrder, true>(lds, g, S, E1); }
            if (PROBE_DUP == 124 && l == 0) { EpiFfnInT<2> E1{ss_b, Q.ACT()}; pg8::gemm_phase<EpiFfnInT<2>, pg8::StaticOrder, true>(lds, g, S, E1); }
            if (PROBE_DUP == 122 && l == 0) { EpiNull E0; pg8::gemm_phase<EpiNull, pg8::StaticOrder, true>(lds, g, S, E0); }
        }
        SEAM(pb + 8);
        if (EN(12) && IN(pb + 9)) {
            Bufs Q = P; asm volatile("" : "+s"(Q.ws), "+s"(Q.o_));
            pg8::Gemm g{Q.ACT(), Q.WFO() + (size_t)l * 1024 * DFF, MT, 1024, DFF, DFF, DFF}; pg8::StaticOrder S; S.init(MT, 1024, G, (int)blockIdx.x);
            EpiResid E{Q.HB(), ss_c};
            pg8::gemm_phase<EpiResid, pg8::StaticOrder, true>(lds, g, S, E);
            if (PROBE_DUP == 26 && l == 0) { EpiResidT<true> E2{Q.HB(), (ssq_t*)Q.TAU()}; pg8::gemm_phase<EpiResidT<true>, pg8::StaticOrder, true>(lds, g, S, E2); }
        }
        SEAM(pb + 9);
        if (EN(13) && IN(pb + 10) && l == 0) {
            Bufs Q = P; asm volatile("" : "+s"(Q.ws), "+s"(Q.o_));
            pg8::Gemm g{Q.HB(), Q.WIN() + (size_t)DINP * 1024, MT, DINP, 1024, 1024, 1024}; pg8::StaticOrder S; S.init(MT, DINP, G, (int)blockIdx.x); EpiIn E{ss_c, Q, lds + pg8::STAGE_BYTES};
            pg8::gemm_phase<EpiIn, pg8::StaticOrder, true>(lds, g, S, E);
        }
        if (l == 0) SEAM(pb + 10);
    }
    if (PROBE_DUP == 30) { for (int i = 0; i < 20; ++i) xcd_barrier(bar); }
    if (EN(15) && IN(PH_FINAL)) {
        const ssq_t* ssf = P.ss() + (size_t)6 * MT;
        const int lane = LANE, gwave = (int)blockIdx.x * 8 + WAVE, gwaves = G * 8;
        const unsigned chkflag = (PROBE_DUP >= 40 && PROBE_DUP <= 43) ? __hip_atomic_load(P.ctl() + 2, RLX_AGENT) : 0u;
        for (int row = gwave; row < MT; row += gwaves) {
            const float rs = rs_of(ssf[row]); float* o = P.out() + (size_t)row * 1024; const bf16_t* hrow = P.HB() + (size_t)row * 1024;
#pragma unroll
            for (int j = 0; j < 2; ++j) { const u32x4 h = *(const GAS u32x4*)(hrow + 512 * j + 8 * lane);
                const f32x4 g0 = *(const GAS f32x4*)(P.norm_final() + 512 * j + 8 * lane), g1 = *(const GAS f32x4*)(P.norm_final() + 512 * j + 8 * lane + 4);
                const f32x4 v0 = {__uint_as_float(h.x << 16), __uint_as_float(h.x & 0xffff0000u), __uint_as_float(h.y << 16), __uint_as_float(h.y & 0xffff0000u)};
                const f32x4 v1 = {__uint_as_float(h.z << 16), __uint_as_float(h.z & 0xffff0000u), __uint_as_float(h.w << 16), __uint_as_float(h.w & 0xffff0000u)};
                *(GAS f32x4*)(o + 512 * j + 8 * lane) = v0 * rs * g0; *(GAS f32x4*)(o + 512 * j + 8 * lane + 4) = v1 * rs * g1; }
            if (chkflag && row == 0 && lane < 2) o[lane] = (chkflag & (1u << lane)) ? __builtin_nanf("") : o[lane];
        }
    }
#undef IN
#undef SEAM
#undef QCTR
}

extern "C" void kernel_launch(void* const* d_in, const int* in_sizes, int n_in, void* d_out, int out_size, void* d_ws, size_t ws_size, hipStream_t stream) {
    static int grid = 0;
    if (grid == 0) {
        if (n_in != 21 || in_sizes[0] != MT * DM || out_size != MT * DM || ws_size < WS_END) {
            fprintf(stderr, "kernel_launch: unexpected problem: n_in %d in0 %d out %d ws %zu (need %zu); nothing launched\n", n_in, n_in > 0 ? in_sizes[0] : -1, out_size, ws_size, (size_t)WS_END); grid = -1; return; }
        int dev = 0, cus = 0, per_cu = 0;
        if (hipGetDevice(&dev) != hipSuccess || hipDeviceGetAttribute(&cus, hipDeviceAttributeMultiprocessorCount, dev) != hipSuccess) { grid = -1; return; }
        if (hipFuncSetAttribute((const void*)mk_fwd, hipFuncAttributeMaxDynamicSharedMemorySize, LDS_BYTES) != hipSuccess) { fprintf(stderr, "kernel_launch: hipFuncSetAttribute failed\n"); grid = -1; return; }
        if (hipOccupancyMaxActiveBlocksPerMultiprocessor(&per_cu, (const void*)mk_fwd, 512, LDS_BYTES) != hipSuccess || per_cu < 1)
            fprintf(stderr, "kernel_launch: note: occupancy query reports %d workgroups per CU\n", per_cu);
        (void)hipGetLastError();
        grid = cus;
    }
    if (grid < 0) return;
    if (hipMemsetAsync((char*)d_ws + WS_CTL, 0, CTL_ZERO_BYTES, stream) != hipSuccess) { fprintf(stderr, "kernel_launch: memset failed\n"); return; }
    Args a{};
    for (int i = 0; i < 21; ++i) a.P.in[i] = (const float*)d_in[i];
    a.P.o_ = (float*)d_out; a.P.ws = (unsigned char*)d_ws;
#if MK_ONE_LAUNCH
    a.ph_lo = 0; a.ph_hi = NPHASES;
    hipLaunchKernelGGL(mk_fwd, dim3(grid), dim3(512), LDS_BYTES, stream, a);
#else
    for (int ph = 0; ph < NPHASES; ++ph) { a.ph_lo = ph; a.ph_hi = ph + 1; hipLaunchKernelGGL(mk_fwd, dim3(grid), dim3(512), LDS_BYTES, stream, a); }
#endif
    const hipError_t le = hipPeekAtLastError();
    if (le != hipSuccess) fprintf(stderr, "kernel_launch: launch failed: %s\n", hipGetErrorName(le));
}
```
